# Optimizing an MI355X kernel written in HIP

```python
import math
import jax, jax.numpy as jnp
from jax import lax
import numpy as np

D_MODEL = 1024
BATCH = 4
SEQ = 8192
DEPTH = 1

MEM_TOKENS = 256
D_FF = 2816
NORM_EPS = 1e-6

GDN_HEADS = 4
GDN_HEAD_DIM = 128
GDN_WIDTH = GDN_HEADS * GDN_HEAD_DIM
GDN_CONV = 4
GDN_CHUNK = 64

MOBA_HEADS = 4
MOBA_HEAD_DIM = 64
MOBA_WIDTH = MOBA_HEADS * MOBA_HEAD_DIM
MOBA_BLOCK = 256
MOBA_TOPK = 3
MOBA_Q_BLOCK = 128

MEM_HEADS = 4
MEM_HEAD_DIM = 64
MEM_WIDTH = MEM_HEADS * MEM_HEAD_DIM

D_MIX = GDN_WIDTH + MOBA_WIDTH + MEM_WIDTH
IN_SPLITS = (GDN_WIDTH, GDN_WIDTH, GDN_WIDTH, GDN_WIDTH, GDN_HEADS, GDN_HEADS,
             MOBA_WIDTH, MOBA_WIDTH, MOBA_WIDTH, MEM_WIDTH)

kernel_name = "hymba_gdn_moba_macaron_layer"


def rms_norm(x, gain, eps=NORM_EPS):
    xf = x.astype(jnp.float32)
    y = xf * lax.rsqrt(jnp.mean(xf * xf, axis=-1, keepdims=True) + eps)
    return (y * gain.astype(jnp.float32)).astype(x.dtype)


def l2_normalize(x, eps=NORM_EPS):
    return x * lax.rsqrt(jnp.sum(x * x, axis=-1, keepdims=True) + eps)


def swiglu_ffn(x, gain, w_gate, w_up, w_down):
    h = rms_norm(x, gain)
    return (jax.nn.silu(h @ w_gate) * (h @ w_up)) @ w_down


def causal_depthwise_conv(x, w):
    k_len, ch = w.shape
    return lax.conv_general_dilated(x, w[:, None, :], window_strides=(1,), padding=[(k_len - 1, 0)],
                                    dimension_numbers=("NWC", "WIO", "NWC"), feature_group_count=ch)


def alibi_slopes(n_heads):
    return 2.0 ** (-8.0 * jnp.arange(1, n_heads + 1, dtype=jnp.float32) / n_heads)


def gated_deltanet(q, k, v, z, a, b, conv_w, a_log, dt_bias, out_gain):
    f32 = jnp.float32
    bsz, seq, _ = q.shape
    H, Dh, C = GDN_HEADS, GDN_HEAD_DIM, GDN_CHUNK
    n_chunks = seq // C
    qkv = jax.nn.silu(causal_depthwise_conv(jnp.concatenate([q, k, v], axis=-1), conv_w))
    qkv = qkv.astype(f32).reshape(bsz, seq, 3, H, Dh)
    q = l2_normalize(qkv[:, :, 0]) * Dh ** -0.5
    k = l2_normalize(qkv[:, :, 1])
    v = qkv[:, :, 2]
    beta = jax.nn.sigmoid(b.astype(f32))
    g = -jnp.exp(a_log.astype(f32)) * jax.nn.softplus(a.astype(f32) + dt_bias.astype(f32))

    def chunks(t):
        t = t.reshape((bsz, n_chunks, C) + t.shape[2:])
        return jnp.moveaxis(jnp.moveaxis(t, 1, 0), 3, 2)

    qc, kc, vc = chunks(q), chunks(k), chunks(v)
    bc = chunks(beta)
    gc = jnp.cumsum(chunks(g), axis=-1)
    lower = jnp.tril(jnp.ones((C, C), dtype=bool))
    strict = jnp.tril(jnp.ones((C, C), dtype=bool), -1)
    diff = gc[..., :, None] - gc[..., None, :]
    decay = jnp.where(lower, jnp.exp(jnp.where(lower, diff, 0.0)), 0.0)
    k_beta = kc * bc[..., None]
    a_mat = jnp.where(strict, jnp.einsum("nbhid,nbhjd->nbhij", k_beta, kc) * decay, 0.0)
    l_mat = a_mat + jnp.eye(C, dtype=f32)
    u = lax.linalg.triangular_solve(l_mat, vc * bc[..., None], left_side=True, lower=True,
                                    unit_diagonal=True)
    w = lax.linalg.triangular_solve(l_mat, k_beta * jnp.exp(gc)[..., None], left_side=True,
                                    lower=True, unit_diagonal=True)
    qk_intra = jnp.einsum("nbhid,nbhjd->nbhij", qc, kc) * decay

    def step(state, inp):
        q_i, k_i, u_i, w_i, g_i, a_i = inp
        v_new = u_i - jnp.einsum("bhcd,bhde->bhce", w_i, state)
        o_i = (jnp.einsum("bhcd,bhde->bhce", q_i * jnp.exp(g_i)[..., None], state)
               + jnp.einsum("bhij,bhje->bhie", a_i, v_new))
        g_last = g_i[..., -1]
        state = (state * jnp.exp(g_last)[..., None, None]
                 + jnp.einsum("bhcd,bhce->bhde", k_i * jnp.exp(g_last[..., None] - g_i)[..., None], v_new))
        return state, o_i

    state0 = jnp.zeros((bsz, H, Dh, Dh), f32)
    _, o = lax.scan(step, state0, (qc, kc, u, w, gc, qk_intra))
    o = jnp.moveaxis(jnp.moveaxis(o, 0, 1), 2, 3).reshape(bsz, seq, H, Dh)
    o = rms_norm(o, out_gain) * jax.nn.silu(z.astype(f32).reshape(bsz, seq, H, Dh))
    return o.reshape(bsz, seq, H * Dh)


def moba_attention(q, k, v, q_gain, k_gain):
    f32 = jnp.float32
    bsz, seq, _ = q.shape
    H, Dh, BLK, QB = MOBA_HEADS, MOBA_HEAD_DIM, MOBA_BLOCK, MOBA_Q_BLOCK
    t_pad = -(-seq // BLK) * BLK
    n_blocks = t_pad // BLK
    n_qblocks = t_pad // QB
    topk = min(MOBA_TOPK, n_blocks)
    bh = bsz * H

    def heads(t, gain=None):
        t = t.reshape(bsz, seq, H, Dh)
        if gain is not None:
            t = rms_norm(t, gain)
        t = t.astype(f32).transpose(0, 2, 1, 3).reshape(bh, seq, Dh)
        return jnp.pad(t, ((0, 0), (0, t_pad - seq), (0, 0)))

    qh, kh, vh = heads(q, q_gain), heads(k, k_gain), heads(v)
    kb = kh.reshape(bh, n_blocks, BLK, Dh)
    vb = vh.reshape(bh, n_blocks, BLK, Dh)
    k_mean = jnp.mean(kb, axis=2)
    slopes = jnp.broadcast_to(alibi_slopes(H), (bsz, H)).reshape(bh)
    scale = Dh ** -0.5
    key_offs = jnp.arange(BLK)
    q_blocks = qh.reshape(bh, n_qblocks, QB, Dh).transpose(1, 0, 2, 3)

    def one_query_block(args):
        q_blk, c = args
        t_pos = c * QB + jnp.arange(QB)
        own = (c * QB) // BLK
        gate = jnp.einsum("nqd,nbd->nqb", q_blk, k_mean)
        gate = jnp.where(jnp.arange(n_blocks) < own, gate, -jnp.inf)
        _, idx = lax.top_k(gate, topk)
        valid = idx < own
        k_sel = jax.vmap(lambda blocks, ids: blocks[ids])(kb, idx)
        v_sel = jax.vmap(lambda blocks, ids: blocks[ids])(vb, idx)
        dist_sel = (t_pos[None, :, None, None] - (idx[..., None] * BLK + key_offs)).astype(f32)
        s_sel = (jnp.einsum("nqd,nqrkd->nqrk", q_blk, k_sel) * scale
                 - slopes[:, None, None, None] * dist_sel)
        s_sel = jnp.where(valid[..., None], s_sel, -jnp.inf).reshape(bh, QB, topk * BLK)
        k_own = lax.dynamic_index_in_dim(kb, own, axis=1, keepdims=False)
        v_own = lax.dynamic_index_in_dim(vb, own, axis=1, keepdims=False)
        dist_own = (t_pos[:, None] - (own * BLK + key_offs)[None, :]).astype(f32)
        s_own = jnp.einsum("nqd,nkd->nqk", q_blk, k_own) * scale - slopes[:, None, None] * dist_own
        s_own = jnp.where(dist_own >= 0, s_own, -jnp.inf)
        p = jax.nn.softmax(jnp.concatenate([s_sel, s_own], axis=-1), axis=-1)
        p_sel = p[..., :topk * BLK].reshape(bh, QB, topk, BLK)
        p_own = p[..., topk * BLK:]
        return (jnp.einsum("nqrk,nqrkd->nqd", p_sel, v_sel)
                + jnp.einsum("nqk,nkd->nqd", p_own, v_own))

    out = lax.map(one_query_block, (q_blocks, jnp.arange(n_qblocks)))
    out = out.transpose(1, 0, 2, 3).reshape(bsz, H, t_pad, Dh)[:, :, :seq]
    return out.transpose(0, 2, 1, 3).reshape(bsz, seq, H * Dh)


def memory_attention(q, mem_h, w_kv, q_gain, k_gain):
    f32 = jnp.float32
    bsz, seq, _ = q.shape
    n_mem = mem_h.shape[1]
    H, Dh = MEM_HEADS, MEM_HEAD_DIM
    k, v = jnp.split(mem_h @ w_kv, 2, axis=-1)
    qh = rms_norm(q.reshape(bsz, seq, H, Dh), q_gain).astype(f32)
    kh = rms_norm(k.reshape(bsz, n_mem, H, Dh), k_gain).astype(f32)
    vh = v.reshape(bsz, n_mem, H, Dh).astype(f32)
    p = jax.nn.softmax(jnp.einsum("bthd,bmhd->bhtm", qh, kh) * Dh ** -0.5, axis=-1)
    return jnp.einsum("bhtm,bmhd->bthd", p, vh).reshape(bsz, seq, H * Dh)


def setup_inputs(seed: int = 0) -> dict:
    key = jax.random.key(seed)
    ks = jax.random.split(key, 24)
    f32 = jnp.float32
    L = DEPTH
    d_in = sum(IN_SPLITS)

    def dense(k, fan_in, fan_out):
        return jax.random.normal(k, (L, fan_in, fan_out), f32) * fan_in ** -0.5

    def gain(k, n):
        return 1.0 + 0.02 * jax.random.normal(k, (L, n), f32)

    dt = jnp.exp(jax.random.uniform(ks[8], (L, GDN_HEADS), f32, math.log(1e-3), math.log(1e-1)))
    return {
        "x": jax.random.normal(ks[0], (BATCH, SEQ, D_MODEL), f32),
        "mem": jax.random.normal(ks[1], (BATCH, MEM_TOKENS, D_MODEL), f32),
        "ffn1_norm": gain(ks[2], D_MODEL),
        "ffn1_w_gate": dense(ks[3], D_MODEL, D_FF),
        "ffn1_w_up": dense(ks[4], D_MODEL, D_FF),
        "ffn1_w_down": dense(ks[5], D_FF, D_MODEL),
        "mix_norm": gain(ks[6], D_MODEL),
        "w_in": dense(ks[7], D_MODEL, d_in),
        "gdn_conv_w": jax.random.normal(ks[9], (L, GDN_CONV, 3 * GDN_WIDTH), f32) * GDN_CONV ** -0.5,
        "gdn_a_log": jnp.log(jax.random.uniform(ks[10], (L, GDN_HEADS), f32, 1.0, 16.0)),
        "gdn_dt_bias": dt + jnp.log(-jnp.expm1(-dt)),
        "gdn_out_norm": gain(ks[11], GDN_HEAD_DIM),
        "moba_q_norm": gain(ks[12], MOBA_HEAD_DIM),
        "moba_k_norm": gain(ks[13], MOBA_HEAD_DIM),
        "mem_norm": gain(ks[14], D_MODEL),
        "w_mem_kv": dense(ks[15], D_MODEL, 2 * MEM_WIDTH),
        "mem_q_norm": gain(ks[16], MEM_HEAD_DIM),
        "mem_k_norm": gain(ks[17], MEM_HEAD_DIM),
        "w_out": dense(ks[18], D_MIX, D_MODEL),
        "ffn2_norm": gain(ks[19], D_MODEL),
        "ffn2_w_gate": dense(ks[20], D_MODEL, D_FF),
        "ffn2_w_up": dense(ks[21], D_MODEL, D_FF),
        "ffn2_w_down": dense(ks[22], D_FF, D_MODEL),
    }


def reference(x, mem, ffn1_norm, ffn1_w_gate, ffn1_w_up, ffn1_w_down, mix_norm, w_in,
              gdn_conv_w, gdn_a_log, gdn_dt_bias, gdn_out_norm, moba_q_norm, moba_k_norm,
              mem_norm, w_mem_kv, mem_q_norm, mem_k_norm, w_out,
              ffn2_norm, ffn2_w_gate, ffn2_w_up, ffn2_w_down):
    split_at = np.cumsum(IN_SPLITS)[:-1].tolist()
    for l in range(DEPTH):
        x = x + 0.5 * swiglu_ffn(x, ffn1_norm[l], ffn1_w_gate[l], ffn1_w_up[l], ffn1_w_down[l])
        h = rms_norm(x, mix_norm[l])
        gq, gk, gv, gz, ga, gb, mq, mk, mv, cq = jnp.split(h @ w_in[l], split_at, axis=-1)
        y_gdn = gated_deltanet(gq, gk, gv, gz, ga, gb, gdn_conv_w[l], gdn_a_log[l], gdn_dt_bias[l],
                               gdn_out_norm[l])
        y_moba = moba_attention(mq, mk, mv, moba_q_norm[l], moba_k_norm[l])
        y_mem = memory_attention(cq, rms_norm(mem, mem_norm[l]), w_mem_kv[l], mem_q_norm[l], mem_k_norm[l])
        y = jnp.concatenate([y_gdn, y_moba, y_mem], axis=-1).astype(x.dtype)
        x = x + y @ w_out[l]
        x = x + 0.5 * swiglu_ffn(x, ffn2_norm[l], ffn2_w_gate[l], ffn2_w_up[l], ffn2_w_down[l])
    return x
```

```cpp
#include <hip/hip_runtime.h>
#include <hip/hip_cooperative_groups.h>
#include <cstdio>
#include <cstdint>
namespace cg = cooperative_groups;

#ifndef MK_N_LAUNCHES
#define MK_N_LAUNCHES 9
#endif

constexpr int BATCH = 4, SEQ = 8192, DM = 1024, T = BATCH * SEQ, FF = 2816, MEMT = 256;
constexpr int NGU = 2 * FF;
constexpr int NINR = 3072;
constexpr int NIN = 3328;
constexpr int PP = NINR;
constexpr float EPS = 1e-6f;
constexpr int C_GQ = 0, C_GK = 512, C_GV = 1024, C_GZ = 1536, C_MQ = 2048, C_MK = 2304, C_MV = 2560, C_CQ = 2816;

constexpr size_t MiB = 1u << 20;
constexpr size_t WS_CTL = 0, CTL_BYTES = 1 * MiB;
constexpr size_t WS_WGU1 = 1 * MiB, WS_WD1 = 12 * MiB, WS_WIN = 18 * MiB, WS_WOUT = 25 * MiB, WS_WGU2 = 27 * MiB, WS_WD2 = 38 * MiB, WS_WKV = 44 * MiB;
constexpr size_t WS_SS = 45 * MiB;
constexpr size_t WS_RSTDM = 47 * MiB;
constexpr size_t WS_AB = 48 * MiB;
constexpr size_t WS_KMEAN = 49 * MiB;
constexpr size_t WS_KVMEM = 50 * MiB;
constexpr size_t WS_MEMB = 52 * MiB;
constexpr size_t WS_GB = 54 * MiB;
constexpr size_t WS_GG = 54 * MiB + 512 * 1024;
constexpr size_t WS_XB = 56 * MiB;
constexpr size_t WS_KNM = 56 * MiB;
constexpr size_t WS_C = 120 * MiB;
constexpr size_t WS_G = 312 * MiB;
constexpr size_t WS_GQ = 312 * MiB, WS_GK = 344 * MiB, WS_GV = 376 * MiB;
constexpr size_t WS_END = 460 * MiB;

constexpr int NWAVES = 8, NTHREADS = 512;
constexpr int LDS_BYTES = 147456;

typedef unsigned short bf16_t;
typedef short bf16x8 __attribute__((ext_vector_type(8)));
typedef float f32x4 __attribute__((ext_vector_type(4)));
typedef float f32x2 __attribute__((ext_vector_type(2)));
typedef unsigned u32x4 __attribute__((ext_vector_type(4)));
typedef unsigned u32x2 __attribute__((ext_vector_type(2)));
#define LAS __attribute__((address_space(3)))

__device__ __forceinline__ unsigned f2bf(float f) { unsigned u = __builtin_bit_cast(unsigned, f); return (u + 0x7fffu + ((u >> 16) & 1u)) >> 16; }
__device__ __forceinline__ unsigned pk2(float lo, float hi) { return f2bf(lo) | (f2bf(hi) << 16); }
__device__ __forceinline__ float bf2f(unsigned short h) { return __builtin_bit_cast(float, (unsigned)h << 16); }
__device__ __forceinline__ float bflo(unsigned w) { return __builtin_bit_cast(float, w << 16); }
__device__ __forceinline__ float bfhi(unsigned w) { return __builtin_bit_cast(float, w & 0xffff0000u); }
__device__ __forceinline__ float wave_sum(float v) {
#pragma unroll
    for (int o = 1; o < 64; o <<= 1) v += __shfl_xor(v, o);
    return v;
}
__device__ __forceinline__ float wave_max(float v) {
#pragma unroll
    for (int o = 1; o < 64; o <<= 1) v = fmaxf(v, __shfl_xor(v, o));
    return v;
}

namespace pg8 {
constexpr int BM = 256, BK = 64, HALF = 128, HTB = HALF * BK * 2, STAGE_BYTES = 8 * HTB, NXCD = 8, WGM = 8;
__host__ __device__ __forceinline__ int lds_byte(int r, int c) { const int st = (r >> 4) * 2 + (c >> 5), rr = r & 15, cc = c & 31, ob = rr * 64 + cc * 2; return st * 1024 + (ob ^ (((ob >> 9) & 1) << 5)); }
__host__ __device__ __forceinline__ void stage_rc(int b, int& R, int& C) { const int st = b / 1024, sb = b % 1024, swz = sb ^ (((sb >> 9) & 1) << 5); R = (st >> 1) * 16 + swz / 64; C = (st & 1) * 32 + (swz % 64) / 2; }
__host__ __device__ __forceinline__ int perm32(int rho) { const int n = rho >> 4, i = rho & 15; return 8 * (i >> 2) + 4 * n + (i & 3); }

struct Unit { int pm, pn; };
struct Gemm { const bf16_t* A; const bf16_t* Bt; int M, N, K, lda; };

struct StaticOrder {
    int nM, nN, nwg, G, c;
    __device__ void init(int M, int N, int G_, int c_) { nM = M / BM; nN = N / BM; nwg = nM * nN; G = G_; c = c_; }
    __device__ bool next(int i, Unit& u) const {
        const long L = (long)i * G + c; if (c < 0 || L >= nwg) return false;
        int wgid = (int)L; { const int q = nwg / NXCD, r = nwg % NXCD, xcd = wgid % NXCD, off = wgid / NXCD; wgid = (xcd < r ? xcd * (q + 1) : r * (q + 1) + (xcd - r) * q) + off; }
        const int nig = WGM * nN, gid = wgid / nig, fm = gid * WGM, gsz = (nM - fm) < WGM ? (nM - fm) : WGM;
        u.pm = fm + ((wgid % nig) % gsz); u.pn = (wgid % nig) / gsz; return true;
    }
};

template <class Epi, bool ALIGN_EPI>
__device__ __forceinline__ void gemm_phase(LAS unsigned char* lds, const Gemm g, const StaticOrder& S, const Epi& E) {
    const int tid = threadIdx.x, wid = __builtin_amdgcn_readfirstlane(tid >> 6), lane = tid & 63, wr = wid >> 2, wc = wid & 3, fr = lane & 15, fq = lane >> 4;
    const int K = g.K, nt = K / BK, lda = g.lda;
    unsigned voffA[2], voffB[2];
#pragma unroll
    for (int i = 0; i < 2; ++i) { int R, C; stage_rc(tid * 16 + i * 8192, R, C); const int Rb = Epi::PERM ? ((R & ~31) + perm32(R & 31)) : R;
        voffA[i] = (unsigned)(R * lda + C) * 2u; voffB[i] = (unsigned)(Rb * K + C) * 2u; }
    const size_t kstep = (size_t)(BK * 2);
    const size_t hstepA = (size_t)HALF * lda * 2, hstepB = (size_t)HALF * K * 2;
    const size_t tstepA = 2 * hstepA, tstepB = 2 * hstepB;
    const unsigned ldsw = (unsigned)wid * 1024u;
    const int aoff = lds_byte(wr * 64 + fr, fq * 8), boff = lds_byte(wc * 32 + fr, fq * 8);
#define PG8_SA(b, h) (((b) * 2 + (h)) * HTB)
#define PG8_SB(b, h) ((4 + (b) * 2 + (h)) * HTB)
#define PG8_STAGE(bufoff, gbase, voff) do { _Pragma("unroll") for (int _i = 0; _i < 2; ++_i) \
        __builtin_amdgcn_global_load_lds((const unsigned*)((const char*)(gbase) + (voff)[_i]), (LAS unsigned*)(lds + (bufoff) + ldsw + _i * 8192), 16, 0, 0); } while (0)
#define PG8_LDA(dst, b, h) do { _Pragma("unroll") for (int m = 0; m < 4; ++m) _Pragma("unroll") for (int k = 0; k < 2; ++k) dst[m][k] = *(const LAS bf16x8*)(lds + PG8_SA(b, h) + aoff + m * 2048 + k * 1024); } while (0)
#define PG8_LDB(dst, b, h) do { _Pragma("unroll") for (int n = 0; n < 2; ++n) _Pragma("unroll") for (int k = 0; k < 2; ++k) dst[n][k] = *(const LAS bf16x8*)(lds + PG8_SB(b, h) + boff + n * 2048 + k * 1024); } while (0)
#define PG8_MMA(ai, bj, At, Bt) do { __builtin_amdgcn_s_setprio(1); _Pragma("unroll") for (int m = 0; m < 4; ++m) _Pragma("unroll") for (int n = 0; n < 2; ++n) _Pragma("unroll") for (int k = 0; k < 2; ++k) \
        acc[ai][bj][m][n] = __builtin_amdgcn_mfma_f32_16x16x32_bf16(Bt[n][k], At[m][k], acc[ai][bj][m][n], 0, 0, 0); __builtin_amdgcn_s_setprio(0); } while (0)
#define PG8_WAIT_V(n) asm volatile("s_waitcnt vmcnt(" #n ")" ::: "memory")
#define PG8_WAIT_L(n) asm volatile("s_waitcnt lgkmcnt(" #n ")" ::: "memory")
#define PG8_BAR __builtin_amdgcn_s_barrier()
#define PG8_SCHED __builtin_amdgcn_sched_barrier(0)
    Unit cur, nxt; int ui = 0;
    if (!S.next(0, cur)) return;
    f32x4 acc[2][2][4][2];
#pragma unroll
    for (int a = 0; a < 2; ++a)
#pragma unroll
        for (int b = 0; b < 2; ++b)
#pragma unroll
            for (int m = 0; m < 4; ++m)
#pragma unroll
                for (int n = 0; n < 2; ++n) acc[a][b][m][n] = (f32x4){0.f, 0.f, 0.f, 0.f};
    bf16x8 At[4][2], B0[2][2], B1[2][2];
    const char* cA = (const char*)g.A + (size_t)cur.pm * tstepA; const char* cB = (const char*)g.Bt + (size_t)cur.pn * tstepB;
    PG8_STAGE(PG8_SB(0, 0), cB, voffB); PG8_STAGE(PG8_SB(0, 1), cB + hstepB, voffB); PG8_STAGE(PG8_SA(0, 0), cA, voffA); PG8_STAGE(PG8_SA(0, 1), cA + hstepA, voffA);
    if (wr == 1) PG8_BAR;
    PG8_WAIT_V(2); PG8_BAR;
    PG8_STAGE(PG8_SB(1, 0), cB + kstep, voffB); PG8_STAGE(PG8_SA(1, 0), cA + kstep, voffA); PG8_STAGE(PG8_SB(1, 1), cB + hstepB + kstep, voffB);
    PG8_WAIT_V(6); PG8_BAR;
    for (;;) {
        const bool has_next = S.next(ui + 1, nxt);
        const char* nA = has_next ? (const char*)g.A + (size_t)nxt.pm * tstepA : cA; const char* nB = has_next ? (const char*)g.Bt + (size_t)nxt.pn * tstepB : cB;
        for (int t = 0; t < nt; t += 2) {
            const bool last = (t == nt - 2);
            const char* a1 = cA + (size_t)(t + 1) * kstep;
            const char* a2 = last ? nA : cA + (size_t)(t + 2) * kstep; const char* b2 = last ? nB : cB + (size_t)(t + 2) * kstep;
            const char* a3 = a2 + kstep; const char* b3 = b2 + kstep;
            PG8_LDB(B0, 0, 0); PG8_LDB(B1, 0, 1); PG8_SCHED; PG8_LDA(At, 0, 0); PG8_STAGE(PG8_SA(1, 1), a1 + hstepA, voffA);
            PG8_WAIT_V(8); PG8_WAIT_L(0); PG8_BAR; PG8_MMA(0, 0, At, B0); PG8_MMA(0, 1, At, B1); PG8_BAR; PG8_SCHED;
            PG8_LDA(At, 0, 1); PG8_STAGE(PG8_SB(0, 0), b2, voffB); PG8_STAGE(PG8_SB(0, 1), b2 + hstepB, voffB); PG8_STAGE(PG8_SA(0, 0), a2, voffA);
            PG8_WAIT_V(8); PG8_WAIT_L(0); PG8_BAR; PG8_MMA(1, 0, At, B0); PG8_MMA(1, 1, At, B1); PG8_BAR; PG8_SCHED;
            PG8_LDB(B0, 1, 0); PG8_LDB(B1, 1, 1); PG8_SCHED; PG8_LDA(At, 1, 0); PG8_STAGE(PG8_SA(0, 1), a2 + hstepA, voffA);
            PG8_WAIT_V(8); PG8_WAIT_L(0); PG8_BAR; PG8_MMA(0, 0, At, B0); PG8_MMA(0, 1, At, B1); PG8_BAR; PG8_SCHED;
            PG8_LDA(At, 1, 1); PG8_STAGE(PG8_SB(1, 0), b3, voffB); PG8_STAGE(PG8_SB(1, 1), b3 + hstepB, voffB); PG8_STAGE(PG8_SA(1, 0), a3, voffA);
            PG8_WAIT_V(8); PG8_WAIT_L(0); PG8_BAR; PG8_MMA(1, 0, At, B0); PG8_MMA(1, 1, At, B1); PG8_BAR; PG8_SCHED;
        }
        if constexpr (ALIGN_EPI) { if (wr == 0) PG8_BAR; }
        E(acc, cur, wr, wc, fr, fq);
        if (!has_next) break;
#pragma unroll
        for (int a = 0; a < 2; ++a)
#pragma unroll
            for (int b = 0; b < 2; ++b)
#pragma unroll
                for (int m = 0; m < 4; ++m)
#pragma unroll
                    for (int n = 0; n < 2; ++n) acc[a][b][m][n] = (f32x4){0.f, 0.f, 0.f, 0.f};
        cur = nxt; cA = nA; cB = nB; ++ui;
        if constexpr (ALIGN_EPI) { if (wr == 1) PG8_BAR; }
    }
    PG8_WAIT_V(0);
    if constexpr (!ALIGN_EPI) { if (wr == 0) PG8_BAR; }
    PG8_BAR;
#undef PG8_SA
#undef PG8_SB
#undef PG8_STAGE
#undef PG8_LDA
#undef PG8_LDB
#undef PG8_MMA
#undef PG8_WAIT_V
#undef PG8_WAIT_L
#undef PG8_BAR
#undef PG8_SCHED
}

__device__ __forceinline__ float row_rstd(const float* ss, int row) {
    const f32x4* p = (const f32x4*)(ss + (size_t)row * 16);
    const f32x4 a = p[0], b = p[1], c = p[2], d = p[3];
    const float s = ((a[0] + a[1]) + (a[2] + a[3])) + ((b[0] + b[1]) + (b[2] + b[3])) + ((c[0] + c[1]) + (c[2] + c[3])) + ((d[0] + d[1]) + (d[2] + d[3]));
    return __builtin_amdgcn_rsqf(s * (1.0f / DM) + EPS);
}
__device__ __forceinline__ float silu_mul(float g, float u) { return g * __builtin_amdgcn_rcpf(1.0f + __expf(-g)) * u; }

struct EpiSwiGLU {
    static constexpr bool PERM = true;
    bf16_t* H; const float* ss;
    __device__ __forceinline__ void operator()(const f32x4 (&acc)[2][2][4][2], const Unit& u, int wr, int wc, int fr, int fq) const {
#pragma unroll
        for (int ai = 0; ai < 2; ++ai)
#pragma unroll
            for (int m = 0; m < 4; ++m) {
                const int row = u.pm * BM + ai * HALF + wr * 64 + m * 16 + fr;
                const float rs = row_rstd(ss, row);
                u32x4 w;
                { const f32x4 g = acc[ai][0][m][0] * rs, up = acc[ai][1][m][0] * rs; w.x = pk2(silu_mul(g[0], up[0]), silu_mul(g[1], up[1])); w.y = pk2(silu_mul(g[2], up[2]), silu_mul(g[3], up[3])); }
                { const f32x4 g = acc[ai][0][m][1] * rs, up = acc[ai][1][m][1] * rs; w.z = pk2(silu_mul(g[0], up[0]), silu_mul(g[1], up[1])); w.w = pk2(silu_mul(g[2], up[2]), silu_mul(g[3], up[3])); }
                *(u32x4*)(H + (size_t)row * FF + u.pn * 128 + wc * 32 + 8 * fq) = w;
            }
    }
};
struct EpiResid {
    static constexpr bool PERM = false;
    const float* base; float* out; bf16_t* xb; float* ss; float scale; int want_xb;
    __device__ __forceinline__ void operator()(const f32x4 (&acc)[2][2][4][2], const Unit& u, int wr, int wc, int fr, int fq) const {
#pragma unroll
        for (int ai = 0; ai < 2; ++ai)
#pragma unroll
            for (int m = 0; m < 4; ++m) {
                const int row = u.pm * BM + ai * HALF + wr * 64 + m * 16 + fr;
                const size_t off = (size_t)row * DM + u.pn * BM + wc * 32 + 4 * fq;
                float s = 0.f;
#pragma unroll
                for (int bj = 0; bj < 2; ++bj)
#pragma unroll
                    for (int n = 0; n < 2; ++n) {
                        const size_t o = off + bj * HALF + n * 16;
                        const f32x4 v = *(const f32x4*)(base + o) + acc[ai][bj][m][n] * scale;
                        *(f32x4*)(out + o) = v;
                        if (want_xb) { u32x2 w; w.x = pk2(v[0], v[1]); w.y = pk2(v[2], v[3]); *(u32x2*)(xb + o) = w; s += (v[0] * v[0] + v[1] * v[1]) + (v[2] * v[2] + v[3] * v[3]); }
                    }
                if (want_xb) { s += __shfl_xor(s, 16); s += __shfl_xor(s, 32); if (fq == 0) ss[(size_t)row * 16 + u.pn * 4 + wc] = s; }
            }
    }
};
struct EpiWin {
    static constexpr bool PERM = true;
    bf16_t* P; float* AB; const float* ss;
    __device__ __forceinline__ void operator()(const f32x4 (&acc)[2][2][4][2], const Unit& u, int wr, int wc, int fr, int fq) const {
#pragma unroll
        for (int ai = 0; ai < 2; ++ai)
#pragma unroll
            for (int m = 0; m < 4; ++m) {
                const int row = u.pm * BM + ai * HALF + wr * 64 + m * 16 + fr;
                const float rs = row_rstd(ss, row);
                if (u.pn < 12) {
#pragma unroll
                    for (int bj = 0; bj < 2; ++bj) {
                        const f32x4 v0 = acc[ai][bj][m][0] * rs, v1 = acc[ai][bj][m][1] * rs;
                        u32x4 w; w.x = pk2(v0[0], v0[1]); w.y = pk2(v0[2], v0[3]); w.z = pk2(v1[0], v1[1]); w.w = pk2(v1[2], v1[3]);
                        *(u32x4*)(P + (size_t)row * PP + u.pn * BM + bj * HALF + wc * 32 + 8 * fq) = w;
                    }
                } else if (wc == 0 && fq == 0) {
                    *(f32x4*)(AB + (size_t)row * 8) = acc[ai][0][m][0] * rs;
                    *(f32x4*)(AB + (size_t)row * 8 + 4) = acc[ai][0][m][1] * rs;
                }
            }
    }
};
struct EpiKV {
    static constexpr bool PERM = false;
    float* O; const float* rstdm;
    __device__ __forceinline__ void operator()(const f32x4 (&acc)[2][2][4][2], const Unit& u, int wr, int wc, int fr, int fq) const {
#pragma unroll
        for (int ai = 0; ai < 2; ++ai)
#pragma unroll
            for (int m = 0; m < 4; ++m) {
                const int row = u.pm * BM + ai * HALF + wr * 64 + m * 16 + fr;
                const float rs = rstdm[row];
                const size_t off = (size_t)row * 512 + u.pn * BM + wc * 32 + 4 * fq;
#pragma unroll
                for (int bj = 0; bj < 2; ++bj)
#pragma unroll
                    for (int n = 0; n < 2; ++n) *(f32x4*)(O + off + bj * HALF + n * 16) = acc[ai][bj][m][n] * rs;
            }
    }
};
}

struct Args;
struct Frame {
    LAS unsigned char* lds;
    int tid, lane, wave, vcu, G;
    float* out; unsigned char* ws;
};
struct Args { const float* in[23]; float* out; unsigned char* ws; int ph_lo, ph_hi; };

template <class SrcCol>
__device__ __forceinline__ void tr_item(const float* W, int ldw, int k0, int d0, SrcCol src, const float* gain, bf16_t* WT, int Kdim, LAS float* scr, int lane) {
    const int dl = lane & 31, sc = src(d0 + dl);
#pragma unroll 8
    for (int i = 0; i < 32; ++i) { const int kk = 2 * i + (lane >> 5);
        float v = 0.f; if (sc >= 0) { v = W[(size_t)(k0 + kk) * ldw + sc]; if (gain) v *= gain[k0 + kk]; }
        scr[kk * 33 + dl] = v; }
    asm volatile("s_waitcnt lgkmcnt(0)" ::: "memory");
    const int c = lane & 7;
#pragma unroll
    for (int j = 0; j < 4; ++j) { const int n = (lane >> 3) + 8 * j; const LAS float* s = scr + (8 * c) * 33 + n;
        u32x4 o; o.x = pk2(s[0 * 33], s[1 * 33]); o.y = pk2(s[2 * 33], s[3 * 33]); o.z = pk2(s[4 * 33], s[5 * 33]); o.w = pk2(s[6 * 33], s[7 * 33]);
        *(u32x4*)(WT + (size_t)(d0 + n) * Kdim + k0 + 8 * c) = o; }
    asm volatile("s_waitcnt lgkmcnt(0)" ::: "memory");
}
struct SrcGU { int up; __device__ int operator()(int d) const { const int pn = d >> 8, r = d & 255; return ((r >> 7) == up) ? pn * 128 + (r & 127) : -2; } };
struct SrcId { __device__ int operator()(int d) const { return d; } };
struct SrcWin { __device__ int operator()(int d) const { if (d < 2048) return d; if (d < 3072) return d + 8; if (d < 3080) return d - 3072 + 2048; return -1; } };

__device__ __forceinline__ float row_to_bf16(const float* xrow, bf16_t* orow, int lane) {
    const f32x4* xr = (const f32x4*)xrow + lane; f32x4 v[4]; float s = 0.f;
#pragma unroll
    for (int j = 0; j < 4; ++j) { v[j] = xr[64 * j]; s += (v[j][0] * v[j][0] + v[j][1] * v[j][1]) + (v[j][2] * v[j][2] + v[j][3] * v[j][3]); }
    u32x2* o8 = (u32x2*)orow + lane;
#pragma unroll
    for (int j = 0; j < 4; ++j) { u32x2 w; w.x = pk2(v[j][0], v[j][1]); w.y = pk2(v[j][2], v[j][3]); o8[64 * j] = w; }
    return wave_sum(s);
}

__device__ __forceinline__ void p0_prologue(Frame& F, const Args& A) {
    LAS float* scr = (LAS float*)(F.lds + F.wave * 16384);
    const int gw = F.vcu * NWAVES + F.wave, NGW = F.G * NWAVES, lane = F.lane;
    unsigned char* ws = F.ws;
    constexpr int I_GU = (DM / 64) * (NGU / 32);
    constexpr int I_D = (FF / 64) * (DM / 32);
    constexpr int I_IN = (DM / 64) * (NIN / 32);
    constexpr int I_O = (DM / 64) * (DM / 32);
    constexpr int I_KV = (DM / 64) * (512 / 32);
    constexpr int NITEMS = 2 * I_GU + 2 * I_D + I_IN + I_O + I_KV;
    for (int it = gw; it < NITEMS; it += NGW) {
        int r = it;
        if (r < 2 * I_GU) { const int l = r / I_GU; r -= l * I_GU; const int kb = r / (NGU / 32), db = r % (NGU / 32); const int d0 = db * 32; const int up = (d0 >> 7) & 1;
            const float* W = A.in[(l ? 20 : 3) + up]; const float* gain = A.in[l ? 19 : 2];
            SrcGU s{up}; tr_item(W, FF, kb * 64, d0, s, gain, (bf16_t*)(ws + (l ? WS_WGU2 : WS_WGU1)), DM, scr, lane); continue; }
        r -= 2 * I_GU;
        if (r < 2 * I_D) { const int l = r / I_D; r -= l * I_D; const int kb = r / (DM / 32), db = r % (DM / 32);
            tr_item(A.in[l ? 22 : 5], DM, kb * 64, db * 32, SrcId{}, nullptr, (bf16_t*)(ws + (l ? WS_WD2 : WS_WD1)), FF, scr, lane); continue; }
        r -= 2 * I_D;
        if (r < I_IN) { const int kb = r / (NIN / 32), db = r % (NIN / 32);
            tr_item(A.in[7], 3080, kb * 64, db * 32, SrcWin{}, A.in[6], (bf16_t*)(ws + WS_WIN), DM, scr, lane); continue; }
        r -= I_IN;
        if (r < I_O) { const int kb = r / (DM / 32), db = r % (DM / 32);
            tr_item(A.in[18], DM, kb * 64, db * 32, SrcId{}, nullptr, (bf16_t*)(ws + WS_WOUT), DM, scr, lane); continue; }
        r -= I_O;
        { const int kb = r / 16, db = r % 16;
            tr_item(A.in[15], 512, kb * 64, db * 32, SrcId{}, A.in[14], (bf16_t*)(ws + WS_WKV), DM, scr, lane); }
    }
    float* ss = (float*)(ws + WS_SS);
    for (int m = gw; m < T; m += NGW) {
        const float s = row_to_bf16(A.in[0] + (size_t)m * DM, (bf16_t*)(ws + WS_XB) + (size_t)m * DM, lane);
        if (lane < 16) ss[(size_t)m * 16 + lane] = (lane == 0) ? s : 0.f;
    }
    for (int m = gw; m < BATCH * MEMT; m += NGW) {
        const float s = row_to_bf16(A.in[1] + (size_t)m * DM, (bf16_t*)(ws + WS_MEMB) + (size_t)m * DM, lane);
        if (lane == 0) ((float*)(ws + WS_RSTDM))[m] = __builtin_amdgcn_rsqf(s * (1.0f / DM) + EPS);
    }
}

__device__ __forceinline__ void p4a_naive(Frame& F, const Args& A) {
    const int gw = F.vcu * NWAVES + F.wave, NGW = F.G * NWAVES, lane = F.lane;
    unsigned char* ws = F.ws;
    const bf16_t* P = (const bf16_t*)(ws + WS_C);
    const float* convw = A.in[8];
    const int h = lane >> 4;
    float cw[3][4][8];
#pragma unroll
    for (int s = 0; s < 3; ++s)
#pragma unroll
        for (int j = 0; j < 4; ++j)
#pragma unroll
            for (int i = 0; i < 8; ++i) cw[s][j][i] = convw[j * 1536 + s * 512 + lane * 8 + i];
    const float alog = A.in[9][h], dtb = A.in[10][h];
    const float* AB = (const float*)(ws + WS_AB);
    for (int t = gw; t < T; t += NGW) {
        const int tl = t & (SEQ - 1);
        float y[3][8];
#pragma unroll
        for (int s = 0; s < 3; ++s) {
#pragma unroll
            for (int i = 0; i < 8; ++i) y[s][i] = 0.f;
#pragma unroll
            for (int j = 0; j < 4; ++j) { const int tt = tl - 3 + j;
                if (tt >= 0) { const u32x4 w = *(const u32x4*)(P + (size_t)(t - 3 + j) * PP + s * 512 + lane * 8);
                    y[s][0] += cw[s][j][0] * bflo(w.x); y[s][1] += cw[s][j][1] * bfhi(w.x); y[s][2] += cw[s][j][2] * bflo(w.y); y[s][3] += cw[s][j][3] * bfhi(w.y);
                    y[s][4] += cw[s][j][4] * bflo(w.z); y[s][5] += cw[s][j][5] * bfhi(w.z); y[s][6] += cw[s][j][6] * bflo(w.w); y[s][7] += cw[s][j][7] * bfhi(w.w); } }
#pragma unroll
            for (int i = 0; i < 8; ++i) { const float v = y[s][i]; y[s][i] = v * __builtin_amdgcn_rcpf(1.0f + __expf(-v)); }
        }
        float sq = 0.f, sk = 0.f;
#pragma unroll
        for (int i = 0; i < 8; ++i) { sq += y[0][i] * y[0][i]; sk += y[1][i] * y[1][i]; }
#pragma unroll
        for (int o = 1; o < 16; o <<= 1) { sq += __shfl_xor(sq, o); sk += __shfl_xor(sk, o); }
        const float rq = __builtin_amdgcn_rsqf(sq + EPS) * 0.08838834764831845f, rk = __builtin_amdgcn_rsqf(sk + EPS);
        u32x4 wq, wk, wv;
        wq.x = pk2(y[0][0] * rq, y[0][1] * rq); wq.y = pk2(y[0][2] * rq, y[0][3] * rq); wq.z = pk2(y[0][4] * rq, y[0][5] * rq); wq.w = pk2(y[0][6] * rq, y[0][7] * rq);
        wk.x = pk2(y[1][0] * rk, y[1][1] * rk); wk.y = pk2(y[1][2] * rk, y[1][3] * rk); wk.z = pk2(y[1][4] * rk, y[1][5] * rk); wk.w = pk2(y[1][6] * rk, y[1][7] * rk);
        wv.x = pk2(y[2][0], y[2][1]); wv.y = pk2(y[2][2], y[2][3]); wv.z = pk2(y[2][4], y[2][5]); wv.w = pk2(y[2][6], y[2][7]);
        *(u32x4*)((bf16_t*)(ws + WS_GQ) + (size_t)t * 512 + lane * 8) = wq;
        *(u32x4*)((bf16_t*)(ws + WS_GK) + (size_t)t * 512 + lane * 8) = wk;
        *(u32x4*)((bf16_t*)(ws + WS_GV) + (size_t)t * 512 + lane * 8) = wv;
        if ((lane & 15) == 0) {
            const float a = AB[(size_t)t * 8 + h], b = AB[(size_t)t * 8 + 4 + h];
            const float xx = a + dtb; const float sp = (xx > 20.f) ? xx : log1pf(__expf(xx));
            ((float*)(ws + WS_GG))[(size_t)t * 4 + h] = -__expf(alog) * sp;
            ((float*)(ws + WS_GB))[(size_t)t * 4 + h] = 1.0f / (1.0f + __expf(-b));
        }
    }
    {
        const float* kg = A.in[13]; const int d0 = (lane & 15) * 4;
        const float g0 = kg[d0], g1 = kg[d0 + 1], g2 = kg[d0 + 2], g3 = kg[d0 + 3];
        bf16_t* KNM = (bf16_t*)(ws + WS_KNM);
        for (int t = gw; t < T; t += NGW) {
            const int b = t >> 13, tl = t & (SEQ - 1);
            const u32x2 w = *(const u32x2*)(P + (size_t)t * PP + C_MK + lane * 4);
            float v0 = bflo(w.x), v1 = bfhi(w.x), v2 = bflo(w.y), v3 = bfhi(w.y);
            float s = v0 * v0 + v1 * v1 + v2 * v2 + v3 * v3;
#pragma unroll
            for (int o = 1; o < 16; o <<= 1) s += __shfl_xor(s, o);
            const float r = __builtin_amdgcn_rsqf(s * (1.0f / 64) + EPS);
            u32x2 o; o.x = pk2(v0 * r * g0, v1 * r * g1); o.y = pk2(v2 * r * g2, v3 * r * g3);
            *(u32x2*)(KNM + ((size_t)(b * 4 + h) * SEQ + tl) * 64 + d0) = o;
        }
        float* KM = (float*)(ws + WS_KMEAN);
        for (int it = gw; it < BATCH * 32; it += NGW) {
            const int b = it >> 5, j = it & 31;
            float a0 = 0.f, a1 = 0.f, a2 = 0.f, a3 = 0.f;
            for (int k = 0; k < 256; ++k) {
                const int t = b * SEQ + j * 256 + k;
                const u32x2 w = *(const u32x2*)(P + (size_t)t * PP + C_MK + lane * 4);
                float v0 = bflo(w.x), v1 = bfhi(w.x), v2 = bflo(w.y), v3 = bfhi(w.y);
                float s = v0 * v0 + v1 * v1 + v2 * v2 + v3 * v3;
#pragma unroll
                for (int o = 1; o < 16; o <<= 1) s += __shfl_xor(s, o);
                const float r = __builtin_amdgcn_rsqf(s * (1.0f / 64) + EPS);
                a0 += bf2f((unsigned short)f2bf(v0 * r * g0)); a1 += bf2f((unsigned short)f2bf(v1 * r * g1)); a2 += bf2f((unsigned short)f2bf(v2 * r * g2)); a3 += bf2f((unsigned short)f2bf(v3 * r * g3));
            }
            f32x4 o = {a0 * (1.0f / 256), a1 * (1.0f / 256), a2 * (1.0f / 256), a3 * (1.0f / 256)};
            *(f32x4*)(KM + ((size_t)(b * 4 + h) * 32 + j) * 64 + d0) = o;
        }
    }
}

__device__ __forceinline__ void naive_gdn(Frame& F, const Args& A, int b, int h) {
    unsigned char* ws = F.ws;
    LAS float* vec = (LAS float*)F.lds;
    LAS float* ba = vec + 32 * 384;
    LAS float* part = ba + 64;
    LAS float* part2 = part + 512;
    LAS float* obuf = part2 + 512;
    const int tid = F.tid, e = tid & 127, dq = tid >> 7;
    const bf16_t* GQ = (const bf16_t*)(ws + WS_GQ); const bf16_t* GK = (const bf16_t*)(ws + WS_GK); const bf16_t* GV = (const bf16_t*)(ws + WS_GV);
    const float* GB = (const float*)(ws + WS_GB); const float* GG = (const float*)(ws + WS_GG);
    bf16_t* P = (bf16_t*)(ws + WS_C);
    const float* og = A.in[11];
    float S[32];
#pragma unroll
    for (int i = 0; i < 32; ++i) S[i] = 0.f;
    for (int c0 = 0; c0 < SEQ; c0 += 32) {
        __syncthreads();
        for (int i = tid; i < 32 * 384; i += NTHREADS) { const int tk = i / 384, r = i % 384; const size_t t = (size_t)b * SEQ + c0 + tk;
            const bf16_t* src = (r < 128) ? GQ : (r < 256) ? GK : GV;
            vec[i] = bf2f(src[t * 512 + h * 128 + (r & 127)]); }
        if (tid < 32) { const size_t t = (size_t)b * SEQ + c0 + tid; ba[tid * 2] = GB[t * 4 + h]; ba[tid * 2 + 1] = __expf(GG[t * 4 + h]); }
        __syncthreads();
        for (int tk = 0; tk < 32; ++tk) {
            const LAS float* qq = vec + tk * 384 + 32 * dq; const LAS float* kk = qq + 128; const float vv = vec[tk * 384 + 256 + e];
            const float beta = ba[tk * 2], alpha = ba[tk * 2 + 1];
            float p = 0.f;
#pragma unroll
            for (int i = 0; i < 32; ++i) p += S[i] * kk[i];
            part[dq * 128 + e] = p;
            __syncthreads();
            const float Sk = (part[e] + part[128 + e]) + (part[256 + e] + part[384 + e]);
            const float vn = beta * (vv - alpha * Sk);
            float po = 0.f;
#pragma unroll
            for (int i = 0; i < 32; ++i) { S[i] = alpha * S[i] + kk[i] * vn; po += S[i] * qq[i]; }
            part2[dq * 128 + e] = po;
            __syncthreads();
            if (dq == 0) obuf[tk * 128 + e] = (part2[e] + part2[128 + e]) + (part2[256 + e] + part2[384 + e]);
        }
        __syncthreads();
        { const int r = tid >> 4, cb = (tid & 15) * 8; const size_t t = (size_t)b * SEQ + c0 + r;
            float v[8]; float s = 0.f;
#pragma unroll
            for (int i = 0; i < 8; ++i) { v[i] = obuf[r * 128 + cb + i]; s += v[i] * v[i]; }
#pragma unroll
            for (int o = 1; o < 16; o <<= 1) s += __shfl_xor(s, o);
            const float rs = __builtin_amdgcn_rsqf(s * (1.0f / 128) + EPS);
            const u32x4 zw = *(const u32x4*)(P + t * PP + C_GZ + h * 128 + cb);
            float z[8] = {bflo(zw.x), bfhi(zw.x), bflo(zw.y), bfhi(zw.y), bflo(zw.z), bfhi(zw.z), bflo(zw.w), bfhi(zw.w)};
            float o[8];
#pragma unroll
            for (int i = 0; i < 8; ++i) o[i] = v[i] * rs * og[cb + i] * (z[i] * __builtin_amdgcn_rcpf(1.0f + __expf(-z[i])));
            u32x4 w; w.x = pk2(o[0], o[1]); w.y = pk2(o[2], o[3]); w.z = pk2(o[4], o[5]); w.w = pk2(o[6], o[7]);
            *(u32x4*)(P + t * PP + h * 128 + cb) = w; }
    }
}

__device__ __forceinline__ void naive_moba_query(Frame& F, const Args& A, int t, int h, LAS float* sc, LAS float* qs) {
    unsigned char* ws = F.ws; const int lane = F.lane;
    bf16_t* P = (bf16_t*)(ws + WS_C);
    const bf16_t* KNM = (const bf16_t*)(ws + WS_KNM); const float* KM = (const float*)(ws + WS_KMEAN);
    const int b = t >> 13, tl = t & (SEQ - 1), own = tl >> 8, bh = b * 4 + h;
    const float qraw = bf2f(P[(size_t)t * PP + C_MQ + h * 64 + lane]);
    const float qh = qraw * __builtin_amdgcn_rsqf(wave_sum(qraw * qraw) * (1.0f / 64) + EPS) * A.in[12][lane];
    qs[lane] = qh;
    float mygate = -INFINITY;
    for (int j = 0; j < own; ++j) { const float g = wave_sum(qh * KM[((size_t)bh * 32 + j) * 64 + lane]); if (lane == j) mygate = g; }
    const int nsel = own < 3 ? own : 3;
    int sel0 = 0, sel1 = 0, sel2 = 0;
#pragma unroll
    for (int r = 0; r < 3; ++r) {
        if (r < nsel) {
            const float mx = wave_max(mygate);
            const unsigned long long bal = __ballot(mygate == mx);
            const int idx = __builtin_ctzll(bal);
            if (r == 0) sel0 = idx; else if (r == 1) sel1 = idx; else sel2 = idx;
            if (lane == idx) mygate = -INFINITY;
        }
    }
#define SELBLK(bi) (((bi) >= nsel) ? own : ((bi) == 0 ? sel0 : ((bi) == 1 ? sel1 : sel2)))
    const float slope = exp2f(-2.0f * (float)(h + 1));
    asm volatile("s_waitcnt lgkmcnt(0)" ::: "memory");
    float m = -INFINITY;
    const int nblk = nsel + 1;
    for (int bi = 0; bi < nblk; ++bi) {
        const int blk = SELBLK(bi);
        for (int kc = 0; kc < 4; ++kc) {
            const int key = blk * 256 + kc * 64 + lane;
            const u32x4* kp = (const u32x4*)(KNM + ((size_t)bh * SEQ + key) * 64);
            float dot = 0.f;
#pragma unroll
            for (int c = 0; c < 8; ++c) { const u32x4 w = kp[c];
                dot += qs[c * 8 + 0] * bflo(w.x) + qs[c * 8 + 1] * bfhi(w.x) + qs[c * 8 + 2] * bflo(w.y) + qs[c * 8 + 3] * bfhi(w.y)
                     + qs[c * 8 + 4] * bflo(w.z) + qs[c * 8 + 5] * bfhi(w.z) + qs[c * 8 + 6] * bflo(w.w) + qs[c * 8 + 7] * bfhi(w.w); }
            float s = dot * 0.125f - slope * (float)(tl - key);
            if (key > tl) s = -INFINITY;
            sc[bi * 256 + kc * 64 + lane] = s; m = fmaxf(m, s);
        }
    }
    m = wave_max(m);
    float l = 0.f;
    for (int i = lane; i < nblk * 256; i += 64) { const float p = __expf(sc[i] - m); sc[i] = p; l += p; }
    l = wave_sum(l);
    asm volatile("s_waitcnt lgkmcnt(0)" ::: "memory");
    float o = 0.f;
    for (int bi = 0; bi < nblk; ++bi) {
        const int blk = SELBLK(bi);
        const bf16_t* vp = P + ((size_t)b * SEQ + blk * 256) * PP + C_MV + h * 64 + lane;
#pragma unroll 8
        for (int k = 0; k < 256; ++k) o += sc[bi * 256 + k] * bf2f(vp[(size_t)k * PP]);
    }
    P[(size_t)t * PP + 512 + h * 64 + lane] = (bf16_t)f2bf(o / l);
}
__device__ __forceinline__ void naive_mem_query(Frame& F, const Args& A, int t, int h, LAS float* sc, LAS float* qs) {
    unsigned char* ws = F.ws; const int lane = F.lane;
    bf16_t* P = (bf16_t*)(ws + WS_C);
    const float* KV = (const float*)(ws + WS_KVMEM);
    const int b = t >> 13;
    const float qraw = bf2f(P[(size_t)t * PP + C_CQ + h * 64 + lane]);
    const float qh = qraw * __builtin_amdgcn_rsqf(wave_sum(qraw * qraw) * (1.0f / 64) + EPS) * A.in[16][lane];
    qs[lane] = qh;
    const float* kg = A.in[17];
    asm volatile("s_waitcnt lgkmcnt(0)" ::: "memory");
    float m = -INFINITY;
    for (int kc = 0; kc < 4; ++kc) {
        const int key = kc * 64 + lane;
        const f32x4* kp = (const f32x4*)(KV + ((size_t)b * MEMT + key) * 512 + h * 64);
        float dot = 0.f, s2 = 0.f;
#pragma unroll
        for (int c = 0; c < 16; ++c) { const f32x4 w = kp[c];
            dot += qs[c * 4 + 0] * w[0] * kg[c * 4 + 0] + qs[c * 4 + 1] * w[1] * kg[c * 4 + 1] + qs[c * 4 + 2] * w[2] * kg[c * 4 + 2] + qs[c * 4 + 3] * w[3] * kg[c * 4 + 3];
            s2 += (w[0] * w[0] + w[1] * w[1]) + (w[2] * w[2] + w[3] * w[3]); }
        const float s = dot * __builtin_amdgcn_rsqf(s2 * (1.0f / 64) + EPS) * 0.125f;
        sc[key] = s; m = fmaxf(m, s);
    }
    m = wave_max(m);
    float l = 0.f;
    for (int i = lane; i < 256; i += 64) { const float p = __expf(sc[i] - m); sc[i] = p; l += p; }
    l = wave_sum(l);
    asm volatile("s_waitcnt lgkmcnt(0)" ::: "memory");
    float o = 0.f;
    const float* vp = KV + (size_t)b * MEMT * 512 + 256 + h * 64 + lane;
#pragma unroll 8
    for (int k = 0; k < 256; ++k) o += sc[k] * vp[(size_t)k * 512];
    P[(size_t)t * PP + 768 + h * 64 + lane] = (bf16_t)f2bf(o / l);
}

__device__ __forceinline__ void p4b_naive(Frame& F, const Args& A) {
    const int bx = blockIdx.x;
    if (bx < 16) { naive_gdn(F, A, bx >> 2, bx & 3); return; }
    LAS float* sc = (LAS float*)F.lds + F.wave * 1152;
    LAS float* qs = sc + 1024;
    const int w = bx - 16, NW = F.G - 16;
    const int NQ = T * 4 / 8;
    for (int it = w; it < 2 * NQ; it += NW) {
        const int kind = it >= NQ; const int q = (kind ? it - NQ : it) * 8 + F.wave;
        if (kind) naive_mem_query(F, A, q >> 2, q & 3, sc, qs); else naive_moba_query(F, A, q >> 2, q & 3, sc, qs);
    }
}

__global__ void __launch_bounds__(NTHREADS, 2) mk_fwd(Args args) {
    extern __shared__ __attribute__((aligned(16))) unsigned char lds_raw[];
    Frame F;
    F.lds = (LAS unsigned char*)lds_raw;
    F.tid = threadIdx.x; F.lane = F.tid & 63; F.wave = __builtin_amdgcn_readfirstlane(F.tid >> 6);
    F.G = gridDim.x; { const int bx = blockIdx.x; F.vcu = (F.G % 8 == 0) ? (bx % 8) * (F.G / 8) + bx / 8 : bx; }
    F.out = args.out; F.ws = args.ws;
    unsigned char* ws = args.ws;
    const int lo = args.ph_lo, hi = args.ph_hi;
#define IN(k) (lo <= (k) && (k) < hi)
#define SEAM(k) do { if (IN(k) && IN((k) + 1)) { cg::this_grid().sync(); } } while (0)
    float* ss = (float*)(ws + WS_SS);
    bf16_t* XB = (bf16_t*)(ws + WS_XB);
    bf16_t* PC = (bf16_t*)(ws + WS_C);

    if (IN(0)) { p0_prologue(F, args); }
    SEAM(0);
    if (IN(1)) {
        pg8::Gemm g{XB, (const bf16_t*)(ws + WS_WGU1), T, NGU, DM, DM}; pg8::StaticOrder S; S.init(T, NGU, F.G, (int)blockIdx.x);
        pg8::EpiSwiGLU E{PC, ss};
        pg8::gemm_phase<pg8::EpiSwiGLU, true>(F.lds, g, S, E);
    }
    SEAM(1);
    if (IN(2)) {
        pg8::Gemm g{PC, (const bf16_t*)(ws + WS_WD1), T, DM, FF, FF}; pg8::StaticOrder S; S.init(T, DM, F.G, (int)blockIdx.x);
        pg8::EpiResid E{args.in[0], F.out, XB, ss, 0.5f, 1};
        pg8::gemm_phase<pg8::EpiResid, true>(F.lds, g, S, E);
    }
    SEAM(2);
    if (IN(3)) {
        pg8::Gemm g{XB, (const bf16_t*)(ws + WS_WIN), T, NIN, DM, DM}; pg8::StaticOrder S; S.init(T, NIN, F.G, (int)blockIdx.x);
        pg8::EpiWin E{PC, (float*)(ws + WS_AB), ss};
        pg8::gemm_phase<pg8::EpiWin, true>(F.lds, g, S, E);
        {
            pg8::Gemm g2{(const bf16_t*)(ws + WS_MEMB), (const bf16_t*)(ws + WS_WKV), BATCH * MEMT, 512, DM, DM}; pg8::StaticOrder S2; S2.init(BATCH * MEMT, 512, 8, (int)blockIdx.x - (F.G - 8));
            pg8::EpiKV E2{(float*)(ws + WS_KVMEM), (const float*)(ws + WS_RSTDM)};
            pg8::gemm_phase<pg8::EpiKV, false>(F.lds, g2, S2, E2);
        }
    }
    SEAM(3);
    if (IN(4)) { p4a_naive(F, args); }
    SEAM(4);
    if (IN(5)) { p4b_naive(F, args); }
    SEAM(5);
    if (IN(6)) {
        pg8::Gemm g{PC, (const bf16_t*)(ws + WS_WOUT), T, DM, DM, PP}; pg8::StaticOrder S; S.init(T, DM, F.G, (int)blockIdx.x);
        pg8::EpiResid E{F.out, F.out, XB, ss, 1.0f, 1};
        pg8::gemm_phase<pg8::EpiResid, true>(F.lds, g, S, E);
    }
    SEAM(6);
    if (IN(7)) {
        pg8::Gemm g{XB, (const bf16_t*)(ws + WS_WGU2), T, NGU, DM, DM}; pg8::StaticOrder S; S.init(T, NGU, F.G, (int)blockIdx.x);
        pg8::EpiSwiGLU E{PC, ss};
        pg8::gemm_phase<pg8::EpiSwiGLU, true>(F.lds, g, S, E);
    }
    SEAM(7);
    if (IN(8)) {
        pg8::Gemm g{PC, (const bf16_t*)(ws + WS_WD2), T, DM, FF, FF}; pg8::StaticOrder S; S.init(T, DM, F.G, (int)blockIdx.x);
        pg8::EpiResid E{F.out, F.out, XB, ss, 0.5f, 0};
        pg8::gemm_phase<pg8::EpiResid, true>(F.lds, g, S, E);
    }
#undef IN
#undef SEAM
}

constexpr int N_PHASES = 9;
extern "C" void kernel_launch(void* const* d_in, const int* in_sizes, int n_in, void* d_out, int out_size, void* d_ws, size_t ws_size, hipStream_t stream) {
    static int grid = 0;
    if (grid == 0) {
        if (n_in != 23 || out_size != T * DM || ws_size < WS_END) { fprintf(stderr, "kernel_launch: unexpected shapes (n_in %d out %d ws %zu)\n", n_in, out_size, ws_size); grid = -1; return; }
        int dev = 0, cus = 0, per_cu = 0;
        (void)hipGetDevice(&dev); (void)hipDeviceGetAttribute(&cus, hipDeviceAttributeMultiprocessorCount, dev);
        (void)hipFuncSetAttribute((const void*)mk_fwd, hipFuncAttributeMaxDynamicSharedMemorySize, LDS_BYTES);
        (void)hipOccupancyMaxActiveBlocksPerMultiprocessor(&per_cu, (const void*)mk_fwd, NTHREADS, LDS_BYTES);
        (void)hipGetLastError();
        if (per_cu < 1) { fprintf(stderr, "kernel_launch: occupancy query says %d blocks/CU\n", per_cu); }
        grid = cus;
        if (grid != 256) fprintf(stderr, "kernel_launch: %d CUs (expected 256)\n", grid);
    }
    if (grid < 0) return;
    Args a{};
    for (int i = 0; i < 23; ++i) a.in[i] = (const float*)d_in[i];
    a.out = (float*)d_out; a.ws = (unsigned char*)d_ws;
    if (MK_N_LAUNCHES == 1) {
        a.ph_lo = 0; a.ph_hi = N_PHASES;
        void* kargs[] = {&a};
        hipError_t e = hipLaunchCooperativeKernel((const void*)mk_fwd, dim3(grid), dim3(NTHREADS), kargs, LDS_BYTES, stream);
        if (e != hipSuccess) fprintf(stderr, "cooperative launch failed: %s\n", hipGetErrorString(e));
    } else {
        for (int p = 0; p < N_PHASES; ++p) {
            a.ph_lo = p; a.ph_hi = p + 1;
            hipLaunchKernelGGL(mk_fwd, dim3(grid), dim3(NTHREADS), LDS_BYTES, stream, a);
        }
    }
}
```

```cpp
#include <hip/hip_runtime.h>
#include <hip/hip_cooperative_groups.h>
#include <cstdio>
#include <cstdint>
namespace cg = cooperative_groups;

#ifndef MK_N_LAUNCHES
#define MK_N_LAUNCHES 1
#endif

constexpr int BATCH = 4, SEQ = 8192, DM = 1024, T = BATCH * SEQ, FF = 2816, MEMT = 256;
constexpr int NGU = 2 * FF;
constexpr int NINR = 3072;
constexpr int NIN = 3328;
constexpr int PP = NINR;
constexpr float EPS = 1e-6f;
constexpr int C_GQ = 0, C_GK = 512, C_GV = 1024, C_GZ = 1536, C_MQ = 2048, C_MK = 2304, C_MV = 2560, C_CQ = 2816;

constexpr size_t MiB = 1u << 20;
constexpr size_t WS_CTL = 0, CTL_BYTES = 1 * MiB;
constexpr size_t WS_WGU1 = 1 * MiB, WS_WD1 = 12 * MiB, WS_WIN = 18 * MiB, WS_WOUT = 25 * MiB, WS_WGU2 = 27 * MiB, WS_WD2 = 38 * MiB, WS_WKV = 44 * MiB;
constexpr size_t WS_SS = 45 * MiB;
constexpr size_t WS_RSTDM = 47 * MiB;
constexpr size_t WS_AB = 48 * MiB;
constexpr size_t WS_KMEAN = 49 * MiB;
constexpr size_t WS_KVMEM = 50 * MiB;
constexpr size_t WS_MEMB = 52 * MiB;
constexpr size_t WS_GB = 54 * MiB;
constexpr size_t WS_GG = 54 * MiB + 512 * 1024;
constexpr size_t WS_XB = 56 * MiB;
constexpr size_t WS_KNM = 56 * MiB;
constexpr size_t WS_C = 120 * MiB;
constexpr size_t WS_G = 312 * MiB;
constexpr size_t WS_GQ = 312 * MiB, WS_GK = 344 * MiB, WS_GV = 376 * MiB;
constexpr size_t WS_END = 460 * MiB;

constexpr int NWAVES = 8, NTHREADS = 512;
constexpr int LDS_BYTES = 147456;

typedef unsigned short bf16_t;
typedef short bf16x8 __attribute__((ext_vector_type(8)));
typedef float f32x4 __attribute__((ext_vector_type(4)));
typedef float f32x2 __attribute__((ext_vector_type(2)));
typedef unsigned u32x4 __attribute__((ext_vector_type(4)));
typedef unsigned u32x2 __attribute__((ext_vector_type(2)));
#define LAS __attribute__((address_space(3)))

__device__ __forceinline__ unsigned f2bf(float f) { unsigned u = __builtin_bit_cast(unsigned, f); return (u + 0x7fffu + ((u >> 16) & 1u)) >> 16; }
__device__ __forceinline__ unsigned pk2(float lo, float hi) { return f2bf(lo) | (f2bf(hi) << 16); }
__device__ __forceinline__ float bf2f(unsigned short h) { return __builtin_bit_cast(float, (unsigned)h << 16); }
__device__ __forceinline__ float bflo(unsigned w) { return __builtin_bit_cast(float, w << 16); }
__device__ __forceinline__ float bfhi(unsigned w) { return __builtin_bit_cast(float, w & 0xffff0000u); }
__device__ __forceinline__ float wave_sum(float v) {
#pragma unroll
    for (int o = 1; o < 64; o <<= 1) v += __shfl_xor(v, o);
    return v;
}
__device__ __forceinline__ float wave_max(float v) {
#pragma unroll
    for (int o = 1; o < 64; o <<= 1) v = fmaxf(v, __shfl_xor(v, o));
    return v;
}

namespace pg8 {
constexpr int BM = 256, BK = 64, HALF = 128, HTB = HALF * BK * 2, STAGE_BYTES = 8 * HTB, NXCD = 8, WGM = 8;
__host__ __device__ __forceinline__ int lds_byte(int r, int c) { const int st = (r >> 4) * 2 + (c >> 5), rr = r & 15, cc = c & 31, ob = rr * 64 + cc * 2; return st * 1024 + (ob ^ (((ob >> 9) & 1) << 5)); }
__host__ __device__ __forceinline__ void stage_rc(int b, int& R, int& C) { const int st = b / 1024, sb = b % 1024, swz = sb ^ (((sb >> 9) & 1) << 5); R = (st >> 1) * 16 + swz / 64; C = (st & 1) * 32 + (swz % 64) / 2; }
__host__ __device__ __forceinline__ int perm32(int rho) { const int n = rho >> 4, i = rho & 15; return 8 * (i >> 2) + 4 * n + (i & 3); }

struct Unit { int pm, pn; };
struct Gemm { const bf16_t* A; const bf16_t* Bt; int M, N, K, lda; };

struct StaticOrder {
    int nM, nN, nwg, G, c;
    __device__ void init(int M, int N, int G_, int c_) { nM = M / BM; nN = N / BM; nwg = nM * nN; G = G_; c = c_; }
    __device__ bool next(int i, Unit& u) const {
        const long L = (long)i * G + c; if (c < 0 || L >= nwg) return false;
        int wgid = (int)L; { const int q = nwg / NXCD, r = nwg % NXCD, xcd = wgid % NXCD, off = wgid / NXCD; wgid = (xcd < r ? xcd * (q + 1) : r * (q + 1) + (xcd - r) * q) + off; }
        const int nig = WGM * nN, gid = wgid / nig, fm = gid * WGM, gsz = (nM - fm) < WGM ? (nM - fm) : WGM;
        u.pm = fm + ((wgid % nig) % gsz); u.pn = (wgid % nig) / gsz; return true;
    }
};

template <class Epi, bool ALIGN_EPI>
__device__ __forceinline__ void gemm_phase(LAS unsigned char* lds, const Gemm g, const StaticOrder& S, const Epi& E) {
    const int tid = threadIdx.x, wid = __builtin_amdgcn_readfirstlane(tid >> 6), lane = tid & 63, wr = wid >> 2, wc = wid & 3, fr = lane & 15, fq = lane >> 4;
    const int K = g.K, nt = K / BK, lda = g.lda;
    unsigned voffA[2], voffB[2];
#pragma unroll
    for (int i = 0; i < 2; ++i) { int R, C; stage_rc(tid * 16 + i * 8192, R, C); const int Rb = Epi::PERM ? ((R & ~31) + perm32(R & 31)) : R;
        voffA[i] = (unsigned)(R * lda + C) * 2u; voffB[i] = (unsigned)(Rb * K + C) * 2u; }
    const size_t kstep = (size_t)(BK * 2);
    const size_t hstepA = (size_t)HALF * lda * 2, hstepB = (size_t)HALF * K * 2;
    const size_t tstepA = 2 * hstepA, tstepB = 2 * hstepB;
    const unsigned ldsw = (unsigned)wid * 1024u;
    const int aoff = lds_byte(wr * 64 + fr, fq * 8), boff = lds_byte(wc * 32 + fr, fq * 8);
#define PG8_SA(b, h) (((b) * 2 + (h)) * HTB)
#define PG8_SB(b, h) ((4 + (b) * 2 + (h)) * HTB)
#define PG8_STAGE(bufoff, gbase, voff) do { _Pragma("unroll") for (int _i = 0; _i < 2; ++_i) \
        __builtin_amdgcn_global_load_lds((const unsigned*)((const char*)(gbase) + (voff)[_i]), (LAS unsigned*)(lds + (bufoff) + ldsw + _i * 8192), 16, 0, 0); } while (0)
#define PG8_LDA(dst, b, h) do { _Pragma("unroll") for (int m = 0; m < 4; ++m) _Pragma("unroll") for (int k = 0; k < 2; ++k) dst[m][k] = *(const LAS bf16x8*)(lds + PG8_SA(b, h) + aoff + m * 2048 + k * 1024); } while (0)
#define PG8_LDB(dst, b, h) do { _Pragma("unroll") for (int n = 0; n < 2; ++n) _Pragma("unroll") for (int k = 0; k < 2; ++k) dst[n][k] = *(const LAS bf16x8*)(lds + PG8_SB(b, h) + boff + n * 2048 + k * 1024); } while (0)
#define PG8_MMA(ai, bj, At, Bt) do { __builtin_amdgcn_s_setprio(1); _Pragma("unroll") for (int m = 0; m < 4; ++m) _Pragma("unroll") for (int n = 0; n < 2; ++n) _Pragma("unroll") for (int k = 0; k < 2; ++k) \
        acc[ai][bj][m][n] = __builtin_amdgcn_mfma_f32_16x16x32_bf16(Bt[n][k], At[m][k], acc[ai][bj][m][n], 0, 0, 0); __builtin_amdgcn_s_setprio(0); } while (0)
#define PG8_WAIT_V(n) asm volatile("s_waitcnt vmcnt(" #n ")" ::: "memory")
#define PG8_WAIT_L(n) asm volatile("s_waitcnt lgkmcnt(" #n ")" ::: "memory")
#define PG8_BAR __builtin_amdgcn_s_barrier()
#define PG8_SCHED __builtin_amdgcn_sched_barrier(0)
    Unit cur, nxt; int ui = 0;
    if (!S.next(0, cur)) return;
    f32x4 acc[2][2][4][2];
#pragma unroll
    for (int a = 0; a < 2; ++a)
#pragma unroll
        for (int b = 0; b < 2; ++b)
#pragma unroll
            for (int m = 0; m < 4; ++m)
#pragma unroll
                for (int n = 0; n < 2; ++n) acc[a][b][m][n] = (f32x4){0.f, 0.f, 0.f, 0.f};
    bf16x8 At[4][2], B0[2][2], B1[2][2];
    const char* cA = (const char*)g.A + (size_t)cur.pm * tstepA; const char* cB = (const char*)g.Bt + (size_t)cur.pn * tstepB;
    PG8_STAGE(PG8_SB(0, 0), cB, voffB); PG8_STAGE(PG8_SB(0, 1), cB + hstepB, voffB); PG8_STAGE(PG8_SA(0, 0), cA, voffA); PG8_STAGE(PG8_SA(0, 1), cA + hstepA, voffA);
    if (wr == 1) PG8_BAR;
    PG8_WAIT_V(2); PG8_BAR;
    PG8_STAGE(PG8_SB(1, 0), cB + kstep, voffB); PG8_STAGE(PG8_SA(1, 0), cA + kstep, voffA); PG8_STAGE(PG8_SB(1, 1), cB + hstepB + kstep, voffB);
    PG8_WAIT_V(6); PG8_BAR;
    for (;;) {
        const bool has_next = S.next(ui + 1, nxt);
        const char* nA = has_next ? (const char*)g.A + (size_t)nxt.pm * tstepA : cA; const char* nB = has_next ? (const char*)g.Bt + (size_t)nxt.pn * tstepB : cB;
        for (int t = 0; t < nt; t += 2) {
            const bool last = (t == nt - 2);
            const char* a1 = cA + (size_t)(t + 1) * kstep;
            const char* a2 = last ? nA : cA + (size_t)(t + 2) * kstep; const char* b2 = last ? nB : cB + (size_t)(t + 2) * kstep;
            const char* a3 = a2 + kstep; const char* b3 = b2 + kstep;
            PG8_LDB(B0, 0, 0); PG8_LDB(B1, 0, 1); PG8_SCHED; PG8_LDA(At, 0, 0); PG8_STAGE(PG8_SA(1, 1), a1 + hstepA, voffA);
            PG8_WAIT_V(8); PG8_WAIT_L(0); PG8_BAR; PG8_MMA(0, 0, At, B0); PG8_MMA(0, 1, At, B1); PG8_BAR; PG8_SCHED;
            PG8_LDA(At, 0, 1); PG8_STAGE(PG8_SB(0, 0), b2, voffB); PG8_STAGE(PG8_SB(0, 1), b2 + hstepB, voffB); PG8_STAGE(PG8_SA(0, 0), a2, voffA);
            PG8_WAIT_V(8); PG8_WAIT_L(0); PG8_BAR; PG8_MMA(1, 0, At, B0); PG8_MMA(1, 1, At, B1); PG8_BAR; PG8_SCHED;
            PG8_LDB(B0, 1, 0); PG8_LDB(B1, 1, 1); PG8_SCHED; PG8_LDA(At, 1, 0); PG8_STAGE(PG8_SA(0, 1), a2 + hstepA, voffA);
            PG8_WAIT_V(8); PG8_WAIT_L(0); PG8_BAR; PG8_MMA(0, 0, At, B0); PG8_MMA(0, 1, At, B1); PG8_BAR; PG8_SCHED;
            PG8_LDA(At, 1, 1); PG8_STAGE(PG8_SB(1, 0), b3, voffB); PG8_STAGE(PG8_SB(1, 1), b3 + hstepB, voffB); PG8_STAGE(PG8_SA(1, 0), a3, voffA);
            PG8_WAIT_V(8); PG8_WAIT_L(0); PG8_BAR; PG8_MMA(1, 0, At, B0); PG8_MMA(1, 1, At, B1); PG8_BAR; PG8_SCHED;
        }
        if constexpr (ALIGN_EPI) { if (wr == 0) PG8_BAR; }
        E(acc, cur, wr, wc, fr, fq);
        if (!has_next) break;
#pragma unroll
        for (int a = 0; a < 2; ++a)
#pragma unroll
            for (int b = 0; b < 2; ++b)
#pragma unroll
                for (int m = 0; m < 4; ++m)
#pragma unroll
                    for (int n = 0; n < 2; ++n) acc[a][b][m][n] = (f32x4){0.f, 0.f, 0.f, 0.f};
        cur = nxt; cA = nA; cB = nB; ++ui;
        if constexpr (ALIGN_EPI) { if (wr == 1) PG8_BAR; }
    }
    PG8_WAIT_V(0);
    if constexpr (!ALIGN_EPI) { if (wr == 0) PG8_BAR; }
    PG8_BAR;
#undef PG8_SA
#undef PG8_SB
#undef PG8_STAGE
#undef PG8_LDA
#undef PG8_LDB
#undef PG8_MMA
#undef PG8_WAIT_V
#undef PG8_WAIT_L
#undef PG8_BAR
#undef PG8_SCHED
}

__device__ __forceinline__ float row_rstd(const float* ss, int row) {
    const f32x4* p = (const f32x4*)(ss + (size_t)row * 16);
    const f32x4 a = p[0], b = p[1], c = p[2], d = p[3];
    const float s = ((a[0] + a[1]) + (a[2] + a[3])) + ((b[0] + b[1]) + (b[2] + b[3])) + ((c[0] + c[1]) + (c[2] + c[3])) + ((d[0] + d[1]) + (d[2] + d[3]));
    return __builtin_amdgcn_rsqf(s * (1.0f / DM) + EPS);
}
__device__ __forceinline__ float silu_mul(float g, float u) { return g * __builtin_amdgcn_rcpf(1.0f + __expf(-g)) * u; }

struct EpiSwiGLU {
    static constexpr bool PERM = true;
    bf16_t* H; const float* ss;
    __device__ __forceinline__ void operator()(const f32x4 (&acc)[2][2][4][2], const Unit& u, int wr, int wc, int fr, int fq) const {
#pragma unroll
        for (int ai = 0; ai < 2; ++ai)
#pragma unroll
            for (int m = 0; m < 4; ++m) {
                const int row = u.pm * BM + ai * HALF + wr * 64 + m * 16 + fr;
                const float rs = row_rstd(ss, row);
                u32x4 w;
                { const f32x4 g = acc[ai][0][m][0] * rs, up = acc[ai][1][m][0] * rs; w.x = pk2(silu_mul(g[0], up[0]), silu_mul(g[1], up[1])); w.y = pk2(silu_mul(g[2], up[2]), silu_mul(g[3], up[3])); }
                { const f32x4 g = acc[ai][0][m][1] * rs, up = acc[ai][1][m][1] * rs; w.z = pk2(silu_mul(g[0], up[0]), silu_mul(g[1], up[1])); w.w = pk2(silu_mul(g[2], up[2]), silu_mul(g[3], up[3])); }
                *(u32x4*)(H + (size_t)row * FF + u.pn * 128 + wc * 32 + 8 * fq) = w;
            }
    }
};
struct EpiResid {
    static constexpr bool PERM = false;
    const float* base; float* out; bf16_t* xb; float* ss; float scale; int want_xb;
    __device__ __forceinline__ void operator()(const f32x4 (&acc)[2][2][4][2], const Unit& u, int wr, int wc, int fr, int fq) const {
#pragma unroll
        for (int ai = 0; ai < 2; ++ai)
#pragma unroll
            for (int m = 0; m < 4; ++m) {
                const int row = u.pm * BM + ai * HALF + wr * 64 + m * 16 + fr;
                const size_t off = (size_t)row * DM + u.pn * BM + wc * 32 + 4 * fq;
                float s = 0.f;
#pragma unroll
                for (int bj = 0; bj < 2; ++bj)
#pragma unroll
                    for (int n = 0; n < 2; ++n) {
                        const size_t o = off + bj * HALF + n * 16;
                        const f32x4 v = *(const f32x4*)(base + o) + acc[ai][bj][m][n] * scale;
                        *(f32x4*)(out + o) = v;
                        if (want_xb) { u32x2 w; w.x = pk2(v[0], v[1]); w.y = pk2(v[2], v[3]); *(u32x2*)(xb + o) = w; s += (v[0] * v[0] + v[1] * v[1]) + (v[2] * v[2] + v[3] * v[3]); }
                    }
                if (want_xb) { s += __shfl_xor(s, 16); s += __shfl_xor(s, 32); if (fq == 0) ss[(size_t)row * 16 + u.pn * 4 + wc] = s; }
            }
    }
};
struct EpiWin {
    static constexpr bool PERM = true;
    bf16_t* P; float* AB; const float* ss;
    __device__ __forceinline__ void operator()(const f32x4 (&acc)[2][2][4][2], const Unit& u, int wr, int wc, int fr, int fq) const {
#pragma unroll
        for (int ai = 0; ai < 2; ++ai)
#pragma unroll
            for (int m = 0; m < 4; ++m) {
                const int row = u.pm * BM + ai * HALF + wr * 64 + m * 16 + fr;
                const float rs = row_rstd(ss, row);
                if (u.pn < 12) {
#pragma unroll
                    for (int bj = 0; bj < 2; ++bj) {
                        const f32x4 v0 = acc[ai][bj][m][0] * rs, v1 = acc[ai][bj][m][1] * rs;
                        u32x4 w; w.x = pk2(v0[0], v0[1]); w.y = pk2(v0[2], v0[3]); w.z = pk2(v1[0], v1[1]); w.w = pk2(v1[2], v1[3]);
                        *(u32x4*)(P + (size_t)row * PP + u.pn * BM + bj * HALF + wc * 32 + 8 * fq) = w;
                    }
                } else if (wc == 0 && fq == 0) {
                    *(f32x4*)(AB + (size_t)row * 8) = acc[ai][0][m][0] * rs;
                    *(f32x4*)(AB + (size_t)row * 8 + 4) = acc[ai][0][m][1] * rs;
                }
            }
    }
};
struct EpiKV {
    static constexpr bool PERM = false;
    float* O; const float* rstdm;
    __device__ __forceinline__ void operator()(const f32x4 (&acc)[2][2][4][2], const Unit& u, int wr, int wc, int fr, int fq) const {
#pragma unroll
        for (int ai = 0; ai < 2; ++ai)
#pragma unroll
            for (int m = 0; m < 4; ++m) {
                const int row = u.pm * BM + ai * HALF + wr * 64 + m * 16 + fr;
                const float rs = rstdm[row];
                const size_t off = (size_t)row * 512 + u.pn * BM + wc * 32 + 4 * fq;
#pragma unroll
                for (int bj = 0; bj < 2; ++bj)
#pragma unroll
                    for (int n = 0; n < 2; ++n) *(f32x4*)(O + off + bj * HALF + n * 16) = acc[ai][bj][m][n] * rs;
            }
    }
};
}

struct Args;
struct Frame {
    LAS unsigned char* lds;
    int tid, lane, wave, vcu, G;
    float* out; unsigned char* ws;
};
struct Args { const float* in[23]; float* out; unsigned char* ws; int ph_lo, ph_hi; };

template <class SrcCol>
__device__ __forceinline__ void tr_item(const float* W, int ldw, int k0, int d0, SrcCol src, const float* gain, bf16_t* WT, int Kdim, LAS float* scr, int lane) {
    const int dl = lane & 31, sc = src(d0 + dl);
#pragma unroll 8
    for (int i = 0; i < 32; ++i) { const int kk = 2 * i + (lane >> 5);
        float v = 0.f; if (sc >= 0) { v = W[(size_t)(k0 + kk) * ldw + sc]; if (gain) v *= gain[k0 + kk]; }
        scr[kk * 33 + dl] = v; }
    asm volatile("s_waitcnt lgkmcnt(0)" ::: "memory");
    const int c = lane & 7;
#pragma unroll
    for (int j = 0; j < 4; ++j) { const int n = (lane >> 3) + 8 * j; const LAS float* s = scr + (8 * c) * 33 + n;
        u32x4 o; o.x = pk2(s[0 * 33], s[1 * 33]); o.y = pk2(s[2 * 33], s[3 * 33]); o.z = pk2(s[4 * 33], s[5 * 33]); o.w = pk2(s[6 * 33], s[7 * 33]);
        *(u32x4*)(WT + (size_t)(d0 + n) * Kdim + k0 + 8 * c) = o; }
    asm volatile("s_waitcnt lgkmcnt(0)" ::: "memory");
}
struct SrcGU { int up; __device__ int operator()(int d) const { const int pn = d >> 8, r = d & 255; return ((r >> 7) == up) ? pn * 128 + (r & 127) : -2; } };
struct SrcId { __device__ int operator()(int d) const { return d; } };
struct SrcWin { __device__ int operator()(int d) const { if (d < 2048) return d; if (d < 3072) return d + 8; if (d < 3080) return d - 3072 + 2048; return -1; } };

__device__ __forceinline__ float row_to_bf16(const float* xrow, bf16_t* orow, int lane) {
    const f32x4* xr = (const f32x4*)xrow + lane; f32x4 v[4]; float s = 0.f;
#pragma unroll
    for (int j = 0; j < 4; ++j) { v[j] = xr[64 * j]; s += (v[j][0] * v[j][0] + v[j][1] * v[j][1]) + (v[j][2] * v[j][2] + v[j][3] * v[j][3]); }
    u32x2* o8 = (u32x2*)orow + lane;
#pragma unroll
    for (int j = 0; j < 4; ++j) { u32x2 w; w.x = pk2(v[j][0], v[j][1]); w.y = pk2(v[j][2], v[j][3]); o8[64 * j] = w; }
    return wave_sum(s);
}

__device__ __forceinline__ void p0_prologue(Frame& F, const Args& A) {
    LAS float* scr = (LAS float*)(F.lds + F.wave * 16384);
    const int gw = F.vcu * NWAVES + F.wave, NGW = F.G * NWAVES, lane = F.lane;
    unsigned char* ws = F.ws;
    constexpr int I_GU = (DM / 64) * (NGU / 32);
    constexpr int I_D = (FF / 64) * (DM / 32);
    constexpr int I_IN = (DM / 64) * (NIN / 32);
    constexpr int I_O = (DM / 64) * (DM / 32);
    constexpr int I_KV = (DM / 64) * (512 / 32);
    constexpr int NITEMS = 2 * I_GU + 2 * I_D + I_IN + I_O + I_KV;
    for (int it = gw; it < NITEMS; it += NGW) {
        int r = it;
        if (r < 2 * I_GU) { const int l = r / I_GU; r -= l * I_GU; const int kb = r / (NGU / 32), db = r % (NGU / 32); const int d0 = db * 32; const int up = (d0 >> 7) & 1;
            const float* W = A.in[(l ? 20 : 3) + up]; const float* gain = A.in[l ? 19 : 2];
            SrcGU s{up}; tr_item(W, FF, kb * 64, d0, s, gain, (bf16_t*)(ws + (l ? WS_WGU2 : WS_WGU1)), DM, scr, lane); continue; }
        r -= 2 * I_GU;
        if (r < 2 * I_D) { const int l = r / I_D; r -= l * I_D; const int kb = r / (DM / 32), db = r % (DM / 32);
            tr_item(A.in[l ? 22 : 5], DM, kb * 64, db * 32, SrcId{}, nullptr, (bf16_t*)(ws + (l ? WS_WD2 : WS_WD1)), FF, scr, lane); continue; }
        r -= 2 * I_D;
        if (r < I_IN) { const int kb = r / (NIN / 32), db = r % (NIN / 32);
            tr_item(A.in[7], 3080, kb * 64, db * 32, SrcWin{}, A.in[6], (bf16_t*)(ws + WS_WIN), DM, scr, lane); continue; }
        r -= I_IN;
        if (r < I_O) { const int kb = r / (DM / 32), db = r % (DM / 32);
            tr_item(A.in[18], DM, kb * 64, db * 32, SrcId{}, nullptr, (bf16_t*)(ws + WS_WOUT), DM, scr, lane); continue; }
        r -= I_O;
        { const int kb = r / 16, db = r % 16;
            tr_item(A.in[15], 512, kb * 64, db * 32, SrcId{}, A.in[14], (bf16_t*)(ws + WS_WKV), DM, scr, lane); }
    }
    float* ss = (float*)(ws + WS_SS);
    for (int m = gw; m < T; m += NGW) {
        const float s = row_to_bf16(A.in[0] + (size_t)m * DM, (bf16_t*)(ws + WS_XB) + (size_t)m * DM, lane);
        if (lane < 16) ss[(size_t)m * 16 + lane] = (lane == 0) ? s : 0.f;
    }
    for (int m = gw; m < BATCH * MEMT; m += NGW) {
        const float s = row_to_bf16(A.in[1] + (size_t)m * DM, (bf16_t*)(ws + WS_MEMB) + (size_t)m * DM, lane);
        if (lane == 0) ((float*)(ws + WS_RSTDM))[m] = __builtin_amdgcn_rsqf(s * (1.0f / DM) + EPS);
    }
}

__device__ __forceinline__ void p4a_naive(Frame& F, const Args& A) {
    const int gw = F.vcu * NWAVES + F.wave, NGW = F.G * NWAVES, lane = F.lane;
    unsigned char* ws = F.ws;
    const bf16_t* P = (const bf16_t*)(ws + WS_C);
    const float* convw = A.in[8];
    const int h = lane >> 4;
    float cw[3][4][8];
#pragma unroll
    for (int s = 0; s < 3; ++s)
#pragma unroll
        for (int j = 0; j < 4; ++j)
#pragma unroll
            for (int i = 0; i < 8; ++i) cw[s][j][i] = convw[j * 1536 + s * 512 + lane * 8 + i];
    const float alog = A.in[9][h], dtb = A.in[10][h];
    const float* AB = (const float*)(ws + WS_AB);
    for (int t = gw; t < T; t += NGW) {
        const int tl = t & (SEQ - 1);
        float y[3][8];
#pragma unroll
        for (int s = 0; s < 3; ++s) {
#pragma unroll
            for (int i = 0; i < 8; ++i) y[s][i] = 0.f;
#pragma unroll
            for (int j = 0; j < 4; ++j) { const int tt = tl - 3 + j;
                if (tt >= 0) { const u32x4 w = *(const u32x4*)(P + (size_t)(t - 3 + j) * PP + s * 512 + lane * 8);
                    y[s][0] += cw[s][j][0] * bflo(w.x); y[s][1] += cw[s][j][1] * bfhi(w.x); y[s][2] += cw[s][j][2] * bflo(w.y); y[s][3] += cw[s][j][3] * bfhi(w.y);
                    y[s][4] += cw[s][j][4] * bflo(w.z); y[s][5] += cw[s][j][5] * bfhi(w.z); y[s][6] += cw[s][j][6] * bflo(w.w); y[s][7] += cw[s][j][7] * bfhi(w.w); } }
#pragma unroll
            for (int i = 0; i < 8; ++i) { const float v = y[s][i]; y[s][i] = v * __builtin_amdgcn_rcpf(1.0f + __expf(-v)); }
        }
        float sq = 0.f, sk = 0.f;
#pragma unroll
        for (int i = 0; i < 8; ++i) { sq += y[0][i] * y[0][i]; sk += y[1][i] * y[1][i]; }
#pragma unroll
        for (int o = 1; o < 16; o <<= 1) { sq += __shfl_xor(sq, o); sk += __shfl_xor(sk, o); }
        const float rq = __builtin_amdgcn_rsqf(sq + EPS) * 0.08838834764831845f, rk = __builtin_amdgcn_rsqf(sk + EPS);
        u32x4 wq, wk, wv;
        wq.x = pk2(y[0][0] * rq, y[0][1] * rq); wq.y = pk2(y[0][2] * rq, y[0][3] * rq); wq.z = pk2(y[0][4] * rq, y[0][5] * rq); wq.w = pk2(y[0][6] * rq, y[0][7] * rq);
        wk.x = pk2(y[1][0] * rk, y[1][1] * rk); wk.y = pk2(y[1][2] * rk, y[1][3] * rk); wk.z = pk2(y[1][4] * rk, y[1][5] * rk); wk.w = pk2(y[1][6] * rk, y[1][7] * rk);
        wv.x = pk2(y[2][0], y[2][1]); wv.y = pk2(y[2][2], y[2][3]); wv.z = pk2(y[2][4], y[2][5]); wv.w = pk2(y[2][6], y[2][7]);
        *(u32x4*)((bf16_t*)(ws + WS_GQ) + (size_t)t * 512 + lane * 8) = wq;
        *(u32x4*)((bf16_t*)(ws + WS_GK) + (size_t)t * 512 + lane * 8) = wk;
        *(u32x4*)((bf16_t*)(ws + WS_GV) + (size_t)t * 512 + lane * 8) = wv;
        if ((lane & 15) == 0) {
            const float a = AB[(size_t)t * 8 + h], b = AB[(size_t)t * 8 + 4 + h];
            const float xx = a + dtb; const float sp = (xx > 20.f) ? xx : log1pf(__expf(xx));
            ((float*)(ws + WS_GG))[(size_t)t * 4 + h] = -__expf(alog) * sp;
            ((float*)(ws + WS_GB))[(size_t)t * 4 + h] = 1.0f / (1.0f + __expf(-b));
        }
    }
    {
        const float* kg = A.in[13]; const int d0 = (lane & 15) * 4;
        const float g0 = kg[d0], g1 = kg[d0 + 1], g2 = kg[d0 + 2], g3 = kg[d0 + 3];
        bf16_t* KNM = (bf16_t*)(ws + WS_KNM);
        for (int t = gw; t < T; t += NGW) {
            const int b = t >> 13, tl = t & (SEQ - 1);
            const u32x2 w = *(const u32x2*)(P + (size_t)t * PP + C_MK + lane * 4);
            float v0 = bflo(w.x), v1 = bfhi(w.x), v2 = bflo(w.y), v3 = bfhi(w.y);
            float s = v0 * v0 + v1 * v1 + v2 * v2 + v3 * v3;
#pragma unroll
            for (int o = 1; o < 16; o <<= 1) s += __shfl_xor(s, o);
            const float r = __builtin_amdgcn_rsqf(s * (1.0f / 64) + EPS);
            u32x2 o; o.x = pk2(v0 * r * g0, v1 * r * g1); o.y = pk2(v2 * r * g2, v3 * r * g3);
            *(u32x2*)(KNM + ((size_t)(b * 4 + h) * SEQ + tl) * 64 + d0) = o;
        }
        float* KM = (float*)(ws + WS_KMEAN);
        for (int it = gw; it < BATCH * 32; it += NGW) {
            const int b = it >> 5, j = it & 31;
            float a0 = 0.f, a1 = 0.f, a2 = 0.f, a3 = 0.f;
            for (int k = 0; k < 256; ++k) {
                const int t = b * SEQ + j * 256 + k;
                const u32x2 w = *(const u32x2*)(P + (size_t)t * PP + C_MK + lane * 4);
                float v0 = bflo(w.x), v1 = bfhi(w.x), v2 = bflo(w.y), v3 = bfhi(w.y);
                float s = v0 * v0 + v1 * v1 + v2 * v2 + v3 * v3;
#pragma unroll
                for (int o = 1; o < 16; o <<= 1) s += __shfl_xor(s, o);
                const float r = __builtin_amdgcn_rsqf(s * (1.0f / 64) + EPS);
                a0 += bf2f((unsigned short)f2bf(v0 * r * g0)); a1 += bf2f((unsigned short)f2bf(v1 * r * g1)); a2 += bf2f((unsigned short)f2bf(v2 * r * g2)); a3 += bf2f((unsigned short)f2bf(v3 * r * g3));
            }
            f32x4 o = {a0 * (1.0f / 256), a1 * (1.0f / 256), a2 * (1.0f / 256), a3 * (1.0f / 256)};
            *(f32x4*)(KM + ((size_t)(b * 4 + h) * 32 + j) * 64 + d0) = o;
        }
    }
}

__device__ __forceinline__ void naive_gdn(Frame& F, const Args& A, int b, int h) {
    unsigned char* ws = F.ws;
    LAS float* vec = (LAS float*)F.lds;
    LAS float* ba = vec + 32 * 384;
    LAS float* part = ba + 64;
    LAS float* part2 = part + 512;
    LAS float* obuf = part2 + 512;
    const int tid = F.tid, e = tid & 127, dq = tid >> 7;
    const bf16_t* GQ = (const bf16_t*)(ws + WS_GQ); const bf16_t* GK = (const bf16_t*)(ws + WS_GK); const bf16_t* GV = (const bf16_t*)(ws + WS_GV);
    const float* GB = (const float*)(ws + WS_GB); const float* GG = (const float*)(ws + WS_GG);
    bf16_t* P = (bf16_t*)(ws + WS_C);
    const float* og = A.in[11];
    float S[32];
#pragma unroll
    for (int i = 0; i < 32; ++i) S[i] = 0.f;
    for (int c0 = 0; c0 < SEQ; c0 += 32) {
        __syncthreads();
        for (int i = tid; i < 32 * 384; i += NTHREADS) { const int tk = i / 384, r = i % 384; const size_t t = (size_t)b * SEQ + c0 + tk;
            const bf16_t* src = (r < 128) ? GQ : (r < 256) ? GK : GV;
            vec[i] = bf2f(src[t * 512 + h * 128 + (r & 127)]); }
        if (tid < 32) { const size_t t = (size_t)b * SEQ + c0 + tid; ba[tid * 2] = GB[t * 4 + h]; ba[tid * 2 + 1] = __expf(GG[t * 4 + h]); }
        __syncthreads();
        for (int tk = 0; tk < 32; ++tk) {
            const LAS float* qq = vec + tk * 384 + 32 * dq; const LAS float* kk = qq + 128; const float vv = vec[tk * 384 + 256 + e];
            const float beta = ba[tk * 2], alpha = ba[tk * 2 + 1];
            float p = 0.f;
#pragma unroll
            for (int i = 0; i < 32; ++i) p += S[i] * kk[i];
            part[dq * 128 + e] = p;
            __syncthreads();
            const float Sk = (part[e] + part[128 + e]) + (part[256 + e] + part[384 + e]);
            const float vn = beta * (vv - alpha * Sk);
            float po = 0.f;
#pragma unroll
            for (int i = 0; i < 32; ++i) { S[i] = alpha * S[i] + kk[i] * vn; po += S[i] * qq[i]; }
            part2[dq * 128 + e] = po;
            __syncthreads();
            if (dq == 0) obuf[tk * 128 + e] = (part2[e] + part2[128 + e]) + (part2[256 + e] + part2[384 + e]);
        }
        __syncthreads();
        { const int r = tid >> 4, cb = (tid & 15) * 8; const size_t t = (size_t)b * SEQ + c0 + r;
            float v[8]; float s = 0.f;
#pragma unroll
            for (int i = 0; i < 8; ++i) { v[i] = obuf[r * 128 + cb + i]; s += v[i] * v[i]; }
#pragma unroll
            for (int o = 1; o < 16; o <<= 1) s += __shfl_xor(s, o);
            const float rs = __builtin_amdgcn_rsqf(s * (1.0f / 128) + EPS);
            const u32x4 zw = *(const u32x4*)(P + t * PP + C_GZ + h * 128 + cb);
            float z[8] = {bflo(zw.x), bfhi(zw.x), bflo(zw.y), bfhi(zw.y), bflo(zw.z), bfhi(zw.z), bflo(zw.w), bfhi(zw.w)};
            float o[8];
#pragma unroll
            for (int i = 0; i < 8; ++i) o[i] = v[i] * rs * og[cb + i] * (z[i] * __builtin_amdgcn_rcpf(1.0f + __expf(-z[i])));
            u32x4 w; w.x = pk2(o[0], o[1]); w.y = pk2(o[2], o[3]); w.z = pk2(o[4], o[5]); w.w = pk2(o[6], o[7]);
            *(u32x4*)(P + t * PP + h * 128 + cb) = w; }
    }
}

__device__ __forceinline__ void naive_moba_query(Frame& F, const Args& A, int t, int h, LAS float* sc, LAS float* qs) {
    unsigned char* ws = F.ws; const int lane = F.lane;
    bf16_t* P = (bf16_t*)(ws + WS_C);
    const bf16_t* KNM = (const bf16_t*)(ws + WS_KNM); const float* KM = (const float*)(ws + WS_KMEAN);
    const int b = t >> 13, tl = t & (SEQ - 1), own = tl >> 8, bh = b * 4 + h;
    const float qraw = bf2f(P[(size_t)t * PP + C_MQ + h * 64 + lane]);
    const float qh = qraw * __builtin_amdgcn_rsqf(wave_sum(qraw * qraw) * (1.0f / 64) + EPS) * A.in[12][lane];
    qs[lane] = qh;
    float mygate = -INFINITY;
    for (int j = 0; j < own; ++j) { const float g = wave_sum(qh * KM[((size_t)bh * 32 + j) * 64 + lane]); if (lane == j) mygate = g; }
    const int nsel = own < 3 ? own : 3;
    int sel0 = 0, sel1 = 0, sel2 = 0;
#pragma unroll
    for (int r = 0; r < 3; ++r) {
        if (r < nsel) {
            const float mx = wave_max(mygate);
            const unsigned long long bal = __ballot(mygate == mx);
            const int idx = __builtin_ctzll(bal);
            if (r == 0) sel0 = idx; else if (r == 1) sel1 = idx; else sel2 = idx;
            if (lane == idx) mygate = -INFINITY;
        }
    }
#define SELBLK(bi) (((bi) >= nsel) ? own : ((bi) == 0 ? sel0 : ((bi) == 1 ? sel1 : sel2)))
    const float slope = exp2f(-2.0f * (float)(h + 1));
    asm volatile("s_waitcnt lgkmcnt(0)" ::: "memory");
    float m = -INFINITY;
    const int nblk = nsel + 1;
    for (int bi = 0; bi < nblk; ++bi) {
        const int blk = SELBLK(bi);
        for (int kc = 0; kc < 4; ++kc) {
            const int key = blk * 256 + kc * 64 + lane;
            const u32x4* kp = (const u32x4*)(KNM + ((size_t)bh * SEQ + key) * 64);
            float dot = 0.f;
#pragma unroll
            for (int c = 0; c < 8; ++c) { const u32x4 w = kp[c];
                dot += qs[c * 8 + 0] * bflo(w.x) + qs[c * 8 + 1] * bfhi(w.x) + qs[c * 8 + 2] * bflo(w.y) + qs[c * 8 + 3] * bfhi(w.y)
                     + qs[c * 8 + 4] * bflo(w.z) + qs[c * 8 + 5] * bfhi(w.z) + qs[c * 8 + 6] * bflo(w.w) + qs[c * 8 + 7] * bfhi(w.w); }
            float s = dot * 0.125f - slope * (float)(tl - key);
            if (key > tl) s = -INFINITY;
            sc[bi * 256 + kc * 64 + lane] = s; m = fmaxf(m, s);
        }
    }
    m = wave_max(m);
    float l = 0.f;
    for (int i = lane; i < nblk * 256; i += 64) { const float p = __expf(sc[i] - m); sc[i] = p; l += p; }
    l = wave_sum(l);
    asm volatile("s_waitcnt lgkmcnt(0)" ::: "memory");
    float o = 0.f;
    for (int bi = 0; bi < nblk; ++bi) {
        const int blk = SELBLK(bi);
        const bf16_t* vp = P + ((size_t)b * SEQ + blk * 256) * PP + C_MV + h * 64 + lane;
#pragma unroll 8
        for (int k = 0; k < 256; ++k) o += sc[bi * 256 + k] * bf2f(vp[(size_t)k * PP]);
    }
    P[(size_t)t * PP + 512 + h * 64 + lane] = (bf16_t)f2bf(o / l);
}
__device__ __forceinline__ void naive_mem_query(Frame& F, const Args& A, int t, int h, LAS float* sc, LAS float* qs) {
    unsigned char* ws = F.ws; const int lane = F.lane;
    bf16_t* P = (bf16_t*)(ws + WS_C);
    const float* KV = (const float*)(ws + WS_KVMEM);
    const int b = t >> 13;
    const float qraw = bf2f(P[(size_t)t * PP + C_CQ + h * 64 + lane]);
    const float qh = qraw * __builtin_amdgcn_rsqf(wave_sum(qraw * qraw) * (1.0f / 64) + EPS) * A.in[16][lane];
    qs[lane] = qh;
    const float* kg = A.in[17];
    asm volatile("s_waitcnt lgkmcnt(0)" ::: "memory");
    float m = -INFINITY;
    for (int kc = 0; kc < 4; ++kc) {
        const int key = kc * 64 + lane;
        const f32x4* kp = (const f32x4*)(KV + ((size_t)b * MEMT + key) * 512 + h * 64);
        float dot = 0.f, s2 = 0.f;
#pragma unroll
        for (int c = 0; c < 16; ++c) { const f32x4 w = kp[c];
            dot += qs[c * 4 + 0] * w[0] * kg[c * 4 + 0] + qs[c * 4 + 1] * w[1] * kg[c * 4 + 1] + qs[c * 4 + 2] * w[2] * kg[c * 4 + 2] + qs[c * 4 + 3] * w[3] * kg[c * 4 + 3];
            s2 += (w[0] * w[0] + w[1] * w[1]) + (w[2] * w[2] + w[3] * w[3]); }
        const float s = dot * __builtin_amdgcn_rsqf(s2 * (1.0f / 64) + EPS) * 0.125f;
        sc[key] = s; m = fmaxf(m, s);
    }
    m = wave_max(m);
    float l = 0.f;
    for (int i = lane; i < 256; i += 64) { const float p = __expf(sc[i] - m); sc[i] = p; l += p; }
    l = wave_sum(l);
    asm volatile("s_waitcnt lgkmcnt(0)" ::: "memory");
    float o = 0.f;
    const float* vp = KV + (size_t)b * MEMT * 512 + 256 + h * 64 + lane;
#pragma unroll 8
    for (int k = 0; k < 256; ++k) o += sc[k] * vp[(size_t)k * 512];
    P[(size_t)t * PP + 768 + h * 64 + lane] = (bf16_t)f2bf(o / l);
}

__device__ __forceinline__ void p4b_naive(Frame& F, const Args& A) {
    const int bx = blockIdx.x;
    if (bx < 16) { naive_gdn(F, A, bx >> 2, bx & 3); return; }
    LAS float* sc = (LAS float*)F.lds + F.wave * 1152;
    LAS float* qs = sc + 1024;
    const int w = bx - 16, NW = F.G - 16;
    const int NQ = T * 4 / 8;
    for (int it = w; it < 2 * NQ; it += NW) {
        const int kind = it >= NQ; const int q = (kind ? it - NQ : it) * 8 + F.wave;
        if (kind) naive_mem_query(F, A, q >> 2, q & 3, sc, qs); else naive_moba_query(F, A, q >> 2, q & 3, sc, qs);
    }
}

__global__ void __launch_bounds__(NTHREADS, 2) mk_fwd(Args args) {
    extern __shared__ __attribute__((aligned(16))) unsigned char lds_raw[];
    Frame F;
    F.lds = (LAS unsigned char*)lds_raw;
    F.tid = threadIdx.x; F.lane = F.tid & 63; F.wave = __builtin_amdgcn_readfirstlane(F.tid >> 6);
    F.G = gridDim.x; { const int bx = blockIdx.x; F.vcu = (F.G % 8 == 0) ? (bx % 8) * (F.G / 8) + bx / 8 : bx; }
    F.out = args.out; F.ws = args.ws;
    unsigned char* ws = args.ws;
    const int lo = args.ph_lo, hi = args.ph_hi;
#define IN(k) (lo <= (k) && (k) < hi)
#define SEAM(k) do { if (IN(k) && IN((k) + 1)) { cg::this_grid().sync(); } } while (0)
    float* ss = (float*)(ws + WS_SS);
    bf16_t* XB = (bf16_t*)(ws + WS_XB);
    bf16_t* PC = (bf16_t*)(ws + WS_C);

    if (IN(0)) { p0_prologue(F, args); }
    SEAM(0);
    if (IN(1)) {
        pg8::Gemm g{XB, (const bf16_t*)(ws + WS_WGU1), T, NGU, DM, DM}; pg8::StaticOrder S; S.init(T, NGU, F.G, (int)blockIdx.x);
        pg8::EpiSwiGLU E{PC, ss};
        pg8::gemm_phase<pg8::EpiSwiGLU, true>(F.lds, g, S, E);
    }
    SEAM(1);
    if (IN(2)) {
        pg8::Gemm g{PC, (const bf16_t*)(ws + WS_WD1), T, DM, FF, FF}; pg8::StaticOrder S; S.init(T, DM, F.G, (int)blockIdx.x);
        pg8::EpiResid E{args.in[0], F.out, XB, ss, 0.5f, 1};
        pg8::gemm_phase<pg8::EpiResid, true>(F.lds, g, S, E);
    }
    SEAM(2);
    if (IN(3)) {
        pg8::Gemm g{XB, (const bf16_t*)(ws + WS_WIN), T, NIN, DM, DM}; pg8::StaticOrder S; S.init(T, NIN, F.G, (int)blockIdx.x);
        pg8::EpiWin E{PC, (float*)(ws + WS_AB), ss};
        pg8::gemm_phase<pg8::EpiWin, true>(F.lds, g, S, E);
        {
            pg8::Gemm g2{(const bf16_t*)(ws + WS_MEMB), (const bf16_t*)(ws + WS_WKV), BATCH * MEMT, 512, DM, DM}; pg8::StaticOrder S2; S2.init(BATCH * MEMT, 512, 8, (int)blockIdx.x - (F.G - 8));
            pg8::EpiKV E2{(float*)(ws + WS_KVMEM), (const float*)(ws + WS_RSTDM)};
            pg8::gemm_phase<pg8::EpiKV, false>(F.lds, g2, S2, E2);
        }
    }
    SEAM(3);
    if (IN(4)) { p4a_naive(F, args); }
    SEAM(4);
    if (IN(5)) { p4b_naive(F, args); }
    SEAM(5);
    if (IN(6)) {
        pg8::Gemm g{PC, (const bf16_t*)(ws + WS_WOUT), T, DM, DM, PP}; pg8::StaticOrder S; S.init(T, DM, F.G, (int)blockIdx.x);
        pg8::EpiResid E{F.out, F.out, XB, ss, 1.0f, 1};
        pg8::gemm_phase<pg8::EpiResid, true>(F.lds, g, S, E);
    }
    SEAM(6);
    if (IN(7)) {
        pg8::Gemm g{XB, (const bf16_t*)(ws + WS_WGU2), T, NGU, DM, DM}; pg8::StaticOrder S; S.init(T, NGU, F.G, (int)blockIdx.x);
        pg8::EpiSwiGLU E{PC, ss};
        pg8::gemm_phase<pg8::EpiSwiGLU, true>(F.lds, g, S, E);
    }
    SEAM(7);
    if (IN(8)) {
        pg8::Gemm g{PC, (const bf16_t*)(ws + WS_WD2), T, DM, FF, FF}; pg8::StaticOrder S; S.init(T, DM, F.G, (int)blockIdx.x);
        pg8::EpiResid E{F.out, F.out, XB, ss, 0.5f, 0};
        pg8::gemm_phase<pg8::EpiResid, true>(F.lds, g, S, E);
    }
#undef IN
#undef SEAM
}

constexpr int N_PHASES = 9;
extern "C" void kernel_launch(void* const* d_in, const int* in_sizes, int n_in, void* d_out, int out_size, void* d_ws, size_t ws_size, hipStream_t stream) {
    static int grid = 0;
    if (grid == 0) {
        if (n_in != 23 || out_size != T * DM || ws_size < WS_END) { fprintf(stderr, "kernel_launch: unexpected shapes (n_in %d out %d ws %zu)\n", n_in, out_size, ws_size); grid = -1; return; }
        int dev = 0, cus = 0, per_cu = 0;
        (void)hipGetDevice(&dev); (void)hipDeviceGetAttribute(&cus, hipDeviceAttributeMultiprocessorCount, dev);
        (void)hipFuncSetAttribute((const void*)mk_fwd, hipFuncAttributeMaxDynamicSharedMemorySize, LDS_BYTES);
        (void)hipOccupancyMaxActiveBlocksPerMultiprocessor(&per_cu, (const void*)mk_fwd, NTHREADS, LDS_BYTES);
        (void)hipGetLastError();
        if (per_cu < 1) { fprintf(stderr, "kernel_launch: occupancy query says %d blocks/CU\n", per_cu); }
        grid = cus;
        if (grid != 256) fprintf(stderr, "kernel_launch: %d CUs (expected 256)\n", grid);
    }
    if (grid < 0) return;
    Args a{};
    for (int i = 0; i < 23; ++i) a.in[i] = (const float*)d_in[i];
    a.out = (float*)d_out; a.ws = (unsigned char*)d_ws;
    if (MK_N_LAUNCHES == 1) {
        a.ph_lo = 0; a.ph_hi = N_PHASES;
        void* kargs[] = {&a};
        hipError_t e = hipLaunchCooperativeKernel((const void*)mk_fwd, dim3(grid), dim3(NTHREADS), kargs, LDS_BYTES, stream);
        if (e != hipSuccess) fprintf(stderr, "cooperative launch failed: %s\n", hipGetErrorString(e));
    } else {
        for (int p = 0; p < N_PHASES; ++p) {
            a.ph_lo = p; a.ph_hi = p + 1;
            hipLaunchKernelGGL(mk_fwd, dim3(grid), dim3(NTHREADS), LDS_BYTES, stream, a);
        }
    }
}
```

```cpp
#include <hip/hip_runtime.h>
#include <hip/hip_cooperative_groups.h>
#include <cstdio>
#include <cstdint>
namespace cg = cooperative_groups;

#ifndef PROBE_DUP
#define PROBE_DUP -1
#endif
#ifndef NHELP
#define NHELP 1
#define HELP2 1
#endif
#ifndef USE_CG_SYNC
#define USE_CG_SYNC 0
#endif
#ifndef GDN_NAIVE
#define GDN_NAIVE 0
#endif
#ifndef ATTN_NAIVE
#define ATTN_NAIVE 0
#endif
#ifndef MK_N_LAUNCHES
#define MK_N_LAUNCHES 1
#endif

constexpr int BATCH = 4, SEQ = 8192, DM = 1024, T = BATCH * SEQ, FF = 2816, MEMT = 256;
constexpr int NGU = 2 * FF;
constexpr int NINR = 3072;
constexpr int NIN = 3328;
constexpr int PP = NINR;
constexpr float EPS = 1e-6f;
constexpr int C_GQ = 0, C_GK = 512, C_GV = 1024, C_GZ = 1536, C_MQ = 2048, C_MK = 2304, C_MV = 2560, C_CQ = 2816;

constexpr size_t MiB = 1u << 20;
constexpr size_t WS_CTL = 0, CTL_BYTES = 1 * MiB;
constexpr size_t WS_WGU1 = 1 * MiB, WS_WD1 = 12 * MiB, WS_WIN = 18 * MiB, WS_WOUT = 25 * MiB, WS_WGU2 = 27 * MiB, WS_WD2 = 38 * MiB, WS_WKV = 44 * MiB;
constexpr size_t WS_SS = 45 * MiB;
constexpr size_t WS_RSTDM = 47 * MiB;
constexpr size_t WS_AB = 48 * MiB;
constexpr size_t WS_KMEAN = 49 * MiB;
constexpr size_t WS_KVMEM = 50 * MiB;
constexpr size_t WS_MEMB = 52 * MiB;
constexpr size_t WS_GB = 54 * MiB;
constexpr size_t WS_GG = 54 * MiB + 512 * 1024;
constexpr size_t WS_XB = 56 * MiB;
constexpr size_t WS_KNM = 56 * MiB;
constexpr size_t WS_C = 120 * MiB;
constexpr size_t WS_G = 312 * MiB;
constexpr size_t WS_GQ = 312 * MiB, WS_GK = 344 * MiB, WS_GV = 376 * MiB;
constexpr size_t WS_END = 494 * MiB;

constexpr int NWAVES = 8, NTHREADS = 512;
constexpr int LDS_BYTES = 163840;

typedef unsigned short bf16_t;
typedef short bf16x8 __attribute__((ext_vector_type(8)));
typedef float f32x4 __attribute__((ext_vector_type(4)));
typedef float f32x2 __attribute__((ext_vector_type(2)));
typedef unsigned u32x4 __attribute__((ext_vector_type(4)));
typedef unsigned u32x2 __attribute__((ext_vector_type(2)));
#define LAS __attribute__((address_space(3)))
typedef float f32x16 __attribute__((ext_vector_type(16)));
typedef __bf16 bf16x2_t __attribute__((ext_vector_type(2)));
__device__ __forceinline__ unsigned cvtpk(float lo, float hi) { f32x2 v = {lo, hi}; bf16x2_t b = __builtin_convertvector(v, bf16x2_t); return __builtin_bit_cast(unsigned, b); }

__device__ __forceinline__ unsigned f2bf(float f) { unsigned u = __builtin_bit_cast(unsigned, f); return (u + 0x7fffu + ((u >> 16) & 1u)) >> 16; }
__device__ __forceinline__ unsigned pk2(float lo, float hi) { return f2bf(lo) | (f2bf(hi) << 16); }
__device__ __forceinline__ float bf2f(unsigned short h) { return __builtin_bit_cast(float, (unsigned)h << 16); }
__device__ __forceinline__ float bflo(unsigned w) { return __builtin_bit_cast(float, w << 16); }
__device__ __forceinline__ float bfhi(unsigned w) { return __builtin_bit_cast(float, w & 0xffff0000u); }
__device__ __forceinline__ float wave_sum(float v) {
#pragma unroll
    for (int o = 1; o < 64; o <<= 1) v += __shfl_xor(v, o);
    return v;
}
__device__ __forceinline__ float wave_max(float v) {
#pragma unroll
    for (int o = 1; o < 64; o <<= 1) v = fmaxf(v, __shfl_xor(v, o));
    return v;
}

namespace pg8 {
constexpr int BM = 256, BK = 64, HALF = 128, HTB = HALF * BK * 2, STAGE_BYTES = 8 * HTB, NXCD = 8, WGM = 4;
__host__ __device__ __forceinline__ int lds_byte(int r, int c) { const int st = (r >> 4) * 2 + (c >> 5), rr = r & 15, cc = c & 31, ob = rr * 64 + cc * 2; return st * 1024 + (ob ^ (((ob >> 9) & 1) << 5)); }
__host__ __device__ __forceinline__ void stage_rc(int b, int& R, int& C) { const int st = b / 1024, sb = b % 1024, swz = sb ^ (((sb >> 9) & 1) << 5); R = (st >> 1) * 16 + swz / 64; C = (st & 1) * 32 + (swz % 64) / 2; }
__host__ __device__ __forceinline__ int perm32(int rho) { const int n = rho >> 4, i = rho & 15; return 8 * (i >> 2) + 4 * n + (i & 3); }

struct Unit { int pm, pn; };
struct Gemm { const bf16_t* A; const bf16_t* Bt; int M, N, K, lda; };

struct StaticOrder {
    int nM, nN, nwg, G, c;
    __device__ void init(int M, int N, int G_, int c_) { nM = M / BM; nN = N / BM; nwg = nM * nN; G = G_; c = c_; }
    __device__ bool next(int i, Unit& u) const {
        const long L = (long)i * G + c; if (c < 0 || L >= nwg) return false;
        int wgid = (int)L; { const int q = nwg / NXCD, r = nwg % NXCD, xcd = wgid % NXCD, off = wgid / NXCD; wgid = (xcd < r ? xcd * (q + 1) : r * (q + 1) + (xcd - r) * q) + off; }
        const int nig = WGM * nN, gid = wgid / nig, fm = gid * WGM, gsz = (nM - fm) < WGM ? (nM - fm) : WGM;
        u.pm = fm + ((wgid % nig) % gsz); u.pn = (wgid % nig) / gsz; return true;
    }
};

__device__ __forceinline__ void rstd_table(LAS unsigned char* lds, const float* ss, const StaticOrder& S);
template <class Epi, bool ALIGN_EPI>
__device__ __forceinline__ void gemm_phase(LAS unsigned char* lds, const Gemm g, const StaticOrder& S, const Epi& E, const float* tab_ss = nullptr) {
    int tid = threadIdx.x; asm volatile("" : "+v"(tid));
    const int wid = __builtin_amdgcn_readfirstlane(tid >> 6), lane = tid & 63, wr = wid >> 2, wc = wid & 3, fr = lane & 15, fq = lane >> 4;
    const int K = g.K, nt = K / BK, lda = g.lda;
    unsigned voffA[2], voffB[2];
#pragma unroll
    for (int i = 0; i < 2; ++i) { int R, C; stage_rc(tid * 16 + i * 8192, R, C); const int Rb = (int)Epi::PERM == 2 ? (((R >> 5) << 6) + perm32(R & 31)) : (Epi::PERM ? ((R & ~31) + perm32(R & 31)) : R);
        voffA[i] = (unsigned)(R * lda + C) * 2u; voffB[i] = (unsigned)(Rb * K + C) * 2u; }
    const size_t kstep = (size_t)(BK * 2);
    const size_t hstepA = (size_t)HALF * lda * 2, hstepB = (size_t)((int)Epi::PERM == 2 ? 32 : HALF) * K * 2;
    const size_t tstepA = 2 * hstepA, tstepB = (size_t)BM * K * 2;
    const unsigned ldsw = (unsigned)wid * 1024u;
    const int aoff = lds_byte(wr * 64 + fr, fq * 8), boff = lds_byte(wc * 32 + fr, fq * 8);
#define PG8_SA(b, h) (((b) * 2 + (h)) * HTB)
#define PG8_SB(b, h) ((4 + (b) * 2 + (h)) * HTB)
#define PG8_STAGE(bufoff, gbase, voff) do { _Pragma("unroll") for (int _i = 0; _i < 2; ++_i) \
        __builtin_amdgcn_global_load_lds((const unsigned*)((const char*)(gbase) + (voff)[_i]), (LAS unsigned*)(lds + (bufoff) + ldsw + _i * 8192), 16, 0, 0); } while (0)
#define PG8_LDA(dst, b, h) do { _Pragma("unroll") for (int m = 0; m < 4; ++m) _Pragma("unroll") for (int k = 0; k < 2; ++k) dst[m][k] = *(const LAS bf16x8*)(lds + PG8_SA(b, h) + aoff + m * 2048 + k * 1024); } while (0)
#define PG8_LDB(dst, b, h) do { _Pragma("unroll") for (int n = 0; n < 2; ++n) _Pragma("unroll") for (int k = 0; k < 2; ++k) dst[n][k] = *(const LAS bf16x8*)(lds + PG8_SB(b, h) + boff + n * 2048 + k * 1024); } while (0)
#define PG8_MMA(ai, bj, At, Bt) do { __builtin_amdgcn_s_setprio(1); _Pragma("unroll") for (int m = 0; m < 4; ++m) _Pragma("unroll") for (int n = 0; n < 2; ++n) _Pragma("unroll") for (int k = 0; k < 2; ++k) \
        acc[ai][bj][m][n] = __builtin_amdgcn_mfma_f32_16x16x32_bf16(Bt[n][k], At[m][k], acc[ai][bj][m][n], 0, 0, 0); __builtin_amdgcn_s_setprio(0); } while (0)
#define PG8_WAIT_V(n) asm volatile("s_waitcnt vmcnt(" #n ")" ::: "memory")
#define PG8_WAIT_L(n) asm volatile("s_waitcnt lgkmcnt(" #n ")" ::: "memory")
#define PG8_BAR __builtin_amdgcn_s_barrier()
#define PG8_SCHED __builtin_amdgcn_sched_barrier(0)
    Unit cur, nxt; int ui = 0;
    if (!S.next(0, cur)) return;
    f32x4 acc[2][2][4][2];
#pragma unroll
    for (int a = 0; a < 2; ++a)
#pragma unroll
        for (int b = 0; b < 2; ++b)
#pragma unroll
            for (int m = 0; m < 4; ++m)
#pragma unroll
                for (int n = 0; n < 2; ++n) acc[a][b][m][n] = (f32x4){0.f, 0.f, 0.f, 0.f};
    bf16x8 At[4][2], B0[2][2], B1[2][2];
    const char* cA = (const char*)g.A + (size_t)cur.pm * tstepA; const char* cB = (const char*)g.Bt + (size_t)cur.pn * tstepB;
    PG8_STAGE(PG8_SB(0, 0), cB, voffB); PG8_STAGE(PG8_SB(0, 1), cB + hstepB, voffB); PG8_STAGE(PG8_SA(0, 0), cA, voffA); PG8_STAGE(PG8_SA(0, 1), cA + hstepA, voffA);
    if (tab_ss) rstd_table(lds, tab_ss, S);
    if (wr == 1) PG8_BAR;
    PG8_WAIT_V(2); PG8_BAR;
    PG8_STAGE(PG8_SB(1, 0), cB + kstep, voffB); PG8_STAGE(PG8_SA(1, 0), cA + kstep, voffA); PG8_STAGE(PG8_SB(1, 1), cB + hstepB + kstep, voffB);
    PG8_WAIT_V(6); PG8_BAR;
    for (;;) {
        const bool has_next = S.next(ui + 1, nxt);
        const char* nA = has_next ? (const char*)g.A + (size_t)nxt.pm * tstepA : cA; const char* nB = has_next ? (const char*)g.Bt + (size_t)nxt.pn * tstepB : cB;
        for (int t = 0; t < nt; t += 2) {
            const bool last = (t == nt - 2);
            const char* a1 = cA + (size_t)(t + 1) * kstep;
            const char* a2 = last ? nA : cA + (size_t)(t + 2) * kstep; const char* b2 = last ? nB : cB + (size_t)(t + 2) * kstep;
            const char* a3 = a2 + kstep; const char* b3 = b2 + kstep;
            PG8_LDB(B0, 0, 0); PG8_LDB(B1, 0, 1); PG8_SCHED; PG8_LDA(At, 0, 0); PG8_STAGE(PG8_SA(1, 1), a1 + hstepA, voffA);
            PG8_WAIT_V(8); PG8_WAIT_L(0); PG8_BAR; PG8_MMA(0, 0, At, B0); PG8_MMA(0, 1, At, B1); PG8_BAR; PG8_SCHED;
            PG8_LDA(At, 0, 1); PG8_STAGE(PG8_SB(0, 0), b2, voffB); PG8_STAGE(PG8_SB(0, 1), b2 + hstepB, voffB); PG8_STAGE(PG8_SA(0, 0), a2, voffA);
            PG8_WAIT_V(8); PG8_WAIT_L(0); PG8_BAR; PG8_MMA(1, 0, At, B0); PG8_MMA(1, 1, At, B1); PG8_BAR; PG8_SCHED;
            PG8_LDB(B0, 1, 0); PG8_LDB(B1, 1, 1); PG8_SCHED; PG8_LDA(At, 1, 0); PG8_STAGE(PG8_SA(0, 1), a2 + hstepA, voffA);
            PG8_WAIT_V(8); PG8_WAIT_L(0); PG8_BAR; PG8_MMA(0, 0, At, B0); PG8_MMA(0, 1, At, B1); PG8_BAR; PG8_SCHED;
            PG8_LDA(At, 1, 1); PG8_STAGE(PG8_SB(1, 0), b3, voffB); PG8_STAGE(PG8_SB(1, 1), b3 + hstepB, voffB); PG8_STAGE(PG8_SA(1, 0), a3, voffA);
            PG8_WAIT_V(8); PG8_WAIT_L(0); PG8_BAR; PG8_MMA(1, 0, At, B0); PG8_MMA(1, 1, At, B1); PG8_BAR; PG8_SCHED;
        }
        if constexpr (ALIGN_EPI) { if (wr == 0) PG8_BAR; }
        E(acc, cur, wr, wc, fr, fq, ui, lds);
        if (!has_next) break;
#pragma unroll
        for (int a = 0; a < 2; ++a)
#pragma unroll
            for (int b = 0; b < 2; ++b)
#pragma unroll
                for (int m = 0; m < 4; ++m)
#pragma unroll
                    for (int n = 0; n < 2; ++n) acc[a][b][m][n] = (f32x4){0.f, 0.f, 0.f, 0.f};
        cur = nxt; cA = nA; cB = nB; ++ui;
        if constexpr (ALIGN_EPI) { if (wr == 1) PG8_BAR; }
    }
    PG8_WAIT_V(0);
    if constexpr (!ALIGN_EPI) { if (wr == 0) PG8_BAR; }
    PG8_BAR;
#undef PG8_SA
#undef PG8_SB
#undef PG8_STAGE
#undef PG8_LDA
#undef PG8_LDB
#undef PG8_MMA
#undef PG8_WAIT_V
#undef PG8_WAIT_L
#undef PG8_BAR
#undef PG8_SCHED
}

__device__ __forceinline__ float row_rstd(const float* ss, int row) {
    const f32x4* p = (const f32x4*)(ss + (size_t)row * 16);
    const f32x4 a = p[0], b = p[1], c = p[2], d = p[3];
    const float s = ((a[0] + a[1]) + (a[2] + a[3])) + ((b[0] + b[1]) + (b[2] + b[3])) + ((c[0] + c[1]) + (c[2] + c[3])) + ((d[0] + d[1]) + (d[2] + d[3]));
    return __builtin_amdgcn_rsqf(s * (1.0f / DM) + EPS);
}
constexpr int RSTD_TAB_OFF = 131072;
__device__ __forceinline__ void rows_rstd8(LAS unsigned char* lds, int ui, int rl0  , float (&rs)[2][4]) {
    const LAS float* tab = (const LAS float*)(lds + RSTD_TAB_OFF) + ui * 256 + rl0;
#pragma unroll
    for (int ai = 0; ai < 2; ++ai)
#pragma unroll
        for (int m = 0; m < 4; ++m) rs[ai][m] = tab[ai * HALF + m * 16];
}
__device__ __forceinline__ float silu_mul(float g, float u) { return g * __builtin_amdgcn_rcpf(1.0f + __expf(-g)) * u; }

struct EpiSwiGLU {
    static constexpr bool PERM = true;
    bf16_t* H; const float* ss;
    __device__ __forceinline__ void operator()(const f32x4 (&acc)[2][2][4][2], const Unit& u, int wr, int wc, int fr, int fq, int ui, LAS unsigned char* lds) const {
        float rs8[2][4]; rows_rstd8(lds, ui, wr * 64 + fr, rs8);
#pragma unroll
        for (int ai = 0; ai < 2; ++ai)
#pragma unroll
            for (int m = 0; m < 4; ++m) {
                const int row = u.pm * BM + ai * HALF + wr * 64 + m * 16 + fr;
                const float rs = rs8[ai][m];
                u32x4 w;
                { const f32x4 g = acc[ai][0][m][0] * rs, up = acc[ai][1][m][0] * rs; w.x = cvtpk(silu_mul(g[0], up[0]), silu_mul(g[1], up[1])); w.y = cvtpk(silu_mul(g[2], up[2]), silu_mul(g[3], up[3])); }
                { const f32x4 g = acc[ai][0][m][1] * rs, up = acc[ai][1][m][1] * rs; w.z = cvtpk(silu_mul(g[0], up[0]), silu_mul(g[1], up[1])); w.w = cvtpk(silu_mul(g[2], up[2]), silu_mul(g[3], up[3])); }
                *(u32x4*)(H + (size_t)row * FF + u.pn * 128 + wc * 32 + 8 * fq) = w;
            }
    }
};
template <int MODE> struct EpiResid {
    static constexpr int PERM = 2;
    const float* xin; float* out; bf16_t* xb; float* ss; float scale;
    __device__ __forceinline__ void operator()(const f32x4 (&acc)[2][2][4][2], const Unit& u, int wr, int wc, int fr, int fq, int ui, LAS unsigned char* lds) const {
        const size_t base = (size_t)(u.pm * BM + wr * 64 + fr) * DM + u.pn * BM + wc * 64 + 8 * fq;
        u32x4 rb[2][4][2];
#pragma unroll
        for (int ai = 0; ai < 2; ++ai)
#pragma unroll
            for (int m = 0; m < 4; ++m)
#pragma unroll
                for (int bj = 0; bj < 2; ++bj) rb[ai][m][bj] = *(const u32x4*)(xb + base + (size_t)(ai * HALF + m * 16) * DM + bj * 32);
#pragma unroll
        for (int ai = 0; ai < 2; ++ai)
#pragma unroll
            for (int m = 0; m < 4; ++m) {
                const size_t off = base + (size_t)(ai * HALF + m * 16) * DM;
                float s = 0.f;
#pragma unroll
                for (int bj = 0; bj < 2; ++bj) {
                    const u32x4 w = rb[ai][m][bj];
                    const f32x4 v0 = (f32x4){bflo(w.x), bfhi(w.x), bflo(w.y), bfhi(w.y)} + acc[ai][bj][m][0] * scale;
                    const f32x4 v1 = (f32x4){bflo(w.z), bfhi(w.z), bflo(w.w), bfhi(w.w)} + acc[ai][bj][m][1] * scale;
                    if (MODE == 2) { *(f32x4*)(out + off + bj * 32) = v0; *(f32x4*)(out + off + bj * 32 + 4) = v1; }
                    else { u32x4 o; o.x = cvtpk(v0[0], v0[1]); o.y = cvtpk(v0[2], v0[3]); o.z = cvtpk(v1[0], v1[1]); o.w = cvtpk(v1[2], v1[3]);
                        *(u32x4*)(xb + off + bj * 32) = o;
                        const float r0 = bflo(o.x), r1 = bfhi(o.x), r2 = bflo(o.y), r3 = bfhi(o.y), r4 = bflo(o.z), r5 = bfhi(o.z), r6 = bflo(o.w), r7 = bfhi(o.w);
                        s += ((r0 * r0 + r1 * r1) + (r2 * r2 + r3 * r3)) + ((r4 * r4 + r5 * r5) + (r6 * r6 + r7 * r7)); }
                }
                if (MODE != 2) { s += __shfl_xor(s, 16); s += __shfl_xor(s, 32); if (fq == 0) ss[(size_t)(u.pm * BM + ai * HALF + wr * 64 + m * 16 + fr) * 16 + u.pn * 4 + wc] = s; }
            }
    }
};
struct EpiWin {
    static constexpr int PERM = 2;
    bf16_t* P; float* AB; const float* ss;
    __device__ __forceinline__ void operator()(const f32x4 (&acc)[2][2][4][2], const Unit& u, int wr, int wc, int fr, int fq, int ui, LAS unsigned char* lds) const {
        float rs8[2][4]; rows_rstd8(lds, ui, wr * 64 + fr, rs8);
#pragma unroll
        for (int ai = 0; ai < 2; ++ai)
#pragma unroll
            for (int m = 0; m < 4; ++m) {
                const int row = u.pm * BM + ai * HALF + wr * 64 + m * 16 + fr;
                const float rs = rs8[ai][m];
                if (u.pn < 12) {
#pragma unroll
                    for (int bj = 0; bj < 2; ++bj) {
                        const f32x4 v0 = acc[ai][bj][m][0] * rs, v1 = acc[ai][bj][m][1] * rs;
                        u32x4 w; w.x = cvtpk(v0[0], v0[1]); w.y = cvtpk(v0[2], v0[3]); w.z = cvtpk(v1[0], v1[1]); w.w = cvtpk(v1[2], v1[3]);
                        *(u32x4*)(P + (size_t)row * PP + u.pn * BM + wc * 64 + bj * 32 + 8 * fq) = w;
                    }
                } else if (wc == 0 && fq == 0) {
                    *(f32x4*)(AB + (size_t)row * 8) = acc[ai][0][m][0] * rs;
                    *(f32x4*)(AB + (size_t)row * 8 + 4) = acc[ai][0][m][1] * rs;
                }
            }
    }
};
struct EpiNullP { static constexpr bool PERM = true; float* sink;
    __device__ __forceinline__ void operator()(const f32x4 (&acc)[2][2][4][2], const Unit& u, int wr, int wc, int fr, int fq, int ui, LAS unsigned char* lds) const {
        float s = 0.f;
#pragma unroll
        for (int ai = 0; ai < 2; ++ai)
#pragma unroll
            for (int bj = 0; bj < 2; ++bj)
#pragma unroll
                for (int m = 0; m < 4; ++m)
#pragma unroll
                    for (int n = 0; n < 2; ++n) s += acc[ai][bj][m][n][0];
        if (s == 123456.789f) sink[0] = s;
    } };
struct EpiNullN { static constexpr bool PERM = false; float* sink;
    __device__ __forceinline__ void operator()(const f32x4 (&acc)[2][2][4][2], const Unit& u, int wr, int wc, int fr, int fq, int ui, LAS unsigned char* lds) const {
        float s = 0.f;
#pragma unroll
        for (int ai = 0; ai < 2; ++ai)
#pragma unroll
            for (int bj = 0; bj < 2; ++bj)
#pragma unroll
                for (int m = 0; m < 4; ++m)
#pragma unroll
                    for (int n = 0; n < 2; ++n) s += acc[ai][bj][m][n][0];
        if (s == 123456.789f) sink[0] = s;
    } };
struct EpiKV {
    static constexpr bool PERM = false;
    float* O; const float* rstdm;
    __device__ __forceinline__ void operator()(const f32x4 (&acc)[2][2][4][2], const Unit& u, int wr, int wc, int fr, int fq, int ui, LAS unsigned char* lds) const {
#pragma unroll
        for (int ai = 0; ai < 2; ++ai)
#pragma unroll
            for (int m = 0; m < 4; ++m) {
                const int row = u.pm * BM + ai * HALF + wr * 64 + m * 16 + fr;
                const float rs = rstdm[row];
                const size_t off = (size_t)row * 512 + u.pn * BM + wc * 32 + 4 * fq;
#pragma unroll
                for (int bj = 0; bj < 2; ++bj)
#pragma unroll
                    for (int n = 0; n < 2; ++n) *(f32x4*)(O + off + bj * HALF + n * 16) = acc[ai][bj][m][n] * rs;
            }
    }
};
__device__ __forceinline__ void rstd_table(LAS unsigned char* lds, const float* ss, const StaticOrder& S) {
    LAS float* tab = (LAS float*)(lds + RSTD_TAB_OFF);
    const int tid = threadIdx.x, half = tid >> 8, rl = tid & 255;
    for (int i = half; i < 12; i += 2) { Unit u; if (!S.next(i, u)) break; tab[i * 256 + rl] = row_rstd(ss, u.pm * BM + rl); }
    __syncthreads();
}
}


#define XB_TMO      128
#define XB_XCNT(j)  (256  + 64 * (j))
#define XB_XSUB(j)  (1280 + 64 * (j))
#define XB_XGEN(j)  (2304 + 64 * (j))
#define XB_TOP      3328
#define XB_TOPGEN   3392
#define XCD_BAR_WORDS 3456
#define XB_SPIN_CAP (1u << 18)
constexpr int CW_BAR = 1024;
constexpr int LDS_ST_OFF = 147440;
__device__ __forceinline__ unsigned xb_ld(unsigned* p)              { return __hip_atomic_load(p, __ATOMIC_RELAXED, __HIP_MEMORY_SCOPE_AGENT); }
__device__ __forceinline__ unsigned xb_add(unsigned* p, unsigned v) { return __hip_atomic_fetch_add(p, v, __ATOMIC_RELAXED, __HIP_MEMORY_SCOPE_AGENT); }
__device__ __forceinline__ unsigned xb_xcc_id() { return (unsigned)__builtin_amdgcn_s_getreg((3 << 11) | 20) & 0xFu; }
#define XB_SPIN(cond, bar) do { unsigned _sp = 0; while (cond) { __builtin_amdgcn_s_sleep(1); \
    if ((++_sp & 255u) == 0u) { if (xb_ld(&(bar)[XB_TMO])) break; if (_sp > XB_SPIN_CAP) { atomicAdd(&(bar)[XB_TMO], 1u); break; } } } } while (0)
struct XcdBarrier { unsigned* bar; unsigned x; volatile LAS unsigned* st; };
__device__ __forceinline__ XcdBarrier xcd_barrier_post(unsigned* bar, volatile LAS unsigned* st) {
    XcdBarrier b; b.bar = bar; b.x = xb_xcc_id(); b.st = st;
    if (threadIdx.x == 0) (void)xb_add(&bar[XB_XCNT(b.x)], 1u);
    return b;
}
__device__ __forceinline__ void xcd_barrier_complete(unsigned* bar, unsigned x, unsigned& nloc, unsigned& nx) {
    const unsigned G = gridDim.x * gridDim.y * gridDim.z;
    unsigned sum, cnt, mine, sp = 0u;
    for (;;) {
        sum = 0u; cnt = 0u; mine = 0u;
#pragma unroll
        for (unsigned j = 0; j < 16; ++j) { const unsigned c = xb_ld(&bar[XB_XCNT(j)]); sum += c; cnt += (c > 0u) ? 1u : 0u; mine = (j == x) ? c : mine; }
        if (sum == G) break;
        __builtin_amdgcn_s_sleep(1);
        if ((++sp & 255u) == 0u) { if (xb_ld(&bar[XB_TMO])) break; if (sp > XB_SPIN_CAP) { atomicAdd(&bar[XB_TMO], 1u); break; } }
    }
    nloc = mine > 0u ? mine : 1u; nx = cnt > 0u ? cnt : 1u;
}
__device__ __forceinline__ void xcd_barrier(const XcdBarrier& b) {
    asm volatile("s_waitcnt vmcnt(0)" ::: "memory");
    __syncthreads();
    if (threadIdx.x == 0) {
        unsigned* bar = b.bar;
        __builtin_amdgcn_s_waitcnt(0);
        unsigned nloc = b.st[0], nx = b.st[1];
        if (nloc == 0u) { xcd_barrier_complete(bar, b.x, nloc, nx); b.st[0] = nloc; b.st[1] = nx; }
        const unsigned old = xb_add(&bar[XB_XSUB(b.x)], 1u);
        const unsigned gen = old / nloc;
        if (old + 1u == (gen + 1u) * nloc) {
            __builtin_amdgcn_fence(__ATOMIC_RELEASE, "agent");
            asm volatile("s_waitcnt vmcnt(0)" ::: "memory");
            asm volatile("buffer_inv sc1" ::: "memory");
            const unsigned og = xb_add(&bar[XB_TOP], 1u);
            const unsigned tg = og / nx;
            if (og + 1u == (tg + 1u) * nx) xb_add(&bar[XB_TOPGEN], 1u);
            else XB_SPIN(xb_ld(&bar[XB_TOPGEN]) == tg, bar);
            asm volatile("s_waitcnt vmcnt(0)" ::: "memory");
            xb_add(&bar[XB_XGEN(b.x)], 1u);
            asm volatile("s_waitcnt vmcnt(0)" ::: "memory");
        } else {
            asm volatile("buffer_inv sc1" ::: "memory");
            XB_SPIN(xb_ld(&bar[XB_XGEN(b.x)]) == gen, bar);
            asm volatile("s_waitcnt vmcnt(0)" ::: "memory");
        }
    }
    __syncthreads();
}

struct Args;
struct Frame {
    LAS unsigned char* lds;
    int tid, lane, wave, vcu, G;
    float* out; unsigned char* ws;
};
struct Args { const float* in[23]; float* out; unsigned char* ws; int ph_lo, ph_hi; };

template <class SrcCol>
__device__ __forceinline__ void tr_item(const float* W, int ldw, int k0, int d0, SrcCol src, const float* gain, bf16_t* WT, int Kdim, LAS float* scr, int lane) {
    const int dl = lane & 31, sc = src(d0 + dl);
#pragma unroll 8
    for (int i = 0; i < 32; ++i) { const int kk = 2 * i + (lane >> 5);
        float v = 0.f; if (sc >= 0) { v = W[(size_t)(k0 + kk) * ldw + sc]; if (gain) v *= gain[k0 + kk]; }
        scr[kk * 33 + dl] = v; }
    asm volatile("s_waitcnt lgkmcnt(0)" ::: "memory");
    const int c = lane & 7;
#pragma unroll
    for (int j = 0; j < 4; ++j) { const int n = (lane >> 3) + 8 * j; const LAS float* s = scr + (8 * c) * 33 + n;
        u32x4 o; o.x = pk2(s[0 * 33], s[1 * 33]); o.y = pk2(s[2 * 33], s[3 * 33]); o.z = pk2(s[4 * 33], s[5 * 33]); o.w = pk2(s[6 * 33], s[7 * 33]);
        *(u32x4*)(WT + (size_t)(d0 + n) * Kdim + k0 + 8 * c) = o; }
    asm volatile("s_waitcnt lgkmcnt(0)" ::: "memory");
}
__device__ __forceinline__ void tr_item64(const float* W, int ldw, int k0, int d0, int sc0, const float* gain, bf16_t* WT, int Kdim, LAS float* scr, int lane) {
    const int n4 = (lane & 15) * 4;
#pragma unroll 8
    for (int i = 0; i < 16; ++i) { const int kk = 4 * i + (lane >> 4);
        f32x4 v = *(const f32x4*)(W + (size_t)(k0 + kk) * ldw + sc0 + n4); if (gain) v = v * gain[k0 + kk];
        scr[kk * 65 + n4] = v[0]; scr[kk * 65 + n4 + 1] = v[1]; scr[kk * 65 + n4 + 2] = v[2]; scr[kk * 65 + n4 + 3] = v[3]; }
    asm volatile("s_waitcnt lgkmcnt(0)" ::: "memory");
    const int c = lane & 7;
#pragma unroll
    for (int j = 0; j < 8; ++j) { const int n = (lane >> 3) + 8 * j; const LAS float* sp = scr + (8 * c) * 65 + n;
        u32x4 o; o.x = cvtpk(sp[0 * 65], sp[1 * 65]); o.y = cvtpk(sp[2 * 65], sp[3 * 65]); o.z = cvtpk(sp[4 * 65], sp[5 * 65]); o.w = cvtpk(sp[6 * 65], sp[7 * 65]);
        *(u32x4*)(WT + (size_t)(d0 + n) * Kdim + k0 + 8 * c) = o; }
    asm volatile("s_waitcnt lgkmcnt(0)" ::: "memory");
}
struct SrcGU { int up; __device__ int operator()(int d) const { const int pn = d >> 8, r = d & 255; return ((r >> 7) == up) ? pn * 128 + (r & 127) : -2; } };
struct SrcId { __device__ int operator()(int d) const { return d; } };
struct SrcWin { __device__ int operator()(int d) const { if (d < 2048) return d; if (d < 3072) return d + 8; if (d < 3080) return d - 3072 + 2048; return -1; } };

__device__ __forceinline__ float row_to_bf16(const float* xrow, bf16_t* orow, int lane) {
    const f32x4* xr = (const f32x4*)xrow + lane; f32x4 v[4]; float s = 0.f;
#pragma unroll
    for (int j = 0; j < 4; ++j) { v[j] = xr[64 * j]; s += (v[j][0] * v[j][0] + v[j][1] * v[j][1]) + (v[j][2] * v[j][2] + v[j][3] * v[j][3]); }
    u32x2* o8 = (u32x2*)orow + lane;
#pragma unroll
    for (int j = 0; j < 4; ++j) { u32x2 w; w.x = pk2(v[j][0], v[j][1]); w.y = pk2(v[j][2], v[j][3]); o8[64 * j] = w; }
    return wave_sum(s);
}

template <int PART>
__device__ __forceinline__ void tr_weights(Frame& F, const Args& A, int gw, int NGW) {
    LAS float* scr = (LAS float*)(F.lds + F.wave * 16640);
    const int lane = F.lane;
    unsigned char* ws = F.ws;
    constexpr int I_GU = (DM / 64) * (NGU / 64);
    constexpr int I_D = (FF / 64) * (DM / 64);
    constexpr int I_IN = (DM / 64) * (NINR / 64);
    constexpr int I_AB = (DM / 64) * 8;
    constexpr int I_O = (DM / 64) * (DM / 64);
    constexpr int I_KV = (DM / 64) * (512 / 64);
    constexpr int NITEMS = PART ? (I_GU + I_D + I_O) : (I_GU + I_D + I_IN + I_AB + I_KV);
    constexpr int l = PART;
    for (int it = gw; it < NITEMS; it += NGW) {
        int r = it;
        if (r < I_GU) { const int kb = r / (NGU / 64), db = r % (NGU / 64); const int d0 = db * 64; const int up = (d0 >> 7) & 1;
            const float* W = A.in[(l ? 20 : 3) + up]; const float* gain = A.in[l ? 19 : 2];
            tr_item64(W, FF, kb * 64, d0, (d0 >> 8) * 128 + (d0 & 127), gain, (bf16_t*)(ws + (l ? WS_WGU2 : WS_WGU1)), DM, scr, lane); continue; }
        r -= I_GU;
        if (r < I_D) { const int kb = r / (DM / 64), db = r % (DM / 64);
            tr_item64(A.in[l ? 22 : 5], DM, kb * 64, db * 64, db * 64, nullptr, (bf16_t*)(ws + (l ? WS_WD2 : WS_WD1)), FF, scr, lane); continue; }
        r -= I_D;
        if (PART) { const int kb = r / (DM / 64), db = r % (DM / 64);
            tr_item64(A.in[18], DM, kb * 64, db * 64, db * 64, nullptr, (bf16_t*)(ws + WS_WOUT), DM, scr, lane); continue; }
        if (r < I_IN) { const int kb = r / (NINR / 64), db = r % (NINR / 64); const int d0 = db * 64;
            tr_item64(A.in[7], 3080, kb * 64, d0, d0 < 2048 ? d0 : d0 + 8, A.in[6], (bf16_t*)(ws + WS_WIN), DM, scr, lane); continue; }
        r -= I_IN;
        if (r < I_AB) { const int kb = r / 8, db = r % 8;
            tr_item(A.in[7], 3080, kb * 64, NINR + db * 32, SrcWin{}, A.in[6], (bf16_t*)(ws + WS_WIN), DM, scr, lane); continue; }
        r -= I_AB;
        { const int kb = r / 8, db = r % 8;
            tr_item64(A.in[15], 512, kb * 64, db * 64, db * 64, A.in[14], (bf16_t*)(ws + WS_WKV), DM, scr, lane); }
    }
}

__device__ __forceinline__ void p0_prologue(Frame& F, const Args& A) {
    const int gw = F.vcu * NWAVES + F.wave, NGW = F.G * NWAVES, lane = F.lane;
    unsigned char* ws = F.ws;
    tr_weights<0>(F, A, gw, NGW);
    float* ss = (float*)(ws + WS_SS);
    for (int m = gw; m < T; m += NGW) {
        const float s = row_to_bf16(A.in[0] + (size_t)m * DM, (bf16_t*)(ws + WS_XB) + (size_t)m * DM, lane);
        if (lane < 16) ss[(size_t)m * 16 + lane] = (lane == 0) ? s : 0.f;
    }
    for (int m = gw; m < BATCH * MEMT; m += NGW) {
        const float s = row_to_bf16(A.in[1] + (size_t)m * DM, (bf16_t*)(ws + WS_MEMB) + (size_t)m * DM, lane);
        if (lane == 0) ((float*)(ws + WS_RSTDM))[m] = __builtin_amdgcn_rsqf(s * (1.0f / DM) + EPS);
    }
}

__device__ __forceinline__ void p4a_naive(Frame& F, const Args& A) {
    const int gw = F.vcu * NWAVES + F.wave, NGW = F.G * NWAVES, lane = F.lane;
    unsigned char* ws = F.ws;
    const bf16_t* P = (const bf16_t*)(ws + WS_C);
    const float* convw = A.in[8];
    const int h = lane >> 4;
#if GDN_NAIVE
    float cw[3][4][8];
#pragma unroll
    for (int s = 0; s < 3; ++s)
#pragma unroll
        for (int j = 0; j < 4; ++j)
#pragma unroll
            for (int i = 0; i < 8; ++i) cw[s][j][i] = convw[j * 1536 + s * 512 + lane * 8 + i];
    const float alog = A.in[9][h], dtb = A.in[10][h];
    const float* AB = (const float*)(ws + WS_AB);
    for (int t = gw; t < T; t += NGW) {
        const int tl = t & (SEQ - 1);
        float y[3][8];
#pragma unroll
        for (int s = 0; s < 3; ++s) {
#pragma unroll
            for (int i = 0; i < 8; ++i) y[s][i] = 0.f;
#pragma unroll
            for (int j = 0; j < 4; ++j) { const int tt = tl - 3 + j;
                if (tt >= 0) { const u32x4 w = *(const u32x4*)(P + (size_t)(t - 3 + j) * PP + s * 512 + lane * 8);
                    y[s][0] += cw[s][j][0] * bflo(w.x); y[s][1] += cw[s][j][1] * bfhi(w.x); y[s][2] += cw[s][j][2] * bflo(w.y); y[s][3] += cw[s][j][3] * bfhi(w.y);
                    y[s][4] += cw[s][j][4] * bflo(w.z); y[s][5] += cw[s][j][5] * bfhi(w.z); y[s][6] += cw[s][j][6] * bflo(w.w); y[s][7] += cw[s][j][7] * bfhi(w.w); } }
#pragma unroll
            for (int i = 0; i < 8; ++i) { const float v = y[s][i]; y[s][i] = v * __builtin_amdgcn_rcpf(1.0f + __expf(-v)); }
        }
        float sq = 0.f, sk = 0.f;
#pragma unroll
        for (int i = 0; i < 8; ++i) { sq += y[0][i] * y[0][i]; sk += y[1][i] * y[1][i]; }
#pragma unroll
        for (int o = 1; o < 16; o <<= 1) { sq += __shfl_xor(sq, o); sk += __shfl_xor(sk, o); }
        const float rq = __builtin_amdgcn_rsqf(sq + EPS) * 0.08838834764831845f, rk = __builtin_amdgcn_rsqf(sk + EPS);
        u32x4 wq, wk, wv;
        wq.x = pk2(y[0][0] * rq, y[0][1] * rq); wq.y = pk2(y[0][2] * rq, y[0][3] * rq); wq.z = pk2(y[0][4] * rq, y[0][5] * rq); wq.w = pk2(y[0][6] * rq, y[0][7] * rq);
        wk.x = pk2(y[1][0] * rk, y[1][1] * rk); wk.y = pk2(y[1][2] * rk, y[1][3] * rk); wk.z = pk2(y[1][4] * rk, y[1][5] * rk); wk.w = pk2(y[1][6] * rk, y[1][7] * rk);
        wv.x = pk2(y[2][0], y[2][1]); wv.y = pk2(y[2][2], y[2][3]); wv.z = pk2(y[2][4], y[2][5]); wv.w = pk2(y[2][6], y[2][7]);
        *(u32x4*)((bf16_t*)(ws + WS_GQ) + (size_t)t * 512 + lane * 8) = wq;
        *(u32x4*)((bf16_t*)(ws + WS_GK) + (size_t)t * 512 + lane * 8) = wk;
        *(u32x4*)((bf16_t*)(ws + WS_GV) + (size_t)t * 512 + lane * 8) = wv;
        if ((lane & 15) == 0) {
            const float a = AB[(size_t)t * 8 + h], b = AB[(size_t)t * 8 + 4 + h];
            const float xx = a + dtb; const float sp = (xx > 20.f) ? xx : log1pf(__expf(xx));
            ((float*)(ws + WS_GG))[(size_t)t * 4 + h] = -__expf(alog) * sp;
            ((float*)(ws + WS_GB))[(size_t)t * 4 + h] = 1.0f / (1.0f + __expf(-b));
        }
    }
#endif
    {
        const float* kg = A.in[13]; const int d0 = (lane & 15) * 4;
        const float g0 = kg[d0], g1 = kg[d0 + 1], g2 = kg[d0 + 2], g3 = kg[d0 + 3];
        bf16_t* KNM = (bf16_t*)(ws + WS_KNM);
        for (int t = gw; t < T; t += NGW) {
            const int b = t >> 13, tl = t & (SEQ - 1);
            const u32x2 w = *(const u32x2*)(P + (size_t)t * PP + C_MK + lane * 4);
            float v0 = bflo(w.x), v1 = bfhi(w.x), v2 = bflo(w.y), v3 = bfhi(w.y);
            float s = v0 * v0 + v1 * v1 + v2 * v2 + v3 * v3;
#pragma unroll
            for (int o = 1; o < 16; o <<= 1) s += __shfl_xor(s, o);
            const float r = __builtin_amdgcn_rsqf(s * (1.0f / 64) + EPS);
            u32x2 o; o.x = pk2(v0 * r * g0, v1 * r * g1); o.y = pk2(v2 * r * g2, v3 * r * g3);
            *(u32x2*)(KNM + ((size_t)(b * 4 + h) * SEQ + tl) * 64 + d0) = o;
        }
        float* KM = (float*)(ws + WS_KMEAN);
        for (int it = gw; it < BATCH * 32; it += NGW) {
            const int b = it >> 5, j = it & 31;
            float a0 = 0.f, a1 = 0.f, a2 = 0.f, a3 = 0.f;
            for (int k = 0; k < 256; ++k) {
                const int t = b * SEQ + j * 256 + k;
                const u32x2 w = *(const u32x2*)(P + (size_t)t * PP + C_MK + lane * 4);
                float v0 = bflo(w.x), v1 = bfhi(w.x), v2 = bflo(w.y), v3 = bfhi(w.y);
                float s = v0 * v0 + v1 * v1 + v2 * v2 + v3 * v3;
#pragma unroll
                for (int o = 1; o < 16; o <<= 1) s += __shfl_xor(s, o);
                const float r = __builtin_amdgcn_rsqf(s * (1.0f / 64) + EPS);
                a0 += bf2f((unsigned short)f2bf(v0 * r * g0)); a1 += bf2f((unsigned short)f2bf(v1 * r * g1)); a2 += bf2f((unsigned short)f2bf(v2 * r * g2)); a3 += bf2f((unsigned short)f2bf(v3 * r * g3));
            }
            f32x4 o = {a0 * (1.0f / 256), a1 * (1.0f / 256), a2 * (1.0f / 256), a3 * (1.0f / 256)};
            *(f32x4*)(KM + ((size_t)(b * 4 + h) * 32 + j) * 64 + d0) = o;
        }
    }
}


constexpr int GREC = 73728;
constexpr int CW_PROG = 12288;
constexpr int CW_PQ = 14336;
constexpr int CW_FLG = 16384;
constexpr int N_PREP = T / 64 * 4;
constexpr int R_W = 0, R_QG = 16384, R_KD = 32768, R_QK = 49152, R_U = 55296, R_GL = 71680;
constexpr int R_OPS = 55296;
constexpr int L_QN = 0, L_KN = 17408, L_KNT = 34816, L_VT = 53248, L_AT = 71680, L_TP = 89088, L_KGT = 98304, L_SC = 116736, L_AB = 117760, L_TT = 126976, L_CW = 147456;
constexpr int PQ = 272, PT = 144;
__device__ __forceinline__ u32x4 pack8(const float (&v)[8]) { u32x4 w; w.x = cvtpk(v[0], v[1]); w.y = cvtpk(v[2], v[3]); w.z = cvtpk(v[4], v[5]); w.w = cvtpk(v[6], v[7]); return w; }

__device__ __forceinline__ bf16x8 cvt8(const f32x16& x, int s) {
    u32x4 w;
    if (s == 0) { w.x = cvtpk(x[0], x[1]); w.y = cvtpk(x[2], x[3]); w.z = cvtpk(x[4], x[5]); w.w = cvtpk(x[6], x[7]); }
    else { w.x = cvtpk(x[8], x[9]); w.y = cvtpk(x[10], x[11]); w.z = cvtpk(x[12], x[13]); w.w = cvtpk(x[14], x[15]); }
    return __builtin_bit_cast(bf16x8, w);
}

__device__ __forceinline__ void gdn_prep_fetch(Frame& F, int item, u32x4 (&praw)[11], float& pa, float& pb) {
    const int cidx = item >> 2, h = item & 3; const int t0 = cidx * 64, tl0 = t0 & (SEQ - 1);
    const bf16_t* P = (const bf16_t*)(F.ws + WS_C); const int tid2 = F.tid & 127, cg = tid2 & 15, c0 = (tid2 >> 4) * 8; const int s = F.wave >> 1;
    if (F.wave < 6) {
#pragma unroll
        for (int k = 0; k < 11; ++k)
            praw[k] = (tl0 + c0 - 3 + k >= 0) ? *(const u32x4*)(P + (size_t)(t0 + c0 - 3 + k) * PP + s * 512 + h * 128 + cg * 8) : (u32x4){0u, 0u, 0u, 0u};
    }
    if (F.wave == 0) { const float* AB = (const float*)(F.ws + WS_AB); pa = AB[(size_t)(t0 + F.lane) * 8 + h]; pb = AB[(size_t)(t0 + F.lane) * 8 + 4 + h]; }
}
typedef int i32x4 __attribute__((ext_vector_type(4)));
__device__ __forceinline__ void st16_wt(__amdgpu_buffer_rsrc_t rsrc, int off, u32x4 v) { __builtin_amdgcn_raw_buffer_store_b128(__builtin_bit_cast(i32x4, v), rsrc, off, 0, 16); }
__device__ __forceinline__ void gdn_prep_item(Frame& F, const Args& A, int item, int next_item, u32x4 (&praw)[11], float& pa, float& pb, int& cw_head) {
    const int cidx = item >> 2, h = item & 3;
    const int t0 = cidx * 64, tl0 = t0 & (SEQ - 1);
    LAS unsigned char* L = F.lds;
    int tid = F.tid; asm volatile("" : "+v"(tid));
    const int lane = tid & 63, wave = F.wave;
    unsigned char* rec = F.ws + WS_G + (size_t)item * GREC;
    const __amdgpu_buffer_rsrc_t rsrc = __builtin_amdgcn_make_buffer_rsrc(rec, 0, GREC, 0x00020000);
    const bf16_t* P = (const bf16_t*)(F.ws + WS_C);
    LAS float* sc_beta = (LAS float*)(L + L_SC); LAS float* sc_gc = sc_beta + 64; LAS float* sc_eg = sc_beta + 128; LAS float* sc_ekd = sc_beta + 192;
    if (wave == 0) {
        const float a = pa, bb = pb;
        const float xx = a + A.in[10][h]; const float sp = (xx > 20.f) ? xx : log1pf(__expf(xx));
        float g = -__expf(A.in[9][h]) * sp;
        const float beta = 1.0f / (1.0f + __expf(-bb));
#pragma unroll
        for (int o = 1; o < 64; o <<= 1) { const float u = __shfl_up(g, o); if (lane >= o) g += u; }
        const float gl = __shfl(g, 63);
        sc_beta[lane] = beta; sc_gc[lane] = g; sc_eg[lane] = __expf(g); sc_ekd[lane] = __expf(gl - g);
        if (lane == 0) __hip_atomic_store((float*)(rec + R_GL), __expf(gl), __ATOMIC_RELAXED, __HIP_MEMORY_SCOPE_AGENT);
    }
    for (int i = tid; i < 576; i += NTHREADS) { *(LAS u32x4*)(L + L_TP + i * 16) = (u32x4){0u, 0u, 0u, 0u}; *(LAS u32x4*)(L + L_TT + i * 16) = (u32x4){0u, 0u, 0u, 0u}; }
    if (h != cw_head) {
        LAS float* cwl = (LAS float*)(L + L_CW);
        for (int i = tid; i < 1536; i += NTHREADS) { const int e = i & 7, j = (i >> 3) & 3, s3 = (i >> 5) % 3, cg2 = i / 96;
            cwl[i] = A.in[8][j * 1536 + s3 * 512 + h * 128 + cg2 * 8 + e]; }
        cw_head = h;
    }
    __syncthreads();
    if (wave < 6) {
        const int s = wave >> 1, tid2 = tid & 127, cg = tid2 & 15, c0 = (tid2 >> 4) * 8;
        const LAS float* cwl = (const LAS float*)(L + L_CW) + cg * 96 + s * 32;
        f32x4 cw0[4], cw1[4];
#pragma unroll
        for (int j = 0; j < 4; ++j) { cw0[j] = *(const LAS f32x4*)(cwl + j * 8); cw1[j] = *(const LAS f32x4*)(cwl + j * 8 + 4); }
        const int cst = ((c0 + 8 * (cg & 7)) & 63) * 2;
#pragma unroll
        for (int g4 = 0; g4 < 2; ++g4) {
            float y[4][8];
#pragma unroll
            for (int k = 0; k < 4; ++k)
#pragma unroll
                for (int i = 0; i < 8; ++i) y[k][i] = 0.f;
#pragma unroll
            for (int r7 = 0; r7 < 7; ++r7) {
                const u32x4 w = praw[4 * g4 + r7];
                const float x0 = bflo(w.x), x1 = bfhi(w.x), x2 = bflo(w.y), x3 = bfhi(w.y), x4 = bflo(w.z), x5 = bfhi(w.z), x6 = bflo(w.w), x7 = bfhi(w.w);
#pragma unroll
                for (int j = 0; j < 4; ++j) { const int k = r7 - j;
                    if (k >= 0 && k < 4) {
                        y[k][0] += cw0[j][0] * x0; y[k][1] += cw0[j][1] * x1; y[k][2] += cw0[j][2] * x2; y[k][3] += cw0[j][3] * x3;
                        y[k][4] += cw1[j][0] * x4; y[k][5] += cw1[j][1] * x5; y[k][6] += cw1[j][2] * x6; y[k][7] += cw1[j][3] * x7; } }
            }
#pragma unroll
            for (int k = 0; k < 4; ++k)
#pragma unroll
                for (int i = 0; i < 8; ++i) { const float v = y[k][i]; y[k][i] = v * __builtin_amdgcn_rcpf(1.0f + __expf(-v)); }
            if (s < 2) {
#pragma unroll
                for (int k = 0; k < 4; ++k) {
                    float sq = 0.f;
#pragma unroll
                    for (int i = 0; i < 8; ++i) sq += y[k][i] * y[k][i];
#pragma unroll
                    for (int o = 1; o < 16; o <<= 1) sq += __shfl_xor(sq, o);
                    const float rn = __builtin_amdgcn_rsqf(sq + EPS) * (s == 0 ? 0.08838834764831845f : 1.0f);
#pragma unroll
                    for (int i = 0; i < 8; ++i) y[k][i] *= rn;
                }
            }
            const int cb = c0 + 4 * g4;
            if (s == 0) {
#pragma unroll
                for (int k = 0; k < 4; ++k) *(LAS u32x4*)(L + L_QN + (cb + k) * PQ + cg * 16) = pack8(y[k]);
            } else if (s == 1) {
#pragma unroll
                for (int k = 0; k < 4; ++k) *(LAS u32x4*)(L + L_KN + (cb + k) * PQ + cg * 16) = pack8(y[k]);
                float be[4];
#pragma unroll
                for (int k = 0; k < 4; ++k) be[k] = sc_beta[cb + k] * sc_eg[cb + k];
#pragma unroll
                for (int i = 0; i < 8; ++i) {
                    u32x2 kw, gw;
                    kw.x = cvtpk(y[0][i], y[1][i]); kw.y = cvtpk(y[2][i], y[3][i]);
                    gw.x = cvtpk(y[0][i] * be[0], y[1][i] * be[1]); gw.y = cvtpk(y[2][i] * be[2], y[3][i] * be[3]);
                    *(LAS u32x2*)(L + L_KNT + (cg * 8 + i) * PT + cst + 8 * g4) = kw;
                    *(LAS u32x2*)(L + L_KGT + (cg * 8 + i) * PT + cst + 8 * g4) = gw;
                }
            } else {
                float bt[4];
#pragma unroll
                for (int k = 0; k < 4; ++k) bt[k] = sc_beta[cb + k];
#pragma unroll
                for (int i = 0; i < 8; ++i) {
                    u32x2 vw; vw.x = cvtpk(y[0][i] * bt[0], y[1][i] * bt[1]); vw.y = cvtpk(y[2][i] * bt[2], y[3][i] * bt[3]);
                    *(LAS u32x2*)(L + L_VT + (cg * 8 + i) * PT + cst + 8 * g4) = vw;
                }
            }
        }
    }
    __syncthreads();
    if (next_item < T / 64 * 4) gdn_prep_fetch(F, next_item, praw, pa, pb);
    const int r = lane & 31, hh = lane >> 5;
    if (wave < 6) {
        int tm, tn; const LAS unsigned char* Ab; const LAS unsigned char* Bb;
        if (wave < 3) { tm = (wave >= 1); tn = (wave == 2); Ab = L + L_KN + (32 * tm + r) * PQ; Bb = L + L_KN + (32 * tn + r) * PQ; }
        else { tm = (wave == 5); tn = (wave >= 4); Ab = L + L_KN + (32 * tm + r) * PQ; Bb = L + L_QN + (32 * tn + r) * PQ; }
        f32x16 acc;
#pragma unroll
        for (int i = 0; i < 16; ++i) acc[i] = 0.f;
#pragma unroll
        for (int s = 0; s < 8; ++s) { const bf16x8 a = *(const LAS bf16x8*)(Ab + s * 32 + hh * 16), b = *(const LAS bf16x8*)(Bb + s * 32 + hh * 16);
            acc = __builtin_amdgcn_mfma_f32_32x32x16_bf16(a, b, acc, 0, 0, 0); }
        const int col = tn * 32 + r; const float gcc = sc_gc[col];
        if (wave < 3) {
#pragma unroll
            for (int i = 0; i < 16; ++i) { const int row = tm * 32 + (i & 3) + 8 * (i >> 2) + 4 * hh;
                const float v = (row > col) ? acc[i] * sc_beta[row] * __expf(sc_gc[row] - gcc) : 0.f;
                *(LAS float*)(L + L_AT + col * PQ + row * 4) = v;
                *(LAS unsigned short*)(L + L_AB + row * PT + col * 2) = (unsigned short)(cvtpk(v, 0.f) & 0xffffu); }
        } else {
            float v[16];
#pragma unroll
            for (int i = 0; i < 16; ++i) { const int row = tm * 32 + (i & 3) + 8 * (i >> 2) + 4 * hh;
                v[i] = (row <= col) ? acc[i] * __expf(gcc - sc_gc[row]) : 0.f; }
            const int f0 = (tn == 0) ? 0 : 2 + 2 * tm;
            u32x4 w0, w1; w0.x = cvtpk(v[0], v[1]); w0.y = cvtpk(v[2], v[3]); w0.z = cvtpk(v[4], v[5]); w0.w = cvtpk(v[6], v[7]);
            w1.x = cvtpk(v[8], v[9]); w1.y = cvtpk(v[10], v[11]); w1.z = cvtpk(v[12], v[13]); w1.w = cvtpk(v[14], v[15]);
            st16_wt(rsrc, R_QK + f0 * 1024 + lane * 16, w0);
            st16_wt(rsrc, R_QK + (f0 + 1) * 1024 + lane * 16, w1);
        }
    }
    __syncthreads();
    if (wave == 0) {
        {
            const int g = lane >> 4, rr = lane & 15;
            const LAS unsigned char* ab = L + L_AT + (16 * g) * PQ + (16 * g) * 4;
            float Dr[16];
#pragma unroll
            for (int i = 0; i < 16; ++i) Dr[i] = 0.f;
            Dr[15] = (rr == 15) ? 1.0f : 0.f;
#define GDN_L0_BATCH(JHI, JLO) { asm volatile("" : "+v"(ab)); f32x4 av[(JHI) - (JLO) + 1][4]; \
            _Pragma("unroll") for (int jj = (JHI); jj >= (JLO); --jj) _Pragma("unroll") for (int k = 0; k < 4; ++k) if (k >= ((jj + 1) >> 2)) av[jj - (JLO)][k] = *(const LAS f32x4*)(ab + jj * PQ + k * 16); \
            _Pragma("unroll") for (int jj = (JHI); jj >= (JLO); --jj) { f32x2 a0 = {0.f, 0.f}, a1 = {0.f, 0.f}; \
                _Pragma("unroll") for (int k = 0; k < 4; ++k) if (k >= ((jj + 1) >> 2)) { \
                    a0 += (f32x2){Dr[4 * k], Dr[4 * k + 1]} * (f32x2){av[jj - (JLO)][k][0], av[jj - (JLO)][k][1]}; \
                    a1 += (f32x2){Dr[4 * k + 2], Dr[4 * k + 3]} * (f32x2){av[jj - (JLO)][k][2], av[jj - (JLO)][k][3]}; } \
                Dr[jj] = (rr == jj) ? 1.0f : -((a0[0] + a0[1]) + (a1[0] + a1[1])); } }
            GDN_L0_BATCH(14, 7)
            GDN_L0_BATCH(6, 3)
            GDN_L0_BATCH(2, 0)
#undef GDN_L0_BATCH
            u32x4 w0, w1; w0.x = cvtpk(Dr[0], Dr[1]); w0.y = cvtpk(Dr[2], Dr[3]); w0.z = cvtpk(Dr[4], Dr[5]); w0.w = cvtpk(Dr[6], Dr[7]);
            w1.x = cvtpk(Dr[8], Dr[9]); w1.y = cvtpk(Dr[10], Dr[11]); w1.z = cvtpk(Dr[12], Dr[13]); w1.w = cvtpk(Dr[14], Dr[15]);
            *(LAS u32x4*)(L + L_TP + (16 * g + rr) * PT + 32 * g) = w0; *(LAS u32x4*)(L + L_TP + (16 * g + rr) * PT + 32 * g + 16) = w1;
            const unsigned dw[8] = {w0.x, w0.y, w0.z, w0.w, w1.x, w1.y, w1.z, w1.w};
#pragma unroll
            for (int c = 0; c < 16; ++c) *(LAS unsigned short*)(L + L_TT + (16 * g + c) * PT + (16 * g + rr) * 2) = (unsigned short)((c & 1) ? (dw[c >> 1] >> 16) : (dw[c >> 1] & 0xffffu));
        }
        asm volatile("s_waitcnt lgkmcnt(0)" ::: "memory");
#pragma unroll
        for (int q = 0; q < 2; ++q) {
            f32x16 G, M;
#pragma unroll
            for (int i = 0; i < 16; ++i) { G[i] = 0.f; M[i] = 0.f; }
            G = __builtin_amdgcn_mfma_f32_32x32x16_bf16(*(const LAS bf16x8*)(L + L_AB + (32 * q + r) * PT + (32 * q + 8 * hh) * 2),
                                                         *(const LAS bf16x8*)(L + L_TT + (32 * q + r) * PT + (32 * q + 8 * hh) * 2), G, 0, 0, 0);
            const bf16x8 gb = cvt8(G, 1);
            const u32x2 d0 = *(const LAS u32x2*)(L + L_TP + (32 * q + r) * PT + (32 * q + 16 + 4 * hh) * 2), d1 = *(const LAS u32x2*)(L + L_TP + (32 * q + r) * PT + (32 * q + 16 + 8 + 4 * hh) * 2);
            u32x4 da; da.x = d0.x; da.y = d0.y; da.z = d1.x; da.w = d1.y;
            M = __builtin_amdgcn_mfma_f32_32x32x16_bf16(__builtin_bit_cast(bf16x8, da), gb, M, 0, 0, 0);
            if (r < 16) {
#pragma unroll
                for (int i = 8; i < 16; ++i) { const int m = (i & 3) + 8 * (i >> 2) + 4 * hh;
                    *(LAS unsigned short*)(L + L_TP + (32 * q + m) * PT + (32 * q + r) * 2) = (unsigned short)(cvtpk(-M[i], 0.f) & 0xffffu); }
                u32x2 t0, t1; t0.x = cvtpk(-M[8], -M[9]); t0.y = cvtpk(-M[10], -M[11]); t1.x = cvtpk(-M[12], -M[13]); t1.y = cvtpk(-M[14], -M[15]);
                *(LAS u32x2*)(L + L_TT + (32 * q + r) * PT + (32 * q + 16 + 4 * hh) * 2) = t0;
                *(LAS u32x2*)(L + L_TT + (32 * q + r) * PT + (32 * q + 24 + 4 * hh) * 2) = t1;
            }
        }
        asm volatile("s_waitcnt lgkmcnt(0)" ::: "memory");
        {
            f32x16 G, M;
#pragma unroll
            for (int i = 0; i < 16; ++i) { G[i] = 0.f; M[i] = 0.f; }
#pragma unroll
            for (int sx = 0; sx < 2; ++sx)
                G = __builtin_amdgcn_mfma_f32_32x32x16_bf16(*(const LAS bf16x8*)(L + L_AB + (32 + r) * PT + (16 * sx + 8 * hh) * 2),
                                                             *(const LAS bf16x8*)(L + L_TT + r * PT + (16 * sx + 8 * hh) * 2), G, 0, 0, 0);
#pragma unroll
            for (int sx = 0; sx < 2; ++sx) {
                const bf16x8 gb = cvt8(G, sx);
                const u32x2 d0 = *(const LAS u32x2*)(L + L_TP + (32 + r) * PT + (32 + 16 * sx + 4 * hh) * 2), d1 = *(const LAS u32x2*)(L + L_TP + (32 + r) * PT + (32 + 16 * sx + 8 + 4 * hh) * 2);
                u32x4 da; da.x = d0.x; da.y = d0.y; da.z = d1.x; da.w = d1.y;
                M = __builtin_amdgcn_mfma_f32_32x32x16_bf16(__builtin_bit_cast(bf16x8, da), gb, M, 0, 0, 0);
            }
#pragma unroll
            for (int i = 0; i < 16; ++i) { const int m = (i & 3) + 8 * (i >> 2) + 4 * hh;
                *(LAS unsigned short*)(L + L_TP + (32 + m) * PT + r * 2) = (unsigned short)(cvtpk(-M[i], 0.f) & 0xffffu); }
        }
    } else {
        for (int f = wave - 1; f < 32; f += 7) {
            if (f < 16) {
                const int mt = f >> 3, dblk = (f >> 1) & 3, s = f & 1; const int c = 32 * mt + r, d0 = 32 * dblk + 16 * s + 4 * hh;
                const u32x2 lo = *(const LAS u32x2*)(L + L_QN + c * PQ + d0 * 2), hi = *(const LAS u32x2*)(L + L_QN + c * PQ + (d0 + 8) * 2);
                const float e = sc_eg[c];
                float v[8] = {bflo(lo.x) * e, bfhi(lo.x) * e, bflo(lo.y) * e, bfhi(lo.y) * e, bflo(hi.x) * e, bfhi(hi.x) * e, bflo(hi.y) * e, bfhi(hi.y) * e};
                st16_wt(rsrc, R_QG + f * 1024 + lane * 16, pack8(v));
            } else {
                const int g = f - 16; const int dblk = g >> 2, blk = (g >> 1) & 1, s = g & 1; const int d = 32 * dblk + r, c0 = 32 * blk + 16 * s + 4 * hh;
                const int rot = 8 * ((d >> 3) & 7);
                const u32x2 lo = *(const LAS u32x2*)(L + L_KNT + d * PT + ((c0 + rot) & 63) * 2), hi = *(const LAS u32x2*)(L + L_KNT + d * PT + ((c0 + 8 + rot) & 63) * 2);
                const f32x4 e0 = *(const LAS f32x4*)(sc_ekd + c0), e1 = *(const LAS f32x4*)(sc_ekd + c0 + 8);
                float v[8] = {bflo(lo.x) * e0[0], bfhi(lo.x) * e0[1], bflo(lo.y) * e0[2], bfhi(lo.y) * e0[3], bflo(hi.x) * e1[0], bfhi(hi.x) * e1[1], bflo(hi.y) * e1[2], bfhi(hi.y) * e1[3]};
                st16_wt(rsrc, R_KD + g * 1024 + lane * 16, pack8(v));
            }
        }
    }
    __syncthreads();
    {
        const int ct = wave >> 2, et = wave & 3, dt = wave & 3;
        f32x16 acc;
#pragma unroll
        for (int i = 0; i < 16; ++i) acc[i] = 0.f;
        const LAS unsigned char* Ab = L + L_TP + (32 * ct + r) * PT + hh * 16; const LAS unsigned char* Bb = L + L_VT + (32 * et + r) * PT; const int rotv = (4 * et + (r >> 3)) & 7;
#define ROTC(s_, hh_, rot_) ((((2 * (s_) + (hh_)) + (rot_)) & 7) * 16)
#pragma unroll
        for (int s = 0; s < 2; ++s) acc = __builtin_amdgcn_mfma_f32_32x32x16_bf16(*(const LAS bf16x8*)(Ab + s * 32), *(const LAS bf16x8*)(Bb + ROTC(s, hh, rotv)), acc, 0, 0, 0);
        if (ct) {
#pragma unroll
            for (int s = 2; s < 4; ++s) acc = __builtin_amdgcn_mfma_f32_32x32x16_bf16(*(const LAS bf16x8*)(Ab + s * 32), *(const LAS bf16x8*)(Bb + ROTC(s, hh, rotv)), acc, 0, 0, 0);
        }
        { u32x4 w0, w1; w0.x = cvtpk(acc[0], acc[1]); w0.y = cvtpk(acc[2], acc[3]); w0.z = cvtpk(acc[4], acc[5]); w0.w = cvtpk(acc[6], acc[7]);
          w1.x = cvtpk(acc[8], acc[9]); w1.y = cvtpk(acc[10], acc[11]); w1.z = cvtpk(acc[12], acc[13]); w1.w = cvtpk(acc[14], acc[15]);
          st16_wt(rsrc, R_U + (et * 2 + ct) * 2048 + lane * 32, w0); st16_wt(rsrc, R_U + (et * 2 + ct) * 2048 + lane * 32 + 16, w1); }
#pragma unroll
        for (int i = 0; i < 16; ++i) acc[i] = 0.f;
        Ab = L + L_KGT + (32 * dt + r) * PT; Bb = L + L_TP + (32 * ct + r) * PT + hh * 16;
#pragma unroll
        for (int s = 0; s < 2; ++s) acc = __builtin_amdgcn_mfma_f32_32x32x16_bf16(*(const LAS bf16x8*)(Ab + ROTC(s, hh, rotv)), *(const LAS bf16x8*)(Bb + s * 32), acc, 0, 0, 0);
        if (ct) {
#pragma unroll
            for (int s = 2; s < 4; ++s) acc = __builtin_amdgcn_mfma_f32_32x32x16_bf16(*(const LAS bf16x8*)(Ab + ROTC(s, hh, rotv)), *(const LAS bf16x8*)(Bb + s * 32), acc, 0, 0, 0);
        }
#undef ROTC
        { u32x4 w0, w1; w0.x = cvtpk(acc[0], acc[1]); w0.y = cvtpk(acc[2], acc[3]); w0.z = cvtpk(acc[4], acc[5]); w0.w = cvtpk(acc[6], acc[7]);
          w1.x = cvtpk(acc[8], acc[9]); w1.y = cvtpk(acc[10], acc[11]); w1.z = cvtpk(acc[12], acc[13]); w1.w = cvtpk(acc[14], acc[15]);
          const int f0 = (ct * 4 + dt) * 2;
          st16_wt(rsrc, R_W + f0 * 1024 + lane * 16, w0); st16_wt(rsrc, R_W + (f0 + 1) * 1024 + lane * 16, w1); }
    }
    asm volatile("s_waitcnt vmcnt(0)" ::: "memory");
    __syncthreads();
    if (tid == 0) __hip_atomic_store((unsigned*)(F.ws + WS_CTL) + CW_FLG + item, 1u, __ATOMIC_RELAXED, __HIP_MEMORY_SCOPE_AGENT);
}

constexpr int S_OP0 = 0, S_OP1 = 55296, S_OB0 = 110592, S_OB1 = 128000;
__device__ __forceinline__ void gdn_scan(Frame& F, const Args& A, int b, int h) {
    LAS unsigned char* L = F.lds;
    int tid = F.tid; asm volatile("" : "+v"(tid));
    const int lane = tid & 63, wave = F.wave;
    const unsigned char* rec0 = F.ws + WS_G + ((size_t)(b * 128) * 4 + h) * GREC;
    const size_t rstep = (size_t)4 * GREC;
    bf16_t* P = (bf16_t*)(F.ws + WS_C);
    const int r = lane & 31, hh = lane >> 5;
    auto stage = [&](int n) {
        const unsigned char* src = rec0 + (size_t)n * rstep; const int lw = wave - 4; const int ob = (n & 1) ? S_OP1 : S_OP0;
        for (int k = lw; k < 54; k += 4)
            __builtin_amdgcn_global_load_lds((const unsigned*)(src + k * 1024 + lane * 16), (LAS unsigned*)(L + ob + k * 1024), 16, 0, 0);
    };
    auto warm = [&](int n) {
        const unsigned char* src = rec0 + (size_t)(n < 127 ? n : 127) * rstep; const int lw = wave - 4;
#pragma unroll
        for (int k = 0; k < 3; ++k) { const int p = lw + 4 * k; const int off = (p < 9 ? p : p - 3) * 8192;
            __builtin_amdgcn_global_load_lds((const unsigned*)(src + off + lane * 128), (LAS unsigned*)(L + 145920 + lw * 256), 4, 0, 0); }
    };
    auto zstage = [&](int m) {
        const int lw = wave - 4;
#pragma unroll
        for (int k = 0; k < 4; ++k) { const int p = lw * 4 + k;
            const bf16_t* zp = P + ((size_t)b * SEQ + m * 64 + 4 * p + (lane >> 4)) * PP + C_GZ + h * 128 + (lane & 15) * 8;
            __builtin_amdgcn_global_load_lds((const unsigned*)zp, (LAS unsigned*)(L + 147456 + p * 1024), 16, 0, 0); }
    };
    unsigned* flags = (unsigned*)(F.ws + WS_CTL) + CW_FLG + (size_t)(b * 128) * 4 + h;
    auto ensure = [&](int first, int count) {
        unsigned spins = 0;
        for (;;) {
            const unsigned v = (lane < count) ? __hip_atomic_load(flags + 4 * (first + lane), __ATOMIC_RELAXED, __HIP_MEMORY_SCOPE_AGENT) : 1u;
            if (__ballot(v == 0u) == 0ull) break;
            __builtin_amdgcn_s_sleep(4);
            if (++spins > (1u << 20)) break;
        }
        __builtin_amdgcn_fence(__ATOMIC_ACQUIRE, "agent");
        asm volatile("s_waitcnt vmcnt(0)" ::: "memory");
    };
    if (wave == 4) ensure(0, 8);
    __syncthreads();
    if (wave >= 4) { stage(0);
        const unsigned char* src1 = rec0 + rstep; const int lw = wave - 4;
#pragma unroll
        for (int j = 0; j < 8; ++j) { const int k = lw + 4 * j; __builtin_amdgcn_global_load_lds((const unsigned*)(src1 + k * 1024 + lane * 16), (LAS unsigned*)(L + S_OP1 + k * 1024), 16, 0, 0); } }
    f32x16 S[4];
#pragma unroll
    for (int d = 0; d < 4; ++d)
#pragma unroll
        for (int i = 0; i < 16; ++i) S[d][i] = 0.f;
    u32x4 Uc[4]; float glc = 0.f;
    if (wave < 4) {
        const unsigned char* up = rec0 + R_U + wave * 4096 + lane * 32;
        Uc[0] = *(const u32x4*)(up); Uc[1] = *(const u32x4*)(up + 16); Uc[2] = *(const u32x4*)(up + 2048); Uc[3] = *(const u32x4*)(up + 2048 + 16);
        glc = *(const float*)(rec0 + R_GL);
    }
    LAS float* ogl = (LAS float*)(L + 145408);
    if (tid < 128) ogl[tid] = A.in[11][tid];
    asm volatile("s_waitcnt vmcnt(0)" ::: "memory");
    __syncthreads();
    unsigned* prog = (unsigned*)(F.ws + WS_CTL) + CW_PROG + 64 * (b * 4 + h);
    for (int n = 0; n < 128; ++n) {
        if (tid == 0) __hip_atomic_store(prog, (unsigned)(n + 1), __ATOMIC_RELAXED, __HIP_MEMORY_SCOPE_AGENT);
        if (wave < 4) {
            const LAS unsigned char* ob = L + ((n & 1) ? S_OP1 : S_OP0) + lane * 16;
            f32x16 w0, w1, o0, o1;
#pragma unroll
            for (int i = 0; i < 16; ++i) { w0[i] = 0.f; w1[i] = 0.f; o0[i] = 0.f; o1[i] = 0.f; }
            bf16x8 sb[4][2];
#pragma unroll
            for (int d = 0; d < 4; ++d)
#pragma unroll
                for (int s = 0; s < 2; ++s) sb[d][s] = cvt8(S[d], s);
#pragma unroll
            for (int d = 0; d < 4; ++d)
#pragma unroll
                for (int s = 0; s < 2; ++s) {
                    w0 = __builtin_amdgcn_mfma_f32_32x32x16_bf16(*(const LAS bf16x8*)(ob + R_W + ((0 * 4 + d) * 2 + s) * 1024), sb[d][s], w0, 0, 0, 0);
                    w1 = __builtin_amdgcn_mfma_f32_32x32x16_bf16(*(const LAS bf16x8*)(ob + R_W + ((1 * 4 + d) * 2 + s) * 1024), sb[d][s], w1, 0, 0, 0);
                }
#define QGF(a_, d_, s_) (*(const LAS bf16x8*)(ob + R_QG + (((a_) * 4 + (d_)) * 2 + (s_)) * 1024))
            bf16x8 qa[4], qb[4];
            qa[0] = QGF(0, 0, 0); qa[1] = QGF(0, 0, 1); qa[2] = QGF(1, 0, 0); qa[3] = QGF(1, 0, 1);
            __builtin_amdgcn_sched_group_barrier(0x2, 32, 0);
            __builtin_amdgcn_sched_group_barrier(0x100, 8, 0);
#pragma unroll
            for (int g = 0; g < 12; ++g) { __builtin_amdgcn_sched_group_barrier(0x8, 1, 0); __builtin_amdgcn_sched_group_barrier(0x100, 1, 0); }
            __builtin_amdgcn_sched_group_barrier(0x8, 4, 0);
            __builtin_amdgcn_sched_barrier(0);
            const unsigned u0[8] = {Uc[0].x, Uc[0].y, Uc[0].z, Uc[0].w, Uc[1].x, Uc[1].y, Uc[1].z, Uc[1].w};
            const unsigned u1[8] = {Uc[2].x, Uc[2].y, Uc[2].z, Uc[2].w, Uc[3].x, Uc[3].y, Uc[3].z, Uc[3].w};
            bf16x8 vb[2][2];
            const float gl = glc;
#define QG_RUN(d_, qc_) do { o0 = __builtin_amdgcn_mfma_f32_32x32x16_bf16(qc_[0], sb[d_][0], o0, 0, 0, 0); o1 = __builtin_amdgcn_mfma_f32_32x32x16_bf16(qc_[2], sb[d_][0], o1, 0, 0, 0); \
                             o0 = __builtin_amdgcn_mfma_f32_32x32x16_bf16(qc_[1], sb[d_][1], o0, 0, 0, 0); o1 = __builtin_amdgcn_mfma_f32_32x32x16_bf16(qc_[3], sb[d_][1], o1, 0, 0, 0); } while (0)
#define QG_SGB(nds_) do { _Pragma("unroll") for (int g_ = 0; g_ < 4; ++g_) { __builtin_amdgcn_sched_group_barrier(0x8, 1, 0); if (nds_) __builtin_amdgcn_sched_group_barrier(0x100, 1, 0); __builtin_amdgcn_sched_group_barrier(0x2, 6, 0); } } while (0)
            qb[0] = QGF(0, 1, 0); qb[1] = QGF(0, 1, 1); qb[2] = QGF(1, 1, 0); qb[3] = QGF(1, 1, 1);
            QG_RUN(0, qa);
#pragma unroll
            for (int i = 0; i < 8; ++i) { w0[2 * i] = bflo(u0[i]) - w0[2 * i]; w0[2 * i + 1] = bfhi(u0[i]) - w0[2 * i + 1]; }
            QG_SGB(1); __builtin_amdgcn_sched_barrier(0);
            qa[0] = QGF(0, 2, 0); qa[1] = QGF(0, 2, 1); qa[2] = QGF(1, 2, 0); qa[3] = QGF(1, 2, 1);
            QG_RUN(1, qb);
            vb[0][0] = cvt8(w0, 0); vb[0][1] = cvt8(w0, 1);
#pragma unroll
            for (int i = 0; i < 4; ++i) { w1[2 * i] = bflo(u1[i]) - w1[2 * i]; w1[2 * i + 1] = bfhi(u1[i]) - w1[2 * i + 1]; }
            QG_SGB(1); __builtin_amdgcn_sched_barrier(0);
            qb[0] = QGF(0, 3, 0); qb[1] = QGF(0, 3, 1); qb[2] = QGF(1, 3, 0); qb[3] = QGF(1, 3, 1);
            QG_RUN(2, qa);
#pragma unroll
            for (int i = 4; i < 8; ++i) { w1[2 * i] = bflo(u1[i]) - w1[2 * i]; w1[2 * i + 1] = bfhi(u1[i]) - w1[2 * i + 1]; }
            vb[1][0] = cvt8(w1, 0); vb[1][1] = cvt8(w1, 1);
            QG_SGB(1); __builtin_amdgcn_sched_barrier(0);
            QG_RUN(3, qb);
#pragma unroll
            for (int d = 0; d < 2; ++d)
#pragma unroll
                for (int i = 0; i < 16; ++i) S[d][i] *= gl;
            QG_SGB(0);
#undef QGF
#undef QG_RUN
#undef QG_SGB
            __builtin_amdgcn_sched_barrier(0); asm volatile("" ::: "memory"); __builtin_amdgcn_s_barrier(); asm volatile("" ::: "memory"); __builtin_amdgcn_sched_barrier(0);
            bf16x8 kdA[8];
#pragma unroll
            for (int f = 0; f < 8; ++f) kdA[f] = *(const LAS bf16x8*)(ob + R_KD + f * 1024);
#pragma unroll
            for (int d = 2; d < 4; ++d)
#pragma unroll
                for (int i = 0; i < 16; ++i) S[d][i] *= gl;
            __builtin_amdgcn_sched_barrier(0);
            bf16x8 kdB[8];
#pragma unroll
            for (int f = 0; f < 8; ++f) kdB[f] = *(const LAS bf16x8*)(ob + R_KD + (8 + f) * 1024);
#pragma unroll
            for (int d = 0; d < 2; ++d)
#pragma unroll
                for (int bk = 0; bk < 2; ++bk)
#pragma unroll
                    for (int s = 0; s < 2; ++s) S[d] = __builtin_amdgcn_mfma_f32_32x32x16_bf16(kdA[(d * 2 + bk) * 2 + s], vb[bk][s], S[d], 0, 0, 0);
            __builtin_amdgcn_sched_group_barrier(0x100, 8, 1);
            __builtin_amdgcn_sched_group_barrier(0x8, 8, 1);
            __builtin_amdgcn_sched_barrier(0);
            bf16x8 qkf[6];
#pragma unroll
            for (int f = 0; f < 6; ++f) qkf[f] = *(const LAS bf16x8*)(ob + R_QK + f * 1024);
            {   const int nn = (n + 1 < 128) ? n + 1 : 127;
                const unsigned char* up = rec0 + (size_t)nn * rstep + R_U + wave * 4096 + lane * 32;
                Uc[0] = *(const u32x4*)(up); Uc[1] = *(const u32x4*)(up + 16); Uc[2] = *(const u32x4*)(up + 2048); Uc[3] = *(const u32x4*)(up + 2048 + 16);
                glc = *(const float*)(rec0 + (size_t)nn * rstep + R_GL); }
#pragma unroll
            for (int d = 2; d < 4; ++d)
#pragma unroll
                for (int bk = 0; bk < 2; ++bk)
#pragma unroll
                    for (int s = 0; s < 2; ++s) S[d] = __builtin_amdgcn_mfma_f32_32x32x16_bf16(kdB[((d - 2) * 2 + bk) * 2 + s], vb[bk][s], S[d], 0, 0, 0);
            __builtin_amdgcn_sched_group_barrier(0x100, 6, 2);
            __builtin_amdgcn_sched_group_barrier(0x20, 5, 2);
            __builtin_amdgcn_sched_group_barrier(0x8, 8, 2);
            __builtin_amdgcn_sched_barrier(0);
#pragma unroll
            for (int s = 0; s < 2; ++s) {
                o0 = __builtin_amdgcn_mfma_f32_32x32x16_bf16(qkf[0 + s], vb[0][s], o0, 0, 0, 0);
                o1 = __builtin_amdgcn_mfma_f32_32x32x16_bf16(qkf[2 + s], vb[0][s], o1, 0, 0, 0);
                o1 = __builtin_amdgcn_mfma_f32_32x32x16_bf16(qkf[4 + s], vb[1][s], o1, 0, 0, 0);
            }
            LAS unsigned char* obuf = L + ((n & 1) ? S_OB1 : S_OB0) + (wave * 32 + r) * 2;
#pragma unroll
            for (int i = 0; i < 16; ++i) { const int row = (i & 3) + 8 * (i >> 2) + 4 * hh;
                *(LAS unsigned short*)(obuf + row * PQ) = (unsigned short)(cvtpk(o0[i], 0.f) & 0xffffu);
                *(LAS unsigned short*)(obuf + (32 + row) * PQ) = (unsigned short)(cvtpk(o1[i], 0.f) & 0xffffu); }
        } else {
            const int m = n - 1; const int tt = tid - 256, row = tt >> 2, qd = tt & 3;
            const size_t t = (size_t)b * SEQ + (m < 0 ? 0 : m) * 64 + row;
            u32x4 zv0, zv1, zv2, zv3;
            { const bf16_t* zp = P + t * PP + C_GZ + h * 128 + qd * 32;
              asm volatile("global_load_dwordx4 %0, %4, off\n\tglobal_load_dwordx4 %1, %4, off offset:16\n\tglobal_load_dwordx4 %2, %4, off offset:32\n\tglobal_load_dwordx4 %3, %4, off offset:48"
                           : "=&v"(zv0), "=&v"(zv1), "=&v"(zv2), "=&v"(zv3) : "v"(zp) : "memory"); }
            { const int nn = (n + 1 < 128) ? n + 1 : 127; const unsigned char* src = rec0 + (size_t)nn * rstep; const int lw = wave - 4; const int obn = (nn & 1) ? S_OP1 : S_OP0;
#pragma unroll
              for (int j = 8; j < 14; ++j) { const int k = lw + 4 * j;
                  if (k < 54) __builtin_amdgcn_global_load_lds((const unsigned*)(src + k * 1024 + lane * 16), (LAS unsigned*)(L + obn + k * 1024), 16, 0, 0);
                  else __builtin_amdgcn_global_load_lds((const unsigned*)(src + lane * 16), (LAS unsigned*)(L + 147456 + (lw & 1) * 1024), 16, 0, 0); } }
            if (n >= 2) asm volatile("s_waitcnt vmcnt(22)" ::: "memory"); else asm volatile("s_waitcnt vmcnt(18)" ::: "memory");
            __builtin_amdgcn_s_barrier();
            { const int nn = (n + 2 < 128) ? n + 2 : 127; const unsigned char* src = rec0 + (size_t)nn * rstep; const int lw = wave - 4; const int obn = (n & 1) ? S_OP1 : S_OP0;
#pragma unroll
              for (int j = 0; j < 8; ++j) { const int k = lw + 4 * j;
                  __builtin_amdgcn_global_load_lds((const unsigned*)(src + k * 1024 + lane * 16), (LAS unsigned*)(L + obn + k * 1024), 16, 0, 0); } }
            asm volatile("s_waitcnt vmcnt(14)" : "+v"(zv0), "+v"(zv1), "+v"(zv2), "+v"(zv3) :: "memory");
            const u32x4 zv[4] = {zv0, zv1, zv2, zv3};
            if (n >= 1) {
                const LAS unsigned char* ob = L + ((m & 1) ? S_OB1 : S_OB0) + row * PQ + qd * 64;
                float v[32], z[32]; float ssq = 0.f;
#pragma unroll
                for (int k = 0; k < 4; ++k) {
                    const u32x4 o4 = *(const LAS u32x4*)(ob + k * 16);
                    const unsigned ow[4] = {o4.x, o4.y, o4.z, o4.w}, zw[4] = {zv[k].x, zv[k].y, zv[k].z, zv[k].w};
#pragma unroll
                    for (int i = 0; i < 4; ++i) { v[k * 8 + 2 * i] = bflo(ow[i]); v[k * 8 + 2 * i + 1] = bfhi(ow[i]); z[k * 8 + 2 * i] = bflo(zw[i]); z[k * 8 + 2 * i + 1] = bfhi(zw[i]); }
                }
#pragma unroll
                for (int i = 0; i < 32; ++i) ssq += v[i] * v[i];
                ssq += __shfl_xor(ssq, 1); ssq += __shfl_xor(ssq, 2);
                const float rs = __builtin_amdgcn_rsqf(ssq * (1.0f / 128) + EPS);
#pragma unroll
                for (int k = 0; k < 4; ++k) {
                    float o[8];
#pragma unroll
                    for (int i = 0; i < 8; ++i) { const float zz = z[k * 8 + i]; o[i] = v[k * 8 + i] * rs * ogl[qd * 32 + k * 8 + i] * (zz * __builtin_amdgcn_rcpf(1.0f + __expf(-zz))); }
                    *(u32x4*)(P + t * PP + h * 128 + qd * 32 + k * 8) = pack8(o);
                }
            }
            if (n >= 2) asm volatile("s_waitcnt vmcnt(26)" ::: "memory"); else asm volatile("s_waitcnt vmcnt(22)" ::: "memory");
            if (wave == 4 && n + 3 < 128 && ((n + 3) & 31) == 8) ensure(n + 3, (n + 3 + 32 <= 128) ? 32 : 128 - (n + 3));
        }
        asm volatile("s_waitcnt lgkmcnt(0)" ::: "memory"); __builtin_amdgcn_s_barrier(); asm volatile("" ::: "memory");
    }
    asm volatile("s_waitcnt vmcnt(0)" ::: "memory");
    if (tid == 0) __hip_atomic_store(prog, 1000u, __ATOMIC_RELAXED, __HIP_MEMORY_SCOPE_AGENT);
    if (wave >= 4) {
        const int m = 127; const int tt = tid - 256, row = tt >> 2, qd = tt & 3;
        const LAS unsigned char* ob = L + ((m & 1) ? S_OB1 : S_OB0) + row * PQ + qd * 64;
        const size_t t = (size_t)b * SEQ + m * 64 + row;
        float ssq = 0.f; float v[32], z[32];
#pragma unroll
        for (int k = 0; k < 4; ++k) {
            const u32x4 o4 = *(const LAS u32x4*)(ob + k * 16), z4 = *(const u32x4*)(P + t * PP + C_GZ + h * 128 + qd * 32 + k * 8);
            const unsigned ow[4] = {o4.x, o4.y, o4.z, o4.w}, zw[4] = {z4.x, z4.y, z4.z, z4.w};
#pragma unroll
            for (int i = 0; i < 4; ++i) { v[k * 8 + 2 * i] = bflo(ow[i]); v[k * 8 + 2 * i + 1] = bfhi(ow[i]); z[k * 8 + 2 * i] = bflo(zw[i]); z[k * 8 + 2 * i + 1] = bfhi(zw[i]); }
        }
#pragma unroll
        for (int i = 0; i < 32; ++i) ssq += v[i] * v[i];
        ssq += __shfl_xor(ssq, 1); ssq += __shfl_xor(ssq, 2);
        const float rs = __builtin_amdgcn_rsqf(ssq * (1.0f / 128) + EPS);
#pragma unroll
        for (int k = 0; k < 4; ++k) {
            float o[8];
#pragma unroll
            for (int i = 0; i < 8; ++i) { const float zz = z[k * 8 + i]; o[i] = v[k * 8 + i] * rs * ogl[qd * 32 + k * 8 + i] * (zz * __builtin_amdgcn_rcpf(1.0f + __expf(-zz))); }
            *(u32x4*)(P + t * PP + h * 128 + qd * 32 + k * 8) = pack8(o);
        }
    }
}


__device__ __forceinline__ void scan_helper(Frame& F, int i, int part) {
    LAS unsigned char* L = F.lds; const int lane = F.lane, wave = F.wave;
#if HELP2
    const int tid = F.tid & 255; constexpr int HSTRIDE = 256; i += 8 * (wave >> 2);
#else
    const int tid = F.tid; constexpr int HSTRIDE = NTHREADS;
#endif
    const int b = i >> 2, h = i & 3;
    const unsigned char* rec0 = F.ws + WS_G + ((size_t)(b * 128) * 4 + h) * GREC; const size_t rstep = (size_t)4 * GREC;
    const bf16_t* P = (const bf16_t*)(F.ws + WS_C);
    unsigned* prog = (unsigned*)(F.ws + WS_CTL) + CW_PROG + 64 * i;
    constexpr int LA = 8;
    for (int n = 1; n < 128; ++n) {
        unsigned spins = 0;
        for (;;) {
            const unsigned p = __builtin_amdgcn_readfirstlane(__hip_atomic_load(prog, __ATOMIC_RELAXED, __HIP_MEMORY_SCOPE_AGENT));
            const unsigned f = __builtin_amdgcn_readfirstlane(__hip_atomic_load((unsigned*)(F.ws + WS_CTL) + CW_FLG + ((size_t)(b * 128 + n) * 4 + h), __ATOMIC_RELAXED, __HIP_MEMORY_SCOPE_AGENT));
            if ((int)p + LA >= n && f != 0u) break;
            __builtin_amdgcn_s_sleep(8);
            if (++spins > 20000u) break;
        }
        constexpr int NL = 576 / NHELP;
        for (int line = tid; line < NL + (part == 0 ? 128 : 0); line += HSTRIDE) {
        if (line < NL) __builtin_amdgcn_global_load_lds((const unsigned*)(rec0 + (size_t)n * rstep + part * (NL * 128) + line * 128), (LAS unsigned*)(L + wave * 256), 4, 0, 0);
        else { const int zl = line - NL; const int row = zl >> 1, hf = zl & 1;
            __builtin_amdgcn_global_load_lds((const unsigned*)(P + ((size_t)b * SEQ + n * 64 + row) * PP + C_GZ + h * 128 + hf * 64), (LAS unsigned*)(L + wave * 256), 4, 0, 0); }
        }
        asm volatile("s_waitcnt vmcnt(4)" ::: "memory");
    }
    asm volatile("s_waitcnt vmcnt(0)" ::: "memory");
}

constexpr size_t WS_IMG = 460 * MiB;
constexpr size_t WS_IMGM = 492 * MiB;
constexpr int CW_QUEUE = 8192;
constexpr float LOG2E = 1.4426950408889634f;

__device__ __forceinline__ void img_item(Frame& F, const Args& A, int item) {
    LAS unsigned char* L = F.lds; int tid = F.tid; asm volatile("" : "+v"(tid));
    const bool mem = item >= 512; const int bh = mem ? item - 512 : item >> 5, j = item & 31, b = bh >> 2, h = bh & 3;
    unsigned char* img = F.ws + (mem ? WS_IMGM + (size_t)bh * 65536 : WS_IMG + ((size_t)bh * 32 + j) * 65536);
    const int key = tid >> 1, half = tid & 1;
    LAS unsigned* TK = (LAS unsigned*)L;
    LAS unsigned* TV = TK + 256 * 33;
    LAS float* part = (LAS float*)(TV + 256 * 33);
    float kv[32], vv[32];
    if (!mem) {
        const bf16_t* P = (const bf16_t*)(F.ws + WS_C); const size_t t = (size_t)b * SEQ + j * 256 + key;
#pragma unroll
        for (int c4 = 0; c4 < 4; ++c4) {
            const u32x4 kw = *(const u32x4*)(P + t * PP + C_MK + h * 64 + half * 32 + c4 * 8), vw = *(const u32x4*)(P + t * PP + C_MV + h * 64 + half * 32 + c4 * 8);
            const unsigned ka[4] = {kw.x, kw.y, kw.z, kw.w}, va[4] = {vw.x, vw.y, vw.z, vw.w};
#pragma unroll
            for (int i = 0; i < 4; ++i) { kv[c4 * 8 + 2 * i] = bflo(ka[i]); kv[c4 * 8 + 2 * i + 1] = bfhi(ka[i]); vv[c4 * 8 + 2 * i] = bflo(va[i]); vv[c4 * 8 + 2 * i + 1] = bfhi(va[i]); }
        }
    } else {
        const float* KV = (const float*)(F.ws + WS_KVMEM) + ((size_t)b * MEMT + key) * 512 + h * 64 + half * 32;
#pragma unroll
        for (int c4 = 0; c4 < 8; ++c4) { const f32x4 kw = *(const f32x4*)(KV + c4 * 4), vw = *(const f32x4*)(KV + 256 + c4 * 4);
#pragma unroll
            for (int i = 0; i < 4; ++i) { kv[c4 * 4 + i] = kw[i]; vv[c4 * 4 + i] = vw[i]; } }
    }
    float ss = 0.f;
#pragma unroll
    for (int i = 0; i < 32; ++i) ss += kv[i] * kv[i];
    ss += __shfl_xor(ss, 1);
    const float rs = __builtin_amdgcn_rsqf(ss * (1.0f / 64) + EPS);
    const float* kg = (mem ? A.in[17] : A.in[13]) + half * 32;
    unsigned kp[16], vp[16];
#pragma unroll
    for (int i = 0; i < 16; ++i) { kp[i] = cvtpk(kv[2 * i] * rs * kg[2 * i], kv[2 * i + 1] * rs * kg[2 * i + 1]); vp[i] = cvtpk(vv[2 * i], vv[2 * i + 1]); }
#pragma unroll
    for (int i = 0; i < 16; ++i) { TK[key * 33 + half * 16 + i] = kp[i]; TV[key * 33 + half * 16 + i] = vp[i]; }
#pragma unroll
    for (int cc = 0; cc < 4; ++cc) { const int ch = half * 4 + cc; u32x4 w; w.x = kp[cc * 4]; w.y = kp[cc * 4 + 1]; w.z = kp[cc * 4 + 2]; w.w = kp[cc * 4 + 3];
        *(u32x4*)(img + key * 128 + ((ch ^ ((key >> 1) & 7)) * 16)) = w; }
    __syncthreads();
    const LAS unsigned short* TKh = (const LAS unsigned short*)TK; const LAS unsigned short* TVh = (const LAS unsigned short*)TV;
    if (!mem) { const int d = tid & 63, kq = tid >> 6; float a = 0.f;
#pragma unroll 8
        for (int k = 0; k < 32; ++k) a += bf2f(TKh[(kq * 32 + k) * 66 + d]);
        part[kq * 64 + d] = a; }
    {
        const int d = tid >> 3, pt = tid & 7;
#pragma unroll
        for (int cc = 0; cc < 4; ++cc) { const int ch = pt * 4 + cc; unsigned short e[8];
#pragma unroll
            for (int x = 0; x < 8; ++x) { const int pos = ch * 8 + x, kt = pos >> 5, p5 = pos & 31; const int kap = (p5 & 16) | ((p5 & 4) << 1) | ((p5 & 8) >> 1) | (p5 & 3);
                e[x] = TVh[(kt * 32 + kap) * 66 + d]; }
            u32x4 w; w.x = e[0] | ((unsigned)e[1] << 16); w.y = e[2] | ((unsigned)e[3] << 16); w.z = e[4] | ((unsigned)e[5] << 16); w.w = e[6] | ((unsigned)e[7] << 16);
            *(u32x4*)(img + 32768 + d * 512 + ((ch ^ (d & 15)) * 16)) = w; }
    }
    __syncthreads();
    if (!mem && tid < 64) { float a = 0.f;
#pragma unroll
        for (int k = 0; k < 8; ++k) a += part[k * 64 + tid];
        ((float*)(F.ws + WS_KMEAN))[((size_t)bh * 32 + j) * 64 + tid] = a * (1.0f / 256); }
    __syncthreads();
}

__device__ __forceinline__ void attn_item(Frame& F, const Args& A, const int kind, const int bh, const int c) {
    LAS unsigned char* L = F.lds; int tid = F.tid; asm volatile("" : "+v"(tid)); const int lane = tid & 63, wave = F.wave;
    const int b = bh >> 2, h = bh & 3, r = lane & 31, hh = lane >> 5;
    bf16_t* P = (bf16_t*)(F.ws + WS_C);
    const unsigned char* img0 = F.ws + (kind ? WS_IMGM + (size_t)bh * 65536 : WS_IMG + (size_t)bh * 32 * 65536);
    const int nb = kind ? 1 : c + 1, nst = 2 * nb;
    auto stage = [&](int st) {
        const unsigned char* src = img0 + (size_t)(st >> 1) * 65536; const int hf = st & 1; LAS unsigned char* dst = L + (st & 3) * 32768;
#pragma unroll
        for (int k = 0; k < 4; ++k) { const int p = wave * 4 + k;
            if (p < 16) __builtin_amdgcn_global_load_lds((const unsigned*)(src + hf * 16384 + p * 1024 + lane * 16), (LAS unsigned*)(dst + p * 1024), 16, 0, 0);
            else { const int pp = p - 16;
                __builtin_amdgcn_global_load_lds((const unsigned*)(src + 32768 + (4 * pp + (lane >> 4)) * 512 + hf * 256 + (lane & 15) * 16), (LAS unsigned*)(dst + 16384 + pp * 1024), 16, 0, 0); } }
    };
    LAS float* KM = (LAS float*)(L + 131072);
    if (!kind) { const float* kmg = (const float*)(F.ws + WS_KMEAN) + (size_t)bh * 32 * 64; for (int i = tid; i < c * 64; i += NTHREADS) KM[i] = kmg[i]; }
    const int qloc = 32 * wave + r, qpos = c * 256 + qloc; const size_t t = (size_t)b * SEQ + qpos;
    const bf16_t* qp = P + t * PP + (kind ? C_CQ : C_MQ) + h * 64;
    const float* qgain = kind ? A.in[16] : A.in[12]; const float* kgain = kind ? A.in[17] : A.in[13];
    const float mq = wave_max(fabsf(qgain[lane])), mk = wave_max(fabsf(kgain[lane]));
    const float M2 = (8.0f * mq * mk * 1.02f + 0.05f) * LOG2E;
    const float slope2 = kind ? 0.f : exp2f(-2.0f * (float)(h + 1)) * LOG2E;
    float qg[32];
    {
#pragma unroll
        for (int c4 = 0; c4 < 4; ++c4) { const u32x4 w = *(const u32x4*)(qp + hh * 32 + c4 * 8); const unsigned wa[4] = {w.x, w.y, w.z, w.w};
#pragma unroll
            for (int i = 0; i < 4; ++i) { qg[c4 * 8 + 2 * i] = bflo(wa[i]); qg[c4 * 8 + 2 * i + 1] = bfhi(wa[i]); } }
    }
    float ss = 0.f;
#pragma unroll
    for (int i = 0; i < 32; ++i) ss += qg[i] * qg[i];
    ss += __shfl_xor(ss, 32);
    const float rs = __builtin_amdgcn_rsqf(ss * (1.0f / 64) + EPS);
    bf16x8 Qf[4];
#pragma unroll
    for (int s = 0; s < 4; ++s) { const int d0 = 16 * s + 8 * hh; const u32x4 w = *(const u32x4*)(qp + d0); const unsigned wa[4] = {w.x, w.y, w.z, w.w}; const float sc = rs * (0.125f * LOG2E);
        float v[8];
#pragma unroll
        for (int i = 0; i < 4; ++i) { v[2 * i] = bflo(wa[i]) * sc * qgain[d0 + 2 * i]; v[2 * i + 1] = bfhi(wa[i]) * sc * qgain[d0 + 2 * i + 1]; }
        Qf[s] = __builtin_bit_cast(bf16x8, pack8(v)); }
    unsigned selmask = 0u;
    if (!kind) {
#pragma unroll
        for (int i = 0; i < 32; ++i) qg[i] *= rs * qgain[hh * 32 + i];
    }
    asm volatile("s_waitcnt vmcnt(0)" : "+v"(qg[0]), "+v"(qg[31]) :: "memory");
    __syncthreads();
    stage(0); stage(1); if (nst > 2) stage(2);
    if (!kind && c > 0) {
        float v0 = -INFINITY, v1 = -INFINITY, v2 = -INFINITY; int i0 = -1, i1 = -1, i2 = -1;
        for (int j = 0; j < c; ++j) {
            const LAS f32x4* km = (const LAS f32x4*)(KM + j * 64 + hh * 32);
            float g = 0.f;
#pragma unroll
            for (int k = 0; k < 8; ++k) { const f32x4 m4 = km[k]; g += qg[4 * k] * m4[0] + qg[4 * k + 1] * m4[1] + qg[4 * k + 2] * m4[2] + qg[4 * k + 3] * m4[3]; }
            g += __shfl_xor(g, 32);
            if (g > v0) { v2 = v1; i2 = i1; v1 = v0; i1 = i0; v0 = g; i0 = j; }
            else if (g > v1) { v2 = v1; i2 = i1; v1 = g; i1 = j; }
            else if (g > v2) { v2 = g; i2 = j; }
        }
        if (i0 >= 0) selmask |= 1u << i0; if (i1 >= 0) selmask |= 1u << i1; if (i2 >= 0) selmask |= 1u << i2;
    }
    unsigned chs[4];
#pragma unroll
    for (int s = 0; s < 4; ++s) chs[s] = (unsigned)(r * 128 + (((2 * s + hh) ^ ((r >> 1) & 7)) * 16));
    const float lo4 = slope2 * (float)(4 * hh);
    f32x16 O0, O1;
#pragma unroll
    for (int i = 0; i < 16; ++i) { O0[i] = 0.f; O1[i] = 0.f; }
    float lsum = 0.f;
    for (int st = 0; st < nst; ++st) {
        const int younger = (nst - 1 - st) < 2 ? (nst - 1 - st) : 2;
        if (younger == 2) asm volatile("s_waitcnt vmcnt(8)" ::: "memory"); else if (younger == 1) asm volatile("s_waitcnt vmcnt(4)" ::: "memory"); else asm volatile("s_waitcnt vmcnt(0)" ::: "memory");
        asm volatile("s_waitcnt lgkmcnt(0)" ::: "memory"); __builtin_amdgcn_s_barrier(); asm volatile("" ::: "memory");
        if (st + 3 < nst) stage(st + 3);
        const int i = st >> 1, hf = st & 1;
        const bool own = (!kind) && (i == c);
        bool sel = true; if (!kind && !own) sel = (selmask >> i) & 1u;
        if (__ballot(sel) == 0ull) continue;
        const float laneoff = sel ? (slope2 * (float)(256 * i - qpos) - M2) : -INFINITY;
        const int ktmax = own ? wave : 7;
        const LAS unsigned char* kb = L + (st & 3) * 32768; const LAS unsigned char* vb = kb + 16384 + r * 256;
        const int nkt = (ktmax - 4 * hf + 1) < 4 ? (ktmax - 4 * hf + 1) : 4;
        if (nkt <= 0) continue;
        bf16x8 kf[4];
#pragma unroll
        for (int s = 0; s < 4; ++s) kf[s] = *(const LAS bf16x8*)(kb + chs[s]);
#pragma unroll 1
        for (int ktl = 0; ktl < nkt; ++ktl) {
            const int kt = 4 * hf + ktl;
            f32x16 C; const float lo = laneoff + slope2 * (float)(32 * kt) + lo4;
#pragma unroll
            for (int x = 0; x < 16; ++x) C[x] = slope2 * (float)((x & 3) + 8 * (x >> 2)) + lo;
#pragma unroll
            for (int s = 0; s < 4; ++s) C = __builtin_amdgcn_mfma_f32_32x32x16_bf16(kf[s], Qf[s], C, 0, 0, 0);
            const unsigned c0 = (unsigned)(((4 * ktl + hh) ^ (r & 15)) * 16), c1 = (unsigned)(((4 * ktl + 2 + hh) ^ (r & 15)) * 16);
            const bf16x8 vf0 = *(const LAS bf16x8*)(vb + c0), vf1 = *(const LAS bf16x8*)(vb + 32 * 256 + c0);
            const bf16x8 vf2 = *(const LAS bf16x8*)(vb + c1), vf3 = *(const LAS bf16x8*)(vb + 32 * 256 + c1);
            const int kn = (ktl + 1 < nkt) ? ktl + 1 : ktl;
#pragma unroll
            for (int s = 0; s < 4; ++s) kf[s] = *(const LAS bf16x8*)(kb + kn * 4096 + chs[s]);
            __builtin_amdgcn_sched_barrier(0);
            if (own && kt == wave) {
#pragma unroll
                for (int x = 0; x < 16; ++x) if ((x & 3) + 8 * (x >> 2) + 4 * hh > r) C[x] = -INFINITY;
            }
#pragma unroll
            for (int x = 0; x < 16; ++x) C[x] = __builtin_amdgcn_exp2f(C[x]);
            const float ps = (((C[0] + C[1]) + (C[2] + C[3])) + ((C[4] + C[5]) + (C[6] + C[7]))) + (((C[8] + C[9]) + (C[10] + C[11])) + ((C[12] + C[13]) + (C[14] + C[15])));
            lsum += ps;
            const bf16x8 p0 = cvt8(C, 0), p1 = cvt8(C, 1);
            O0 = __builtin_amdgcn_mfma_f32_32x32x16_bf16(vf0, p0, O0, 0, 0, 0);
            O1 = __builtin_amdgcn_mfma_f32_32x32x16_bf16(vf1, p0, O1, 0, 0, 0);
            O0 = __builtin_amdgcn_mfma_f32_32x32x16_bf16(vf2, p1, O0, 0, 0, 0);
            O1 = __builtin_amdgcn_mfma_f32_32x32x16_bf16(vf3, p1, O1, 0, 0, 0);
        }
    }
    lsum += __shfl_xor(lsum, 32);
    const float inv = 1.0f / lsum;
    bf16_t* yp = P + t * PP + (kind ? 768 : 512) + h * 64 + 4 * hh;
#pragma unroll
    for (int g = 0; g < 4; ++g) {
        u32x2 w0, w1; w0.x = cvtpk(O0[4 * g] * inv, O0[4 * g + 1] * inv); w0.y = cvtpk(O0[4 * g + 2] * inv, O0[4 * g + 3] * inv);
        w1.x = cvtpk(O1[4 * g] * inv, O1[4 * g + 1] * inv); w1.y = cvtpk(O1[4 * g + 2] * inv, O1[4 * g + 3] * inv);
        *(u32x2*)(yp + 8 * g) = w0; *(u32x2*)(yp + 32 + 8 * g) = w1;
    }
}

__device__ __forceinline__ void p4b_attn(Frame& F, const Args& A, int pass) {
    LAS unsigned* qw = (LAS unsigned*)(F.lds + 140000);
    unsigned* heads = (unsigned*)(F.ws + WS_CTL) + CW_QUEUE + 1024 * pass;
    const int myq = (int)(xb_xcc_id() & 7u);
    for (int qi = 0; qi < 8; ++qi) {
        const int q = (myq + qi) & 7;
        for (;;) {
            __syncthreads();
            if (F.tid == 0) *qw = atomicAdd(heads + 64 * q, 1u);
            __syncthreads();
            const int idx = (int)*qw;
            if (idx >= 128) break;
            const int bh = 2 * q + (idx & 1);
            if (idx < 64) attn_item(F, A, 0, bh, 31 - (idx >> 1));
            else attn_item(F, A, 1, bh, (idx - 64) >> 1);
        }
    }
}

__device__ __forceinline__ void naive_gdn(Frame& F, const Args& A, int b, int h) {
    unsigned char* ws = F.ws;
    LAS float* vec = (LAS float*)F.lds;
    LAS float* ba = vec + 32 * 384;
    LAS float* part = ba + 64;
    LAS float* part2 = part + 512;
    LAS float* obuf = part2 + 512;
    const int tid = F.tid, e = tid & 127, dq = tid >> 7;
    const bf16_t* GQ = (const bf16_t*)(ws + WS_GQ); const bf16_t* GK = (const bf16_t*)(ws + WS_GK); const bf16_t* GV = (const bf16_t*)(ws + WS_GV);
    const float* GB = (const float*)(ws + WS_GB); const float* GG = (const float*)(ws + WS_GG);
    bf16_t* P = (bf16_t*)(ws + WS_C);
    const float* og = A.in[11];
    float S[32];
#pragma unroll
    for (int i = 0; i < 32; ++i) S[i] = 0.f;
    for (int c0 = 0; c0 < SEQ; c0 += 32) {
        __syncthreads();
        for (int i = tid; i < 32 * 384; i += NTHREADS) { const int tk = i / 384, r = i % 384; const size_t t = (size_t)b * SEQ + c0 + tk;
            const bf16_t* src = (r < 128) ? GQ : (r < 256) ? GK : GV;
            vec[i] = bf2f(src[t * 512 + h * 128 + (r & 127)]); }
        if (tid < 32) { const size_t t = (size_t)b * SEQ + c0 + tid; ba[tid * 2] = GB[t * 4 + h]; ba[tid * 2 + 1] = __expf(GG[t * 4 + h]); }
        __syncthreads();
        for (int tk = 0; tk < 32; ++tk) {
            const LAS float* qq = vec + tk * 384 + 32 * dq; const LAS float* kk = qq + 128; const float vv = vec[tk * 384 + 256 + e];
            const float beta = ba[tk * 2], alpha = ba[tk * 2 + 1];
            float p = 0.f;
#pragma unroll
            for (int i = 0; i < 32; ++i) p += S[i] * kk[i];
            part[dq * 128 + e] = p;
            __syncthreads();
            const float Sk = (part[e] + part[128 + e]) + (part[256 + e] + part[384 + e]);
            const float vn = beta * (vv - alpha * Sk);
            float po = 0.f;
#pragma unroll
            for (int i = 0; i < 32; ++i) { S[i] = alpha * S[i] + kk[i] * vn; po += S[i] * qq[i]; }
            part2[dq * 128 + e] = po;
            __syncthreads();
            if (dq == 0) obuf[tk * 128 + e] = (part2[e] + part2[128 + e]) + (part2[256 + e] + part2[384 + e]);
        }
        __syncthreads();
        { const int r = tid >> 4, cb = (tid & 15) * 8; const size_t t = (size_t)b * SEQ + c0 + r;
            float v[8]; float s = 0.f;
#pragma unroll
            for (int i = 0; i < 8; ++i) { v[i] = obuf[r * 128 + cb + i]; s += v[i] * v[i]; }
#pragma unroll
            for (int o = 1; o < 16; o <<= 1) s += __shfl_xor(s, o);
            const float rs = __builtin_amdgcn_rsqf(s * (1.0f / 128) + EPS);
            const u32x4 zw = *(const u32x4*)(P + t * PP + C_GZ + h * 128 + cb);
            float z[8] = {bflo(zw.x), bfhi(zw.x), bflo(zw.y), bfhi(zw.y), bflo(zw.z), bfhi(zw.z), bflo(zw.w), bfhi(zw.w)};
            float o[8];
#pragma unroll
            for (int i = 0; i < 8; ++i) o[i] = v[i] * rs * og[cb + i] * (z[i] * __builtin_amdgcn_rcpf(1.0f + __expf(-z[i])));
            u32x4 w; w.x = pk2(o[0], o[1]); w.y = pk2(o[2], o[3]); w.z = pk2(o[4], o[5]); w.w = pk2(o[6], o[7]);
            *(u32x4*)(P + t * PP + h * 128 + cb) = w; }
    }
}

__device__ __forceinline__ void naive_moba_query(Frame& F, const Args& A, int t, int h, LAS float* sc, LAS float* qs) {
    unsigned char* ws = F.ws; const int lane = F.lane;
    bf16_t* P = (bf16_t*)(ws + WS_C);
    const bf16_t* KNM = (const bf16_t*)(ws + WS_KNM); const float* KM = (const float*)(ws + WS_KMEAN);
    const int b = t >> 13, tl = t & (SEQ - 1), own = tl >> 8, bh = b * 4 + h;
    const float qraw = bf2f(P[(size_t)t * PP + C_MQ + h * 64 + lane]);
    const float qh = qraw * __builtin_amdgcn_rsqf(wave_sum(qraw * qraw) * (1.0f / 64) + EPS) * A.in[12][lane];
    qs[lane] = qh;
    float mygate = -INFINITY;
    for (int j = 0; j < own; ++j) { const float g = wave_sum(qh * KM[((size_t)bh * 32 + j) * 64 + lane]); if (lane == j) mygate = g; }
    const int nsel = own < 3 ? own : 3;
    int sel0 = 0, sel1 = 0, sel2 = 0;
#pragma unroll
    for (int r = 0; r < 3; ++r) {
        if (r < nsel) {
            const float mx = wave_max(mygate);
            const unsigned long long bal = __ballot(mygate == mx);
            const int idx = __builtin_ctzll(bal);
            if (r == 0) sel0 = idx; else if (r == 1) sel1 = idx; else sel2 = idx;
            if (lane == idx) mygate = -INFINITY;
        }
    }
#define SELBLK(bi) (((bi) >= nsel) ? own : ((bi) == 0 ? sel0 : ((bi) == 1 ? sel1 : sel2)))
    const float slope = exp2f(-2.0f * (float)(h + 1));
    asm volatile("s_waitcnt lgkmcnt(0)" ::: "memory");
    float m = -INFINITY;
    const int nblk = nsel + 1;
    for (int bi = 0; bi < nblk; ++bi) {
        const int blk = SELBLK(bi);
        for (int kc = 0; kc < 4; ++kc) {
            const int key = blk * 256 + kc * 64 + lane;
            const u32x4* kp = (const u32x4*)(KNM + ((size_t)bh * SEQ + key) * 64);
            float dot = 0.f;
#pragma unroll
            for (int c = 0; c < 8; ++c) { const u32x4 w = kp[c];
                dot += qs[c * 8 + 0] * bflo(w.x) + qs[c * 8 + 1] * bfhi(w.x) + qs[c * 8 + 2] * bflo(w.y) + qs[c * 8 + 3] * bfhi(w.y)
                     + qs[c * 8 + 4] * bflo(w.z) + qs[c * 8 + 5] * bfhi(w.z) + qs[c * 8 + 6] * bflo(w.w) + qs[c * 8 + 7] * bfhi(w.w); }
            float s = dot * 0.125f - slope * (float)(tl - key);
            if (key > tl) s = -INFINITY;
            sc[bi * 256 + kc * 64 + lane] = s; m = fmaxf(m, s);
        }
    }
    m = wave_max(m);
    float l = 0.f;
    for (int i = lane; i < nblk * 256; i += 64) { const float p = __expf(sc[i] - m); sc[i] = p; l += p; }
    l = wave_sum(l);
    asm volatile("s_waitcnt lgkmcnt(0)" ::: "memory");
    float o = 0.f;
    for (int bi = 0; bi < nblk; ++bi) {
        const int blk = SELBLK(bi);
        const bf16_t* vp = P + ((size_t)b * SEQ + blk * 256) * PP + C_MV + h * 64 + lane;
#pragma unroll 8
        for (int k = 0; k < 256; ++k) o += sc[bi * 256 + k] * bf2f(vp[(size_t)k * PP]);
    }
    P[(size_t)t * PP + 512 + h * 64 + lane] = (bf16_t)f2bf(o / l);
}
__device__ __forceinline__ void naive_mem_query(Frame& F, const Args& A, int t, int h, LAS float* sc, LAS float* qs) {
    unsigned char* ws = F.ws; const int lane = F.lane;
    bf16_t* P = (bf16_t*)(ws + WS_C);
    const float* KV = (const float*)(ws + WS_KVMEM);
    const int b = t >> 13;
    const float qraw = bf2f(P[(size_t)t * PP + C_CQ + h * 64 + lane]);
    const float qh = qraw * __builtin_amdgcn_rsqf(wave_sum(qraw * qraw) * (1.0f / 64) + EPS) * A.in[16][lane];
    qs[lane] = qh;
    const float* kg = A.in[17];
    asm volatile("s_waitcnt lgkmcnt(0)" ::: "memory");
    float m = -INFINITY;
    for (int kc = 0; kc < 4; ++kc) {
        const int key = kc * 64 + lane;
        const f32x4* kp = (const f32x4*)(KV + ((size_t)b * MEMT + key) * 512 + h * 64);
        float dot = 0.f, s2 = 0.f;
#pragma unroll
        for (int c = 0; c < 16; ++c) { const f32x4 w = kp[c];
            dot += qs[c * 4 + 0] * w[0] * kg[c * 4 + 0] + qs[c * 4 + 1] * w[1] * kg[c * 4 + 1] + qs[c * 4 + 2] * w[2] * kg[c * 4 + 2] + qs[c * 4 + 3] * w[3] * kg[c * 4 + 3];
            s2 += (w[0] * w[0] + w[1] * w[1]) + (w[2] * w[2] + w[3] * w[3]); }
        const float s = dot * __builtin_amdgcn_rsqf(s2 * (1.0f / 64) + EPS) * 0.125f;
        sc[key] = s; m = fmaxf(m, s);
    }
    m = wave_max(m);
    float l = 0.f;
    for (int i = lane; i < 256; i += 64) { const float p = __expf(sc[i] - m); sc[i] = p; l += p; }
    l = wave_sum(l);
    asm volatile("s_waitcnt lgkmcnt(0)" ::: "memory");
    float o = 0.f;
    const float* vp = KV + (size_t)b * MEMT * 512 + 256 + h * 64 + lane;
#pragma unroll 8
    for (int k = 0; k < 256; ++k) o += sc[k] * vp[(size_t)k * 512];
    P[(size_t)t * PP + 768 + h * 64 + lane] = (bf16_t)f2bf(o / l);
}

__device__ __forceinline__ void p4b_naive(Frame& F, const Args& A, int pass) {
    const int bx = blockIdx.x;
#if GDN_NAIVE
    if (bx < 16) { naive_gdn(F, A, bx >> 2, bx & 3); return; }
#else
    if (bx < 16 && !(PROBE_DUP == 51 && pass == 1)) { gdn_scan(F, A, bx >> 2, bx & 3); }
#if HELP2
    else if (bx < 24 && !(PROBE_DUP == 51 && pass == 1)) { scan_helper(F, bx - 16, 0); }
#else
    else if (bx < 16 + 16 * NHELP && !(PROBE_DUP == 51 && pass == 1)) { scan_helper(F, (bx - 16) & 15, (bx - 16) >> 4); }
#endif
#endif
#if !GDN_NAIVE
    if (!(PROBE_DUP == 51 && pass == 1)) {
        LAS unsigned* qw = (LAS unsigned*)(F.lds + 140000);
        unsigned* head = (unsigned*)(F.ws + WS_CTL) + CW_PQ;
        u32x4 praw[11]; float pa = 0.f, pb = 0.f; int cw_head = -1;
#define PREP_ITEM(q_) ((((q_) & 15) >> 2) * 128 + ((q_) >> 4)) * 4 + ((q_) & 3)
        __syncthreads(); if (F.tid == 0) *qw = atomicAdd(head, 1u); __syncthreads();
        int cur = __builtin_amdgcn_readfirstlane((int)*qw);
        if (cur < N_PREP) gdn_prep_fetch(F, PREP_ITEM(cur), praw, pa, pb);
        while (cur < N_PREP) {
            __syncthreads(); if (F.tid == 0) *qw = atomicAdd(head, 1u); __syncthreads();
            const int nxt = __builtin_amdgcn_readfirstlane((int)*qw);
            gdn_prep_item(F, A, PREP_ITEM(cur), nxt < N_PREP ? PREP_ITEM(nxt) : (1 << 30), praw, pa, pb, cw_head);
            cur = nxt;
        }
#undef PREP_ITEM
    }
#endif
#if !ATTN_NAIVE
    p4b_attn(F, A, (PROBE_DUP == 51) ? pass : 0); return;
#endif
    LAS float* sc = (LAS float*)F.lds + F.wave * 1152;
    LAS float* qs = sc + 1024;
    const int w = bx - 16, NW = F.G - 16;
    const int NQ = T * 4 / 8;
    for (int it = w; it < 2 * NQ; it += NW) {
        const int kind = it >= NQ; const int q = (kind ? it - NQ : it) * 8 + F.wave;
        if (kind) naive_mem_query(F, A, q >> 2, q & 3, sc, qs); else naive_moba_query(F, A, q >> 2, q & 3, sc, qs);
    }
}

__global__ void __launch_bounds__(NTHREADS, 2) mk_fwd(Args args) {
    extern __shared__ __attribute__((aligned(16))) unsigned char lds_raw[];
    Frame F;
    F.lds = (LAS unsigned char*)lds_raw;
    F.tid = threadIdx.x; F.lane = F.tid & 63; F.wave = __builtin_amdgcn_readfirstlane(F.tid >> 6);
    F.G = gridDim.x; { const int bx = blockIdx.x; F.vcu = (F.G % 8 == 0) ? (bx % 8) * (F.G / 8) + bx / 8 : bx; }
    F.out = args.out; F.ws = args.ws;
    unsigned char* ws = args.ws;
    const int lo = args.ph_lo, hi = args.ph_hi;
#define IN(k) (lo <= (k) && (k) < hi)
#if USE_CG_SYNC
#define SEAM(k) do { if (IN(k) && IN((k) + 1)) { cg::this_grid().sync(); } } while (0)
#else
    { volatile LAS unsigned* st = (volatile LAS unsigned*)(F.lds + LDS_ST_OFF); if (F.tid < 4) st[F.tid] = 0u; }
    __syncthreads();
    XcdBarrier bar = xcd_barrier_post((unsigned*)(ws + WS_CTL) + CW_BAR, (volatile LAS unsigned*)(F.lds + LDS_ST_OFF));
#define SEAM(k) do { if (IN(k) && IN((k) + 1)) { xcd_barrier(bar); } } while (0)
#endif
#define PH_BEGIN(k) for (int _r = 0; _r < ((PROBE_DUP == (k) || (PROBE_DUP == 51 && (k) == 5)) ? 2 : 1); ++_r) { if (_r) xcd_barrier(bar);
#define PH_END }
    float* ss = (float*)(ws + WS_SS);
    bf16_t* XB = (bf16_t*)(ws + WS_XB);
    bf16_t* PC = (bf16_t*)(ws + WS_C);

    PH_BEGIN(0) if (IN(0)) { p0_prologue(F, args); }
    PH_END
    SEAM(0);
#if PROBE_DUP == 61
    { pg8::Gemm g{XB, (const bf16_t*)(ws + WS_WGU1), T, NGU, DM, DM}; pg8::StaticOrder S; S.init(T, NGU, F.G, (int)blockIdx.x);
      pg8::EpiNullP E{(float*)(ws + WS_CTL) + 60000}; pg8::gemm_phase<pg8::EpiNullP, true>(F.lds, g, S, E); xcd_barrier(bar); }
#endif
    PH_BEGIN(1) if (IN(1)) {
        pg8::Gemm g{XB, (const bf16_t*)(ws + WS_WGU1), T, NGU, DM, DM}; pg8::StaticOrder S; S.init(T, NGU, F.G, (int)blockIdx.x);
        pg8::EpiSwiGLU E{PC, ss};
        pg8::gemm_phase<pg8::EpiSwiGLU, true>(F.lds, g, S, E, ss);
    }
    PH_END
    SEAM(1);
#if PROBE_DUP == 62
    { pg8::Gemm g{PC, (const bf16_t*)(ws + WS_WD1), T, DM, FF, FF}; pg8::StaticOrder S; S.init(T, DM, F.G, (int)blockIdx.x);
      pg8::EpiNullN E{(float*)(ws + WS_CTL) + 60000}; pg8::gemm_phase<pg8::EpiNullN, true>(F.lds, g, S, E); xcd_barrier(bar); }
#endif
    PH_BEGIN(2) if (IN(2)) {
        pg8::Gemm g{PC, (const bf16_t*)(ws + WS_WD1), T, DM, FF, FF}; pg8::StaticOrder S; S.init(T, DM, F.G, (int)blockIdx.x);
        pg8::EpiResid<1> E{nullptr, F.out, XB, ss, 0.5f};
        pg8::gemm_phase<pg8::EpiResid<1>, true>(F.lds, g, S, E);
    }
    PH_END
    SEAM(2);
    PH_BEGIN(3) if (IN(3)) {
        pg8::Gemm g{XB, (const bf16_t*)(ws + WS_WIN), T, NIN, DM, DM}; pg8::StaticOrder S; S.init(T, NIN, F.G, (int)blockIdx.x);
        pg8::EpiWin E{PC, (float*)(ws + WS_AB), ss};
        pg8::gemm_phase<pg8::EpiWin, true>(F.lds, g, S, E, ss);
        {
            pg8::Gemm g2{(const bf16_t*)(ws + WS_MEMB), (const bf16_t*)(ws + WS_WKV), BATCH * MEMT, 512, DM, DM}; pg8::StaticOrder S2; S2.init(BATCH * MEMT, 512, 8, (int)blockIdx.x - (F.G - 8));
            pg8::EpiKV E2{(float*)(ws + WS_KVMEM), (const float*)(ws + WS_RSTDM)};
            pg8::gemm_phase<pg8::EpiKV, false>(F.lds, g2, S2, E2);
        }
        {
            const int rem = ((T / 256) * (NIN / 256)) % F.G; int lo = rem, hi = F.G - 8; if (hi - lo < 32) { lo = 0; hi = F.G; }
            const int c = (int)blockIdx.x;
            if (c >= lo && c < hi) tr_weights<1>(F, args, (c - lo) * NWAVES + F.wave, (hi - lo) * NWAVES);
        }
    }
    PH_END
    SEAM(3);
    PH_BEGIN(4) if (IN(4)) {
#if ATTN_NAIVE
        p4a_naive(F, args);
#else
        for (int it = F.vcu; it < 528; it += F.G) img_item(F, args, it);
#endif
    }
    PH_END
    SEAM(4);
    PH_BEGIN(5) if (IN(5)) { p4b_naive(F, args, _r); }
    PH_END
    SEAM(5);
    PH_BEGIN(6) if (IN(6)) {
        pg8::Gemm g{PC, (const bf16_t*)(ws + WS_WOUT), T, DM, DM, PP}; pg8::StaticOrder S; S.init(T, DM, F.G, (int)blockIdx.x);
        pg8::EpiResid<1> E{nullptr, F.out, XB, ss, 1.0f};
        pg8::gemm_phase<pg8::EpiResid<1>, true>(F.lds, g, S, E);
    }
    PH_END
    SEAM(6);
    PH_BEGIN(7) if (IN(7)) {
        pg8::Gemm g{XB, (const bf16_t*)(ws + WS_WGU2), T, NGU, DM, DM}; pg8::StaticOrder S; S.init(T, NGU, F.G, (int)blockIdx.x);
        pg8::EpiSwiGLU E{PC, ss};
        pg8::gemm_phase<pg8::EpiSwiGLU, true>(F.lds, g, S, E, ss);
    }
    PH_END
    SEAM(7);
    PH_BEGIN(8) if (IN(8)) {
        pg8::Gemm g{PC, (const bf16_t*)(ws + WS_WD2), T, DM, FF, FF}; pg8::StaticOrder S; S.init(T, DM, F.G, (int)blockIdx.x);
        pg8::EpiResid<2> E{nullptr, F.out, XB, ss, 0.5f};
        pg8::gemm_phase<pg8::EpiResid<2>, true>(F.lds, g, S, E);
    }
    PH_END
#undef IN
#undef SEAM
}

constexpr int N_PHASES = 9;
extern "C" void kernel_launch(void* const* d_in, const int* in_sizes, int n_in, void* d_out, int out_size, void* d_ws, size_t ws_size, hipStream_t stream) {
    static int grid = 0;
    if (grid == 0) {
        if (n_in != 23 || out_size != T * DM || ws_size < WS_END) { fprintf(stderr, "kernel_launch: unexpected shapes (n_in %d out %d ws %zu)\n", n_in, out_size, ws_size); grid = -1; return; }
        int dev = 0, cus = 0, per_cu = 0;
        (void)hipGetDevice(&dev); (void)hipDeviceGetAttribute(&cus, hipDeviceAttributeMultiprocessorCount, dev);
        (void)hipFuncSetAttribute((const void*)mk_fwd, hipFuncAttributeMaxDynamicSharedMemorySize, LDS_BYTES);
        (void)hipOccupancyMaxActiveBlocksPerMultiprocessor(&per_cu, (const void*)mk_fwd, NTHREADS, LDS_BYTES);
        (void)hipGetLastError();
        if (per_cu < 1) { fprintf(stderr, "kernel_launch: occupancy query says %d blocks/CU\n", per_cu); }
        grid = cus;
        if (grid != 256) fprintf(stderr, "kernel_launch: %d CUs (expected 256)\n", grid);
    }
    if (grid < 0) return;
    (void)hipMemsetAsync((char*)d_ws + WS_CTL, 0, 81920, stream);
    Args a{};
    for (int i = 0; i < 23; ++i) a.in[i] = (const float*)d_in[i];
    a.out = (float*)d_out; a.ws = (unsigned char*)d_ws;
    if (MK_N_LAUNCHES == 1) {
        a.ph_lo = 0; a.ph_hi = N_PHASES;
#if USE_CG_SYNC
        void* kargs[] = {&a};
        hipError_t e = hipLaunchCooperativeKernel((const void*)mk_fwd, dim3(grid), dim3(NTHREADS), kargs, LDS_BYTES, stream);
        if (e != hipSuccess) fprintf(stderr, "cooperative launch failed: %s\n", hipGetErrorString(e));
#else
        hipLaunchKernelGGL(mk_fwd, dim3(grid), dim3(NTHREADS), LDS_BYTES, stream, a);
#endif
    } else {
        for (int p = 0; p < N_PHASES; ++p) {
            a.ph_lo = p; a.ph_hi = p + 1;
            hipLaunchKernelGGL(mk_fwd, dim3(grid), dim3(NTHREADS), LDS_BYTES, stream, a);
        }
    }
}
```

```cpp
#include <hip/hip_runtime.h>
#include <hip/hip_cooperative_groups.h>
#include <cstdio>
#include <cstdint>
namespace cg = cooperative_groups;

#ifndef PROBE_DUP
#define PROBE_DUP -1
#endif
#ifndef NHELP
#define NHELP 1
#define HELP2 1
#endif
#ifndef USE_CG_SYNC
#define USE_CG_SYNC 0
#endif
#ifndef GDN_NAIVE
#define GDN_NAIVE 0
#endif
#ifndef ATTN_NAIVE
#define ATTN_NAIVE 0
#endif
#ifndef MK_N_LAUNCHES
#define MK_N_LAUNCHES 1
#endif

constexpr int BATCH = 4, SEQ = 8192, DM = 1024, T = BATCH * SEQ, FF = 2816, MEMT = 256;
constexpr int NGU = 2 * FF;
constexpr int NINR = 3072;
constexpr int NIN = 3328;
constexpr int PP = NINR;
constexpr float EPS = 1e-6f;
constexpr int C_GQ = 0, C_GK = 512, C_GV = 1024, C_GZ = 1536, C_MQ = 2048, C_MK = 2304, C_MV = 2560, C_CQ = 2816;

constexpr size_t MiB = 1u << 20;
constexpr size_t WS_CTL = 0, CTL_BYTES = 1 * MiB;
constexpr size_t WS_WGU1 = 1 * MiB, WS_WD1 = 12 * MiB, WS_WIN = 18 * MiB, WS_WOUT = 25 * MiB, WS_WGU2 = 27 * MiB, WS_WD2 = 38 * MiB, WS_WKV = 44 * MiB;
constexpr size_t WS_SS = 45 * MiB;
constexpr size_t WS_RSTDM = 47 * MiB;
constexpr size_t WS_AB = 48 * MiB;
constexpr size_t WS_KMEAN = 49 * MiB;
constexpr size_t WS_KVMEM = 50 * MiB;
constexpr size_t WS_MEMB = 52 * MiB;
constexpr size_t WS_GB = 54 * MiB;
constexpr size_t WS_GG = 54 * MiB + 512 * 1024;
constexpr size_t WS_XB = 56 * MiB;
constexpr size_t WS_KNM = 56 * MiB;
constexpr size_t WS_C = 120 * MiB;
constexpr size_t WS_G = 312 * MiB;
constexpr size_t WS_GQ = 312 * MiB, WS_GK = 344 * MiB, WS_GV = 376 * MiB;
constexpr size_t WS_END = 494 * MiB;

constexpr int NWAVES = 8, NTHREADS = 512;
constexpr int LDS_BYTES = 163840;

typedef unsigned short bf16_t;
typedef short bf16x8 __attribute__((ext_vector_type(8)));
typedef float f32x4 __attribute__((ext_vector_type(4)));
typedef float f32x2 __attribute__((ext_vector_type(2)));
typedef unsigned u32x4 __attribute__((ext_vector_type(4)));
typedef unsigned u32x2 __attribute__((ext_vector_type(2)));
#define LAS __attribute__((address_space(3)))
typedef float f32x16 __attribute__((ext_vector_type(16)));
typedef __bf16 bf16x2_t __attribute__((ext_vector_type(2)));
__device__ __forceinline__ unsigned cvtpk(float lo, float hi) { f32x2 v = {lo, hi}; bf16x2_t b = __builtin_convertvector(v, bf16x2_t); return __builtin_bit_cast(unsigned, b); }

__device__ __forceinline__ unsigned f2bf(float f) { unsigned u = __builtin_bit_cast(unsigned, f); return (u + 0x7fffu + ((u >> 16) & 1u)) >> 16; }
__device__ __forceinline__ unsigned pk2(float lo, float hi) { return f2bf(lo) | (f2bf(hi) << 16); }
__device__ __forceinline__ float bf2f(unsigned short h) { return __builtin_bit_cast(float, (unsigned)h << 16); }
__device__ __forceinline__ float bflo(unsigned w) { return __builtin_bit_cast(float, w << 16); }
__device__ __forceinline__ float bfhi(unsigned w) { return __builtin_bit_cast(float, w & 0xffff0000u); }
__device__ __forceinline__ float wave_sum(float v) {
#pragma unroll
    for (int o = 1; o < 64; o <<= 1) v += __shfl_xor(v, o);
    return v;
}
__device__ __forceinline__ float wave_max(float v) {
#pragma unroll
    for (int o = 1; o < 64; o <<= 1) v = fmaxf(v, __shfl_xor(v, o));
    return v;
}

namespace pg8 {
constexpr int BM = 256, BK = 64, HALF = 128, HTB = HALF * BK * 2, STAGE_BYTES = 8 * HTB, NXCD = 8, WGM = 4;
__host__ __device__ __forceinline__ int lds_byte(int r, int c) { const int st = (r >> 4) * 2 + (c >> 5), rr = r & 15, cc = c & 31, ob = rr * 64 + cc * 2; return st * 1024 + (ob ^ (((ob >> 9) & 1) << 5)); }
__host__ __device__ __forceinline__ void stage_rc(int b, int& R, int& C) { const int st = b / 1024, sb = b % 1024, swz = sb ^ (((sb >> 9) & 1) << 5); R = (st >> 1) * 16 + swz / 64; C = (st & 1) * 32 + (swz % 64) / 2; }
__host__ __device__ __forceinline__ int perm32(int rho) { const int n = rho >> 4, i = rho & 15; return 8 * (i >> 2) + 4 * n + (i & 3); }

struct Unit { int pm, pn; };
struct Gemm { const bf16_t* A; const bf16_t* Bt; int M, N, K, lda; };

struct StaticOrder {
    int nM, nN, nwg, G, c;
    __device__ void init(int M, int N, int G_, int c_) { nM = M / BM; nN = N / BM; nwg = nM * nN; G = G_; c = c_; }
    __device__ bool next(int i, Unit& u) const {
        const long L = (long)i * G + c; if (c < 0 || L >= nwg) return false;
        int wgid = (int)L; { const int q = nwg / NXCD, r = nwg % NXCD, xcd = wgid % NXCD, off = wgid / NXCD; wgid = (xcd < r ? xcd * (q + 1) : r * (q + 1) + (xcd - r) * q) + off; }
        const int nig = WGM * nN, gid = wgid / nig, fm = gid * WGM, gsz = (nM - fm) < WGM ? (nM - fm) : WGM;
        u.pm = fm + ((wgid % nig) % gsz); u.pn = (wgid % nig) / gsz; return true;
    }
};

__device__ __forceinline__ void rstd_table(LAS unsigned char* lds, const float* ss, const StaticOrder& S);
template <class Epi, bool ALIGN_EPI>
__device__ __forceinline__ void gemm_phase(LAS unsigned char* lds, const Gemm g, const StaticOrder& S, const Epi& E, const float* tab_ss = nullptr) {
    int tid = threadIdx.x; asm volatile("" : "+v"(tid));
    const int wid = __builtin_amdgcn_readfirstlane(tid >> 6), lane = tid & 63, wr = wid >> 2, wc = wid & 3, fr = lane & 15, fq = lane >> 4;
    const int K = g.K, nt = K / BK, lda = g.lda;
    unsigned voffA[2], voffB[2];
#pragma unroll
    for (int i = 0; i < 2; ++i) { int R, C; stage_rc(tid * 16 + i * 8192, R, C); const int Rb = (int)Epi::PERM == 2 ? (((R >> 5) << 6) + perm32(R & 31)) : (Epi::PERM ? ((R & ~31) + perm32(R & 31)) : R);
        voffA[i] = (unsigned)(R * lda + C) * 2u; voffB[i] = (unsigned)(Rb * K + C) * 2u; }
    const size_t kstep = (size_t)(BK * 2);
    const size_t hstepA = (size_t)HALF * lda * 2, hstepB = (size_t)((int)Epi::PERM == 2 ? 32 : HALF) * K * 2;
    const size_t tstepA = 2 * hstepA, tstepB = (size_t)BM * K * 2;
    const unsigned ldsw = (unsigned)wid * 1024u;
    const int aoff = lds_byte(wr * 64 + fr, fq * 8), boff = lds_byte(wc * 32 + fr, fq * 8);
#define PG8_SA(b, h) (((b) * 2 + (h)) * HTB)
#define PG8_SB(b, h) ((4 + (b) * 2 + (h)) * HTB)
#define PG8_STAGE(bufoff, gbase, voff) do { _Pragma("unroll") for (int _i = 0; _i < 2; ++_i) \
        __builtin_amdgcn_global_load_lds((const unsigned*)((const char*)(gbase) + (voff)[_i]), (LAS unsigned*)(lds + (bufoff) + ldsw + _i * 8192), 16, 0, 0); } while (0)
#define PG8_LDA(dst, b, h) do { _Pragma("unroll") for (int m = 0; m < 4; ++m) _Pragma("unroll") for (int k = 0; k < 2; ++k) dst[m][k] = *(const LAS bf16x8*)(lds + PG8_SA(b, h) + aoff + m * 2048 + k * 1024); } while (0)
#define PG8_LDB(dst, b, h) do { _Pragma("unroll") for (int n = 0; n < 2; ++n) _Pragma("unroll") for (int k = 0; k < 2; ++k) dst[n][k] = *(const LAS bf16x8*)(lds + PG8_SB(b, h) + boff + n * 2048 + k * 1024); } while (0)
#define PG8_MMA(ai, bj, At, Bt) do { __builtin_amdgcn_s_setprio(1); _Pragma("unroll") for (int m = 0; m < 4; ++m) _Pragma("unroll") for (int n = 0; n < 2; ++n) _Pragma("unroll") for (int k = 0; k < 2; ++k) \
        acc[ai][bj][m][n] = __builtin_amdgcn_mfma_f32_16x16x32_bf16(Bt[n][k], At[m][k], acc[ai][bj][m][n], 0, 0, 0); __builtin_amdgcn_s_setprio(0); } while (0)
#define PG8_WAIT_V(n) asm volatile("s_waitcnt vmcnt(" #n ")" ::: "memory")
#define PG8_WAIT_L(n) asm volatile("s_waitcnt lgkmcnt(" #n ")" ::: "memory")
#define PG8_BAR __builtin_amdgcn_s_barrier()
#define PG8_SCHED __builtin_amdgcn_sched_barrier(0)
    Unit cur, nxt; int ui = 0;
    if (!S.next(0, cur)) return;
    f32x4 acc[2][2][4][2];
#pragma unroll
    for (int a = 0; a < 2; ++a)
#pragma unroll
        for (int b = 0; b < 2; ++b)
#pragma unroll
            for (int m = 0; m < 4; ++m)
#pragma unroll
                for (int n = 0; n < 2; ++n) acc[a][b][m][n] = (f32x4){0.f, 0.f, 0.f, 0.f};
    bf16x8 At[4][2], B0[2][2], B1[2][2];
    const char* cA = (const char*)g.A + (size_t)cur.pm * tstepA; const char* cB = (const char*)g.Bt + (size_t)cur.pn * tstepB;
    PG8_STAGE(PG8_SB(0, 0), cB, voffB); PG8_STAGE(PG8_SB(0, 1), cB + hstepB, voffB); PG8_STAGE(PG8_SA(0, 0), cA, voffA); PG8_STAGE(PG8_SA(0, 1), cA + hstepA, voffA);
    if (tab_ss) rstd_table(lds, tab_ss, S);
    if (wr == 1) PG8_BAR;
    PG8_WAIT_V(2); PG8_BAR;
    PG8_STAGE(PG8_SB(1, 0), cB + kstep, voffB); PG8_STAGE(PG8_SA(1, 0), cA + kstep, voffA); PG8_STAGE(PG8_SB(1, 1), cB + hstepB + kstep, voffB);
    PG8_WAIT_V(6); PG8_BAR;
    for (;;) {
        const bool has_next = S.next(ui + 1, nxt);
        const char* nA = has_next ? (const char*)g.A + (size_t)nxt.pm * tstepA : cA; const char* nB = has_next ? (const char*)g.Bt + (size_t)nxt.pn * tstepB : cB;
        for (int t = 0; t < nt; t += 2) {
            const bool last = (t == nt - 2);
            const char* a1 = cA + (size_t)(t + 1) * kstep;
            const char* a2 = last ? nA : cA + (size_t)(t + 2) * kstep; const char* b2 = last ? nB : cB + (size_t)(t + 2) * kstep;
            const char* a3 = a2 + kstep; const char* b3 = b2 + kstep;
            PG8_LDB(B0, 0, 0); PG8_LDB(B1, 0, 1); PG8_SCHED; PG8_LDA(At, 0, 0); PG8_STAGE(PG8_SA(1, 1), a1 + hstepA, voffA);
            PG8_WAIT_V(8); PG8_WAIT_L(0); PG8_BAR; PG8_MMA(0, 0, At, B0); PG8_MMA(0, 1, At, B1); PG8_BAR; PG8_SCHED;
            PG8_LDA(At, 0, 1); PG8_STAGE(PG8_SB(0, 0), b2, voffB); PG8_STAGE(PG8_SB(0, 1), b2 + hstepB, voffB); PG8_STAGE(PG8_SA(0, 0), a2, voffA);
            PG8_WAIT_V(8); PG8_WAIT_L(0); PG8_BAR; PG8_MMA(1, 0, At, B0); PG8_MMA(1, 1, At, B1); PG8_BAR; PG8_SCHED;
            PG8_LDB(B0, 1, 0); PG8_LDB(B1, 1, 1); PG8_SCHED; PG8_LDA(At, 1, 0); PG8_STAGE(PG8_SA(0, 1), a2 + hstepA, voffA);
            PG8_WAIT_V(8); PG8_WAIT_L(0); PG8_BAR; PG8_MMA(0, 0, At, B0); PG8_MMA(0, 1, At, B1); PG8_BAR; PG8_SCHED;
            PG8_LDA(At, 1, 1); PG8_STAGE(PG8_SB(1, 0), b3, voffB); PG8_STAGE(PG8_SB(1, 1), b3 + hstepB, voffB); PG8_STAGE(PG8_SA(1, 0), a3, voffA);
            PG8_WAIT_V(8); PG8_WAIT_L(0); PG8_BAR; PG8_MMA(1, 0, At, B0); PG8_MMA(1, 1, At, B1); PG8_BAR; PG8_SCHED;
        }
        if constexpr (ALIGN_EPI) { if (wr == 0) PG8_BAR; }
        E(acc, cur, wr, wc, fr, fq, ui, lds);
        if (!has_next) break;
#pragma unroll
        for (int a = 0; a < 2; ++a)
#pragma unroll
            for (int b = 0; b < 2; ++b)
#pragma unroll
                for (int m = 0; m < 4; ++m)
#pragma unroll
                    for (int n = 0; n < 2; ++n) acc[a][b][m][n] = (f32x4){0.f, 0.f, 0.f, 0.f};
        cur = nxt; cA = nA; cB = nB; ++ui;
        if constexpr (ALIGN_EPI) { if (wr == 1) PG8_BAR; }
    }
    PG8_WAIT_V(0);
    if constexpr (!ALIGN_EPI) { if (wr == 0) PG8_BAR; }
    PG8_BAR;
#undef PG8_SA
#undef PG8_SB
#undef PG8_STAGE
#undef PG8_LDA
#undef PG8_LDB
#undef PG8_MMA
#undef PG8_WAIT_V
#undef PG8_WAIT_L
#undef PG8_BAR
#undef PG8_SCHED
}

__device__ __forceinline__ float row_rstd(const float* ss, int row) {
    const f32x4* p = (const f32x4*)(ss + (size_t)row * 16);
    const f32x4 a = p[0], b = p[1], c = p[2], d = p[3];
    const float s = ((a[0] + a[1]) + (a[2] + a[3])) + ((b[0] + b[1]) + (b[2] + b[3])) + ((c[0] + c[1]) + (c[2] + c[3])) + ((d[0] + d[1]) + (d[2] + d[3]));
    return __builtin_amdgcn_rsqf(s * (1.0f / DM) + EPS);
}
constexpr int RSTD_TAB_OFF = 131072;
__device__ __forceinline__ void rows_rstd8(LAS unsigned char* lds, int ui, int rl0  , float (&rs)[2][4]) {
    const LAS float* tab = (const LAS float*)(lds + RSTD_TAB_OFF) + ui * 256 + rl0;
#pragma unroll
    for (int ai = 0; ai < 2; ++ai)
#pragma unroll
        for (int m = 0; m < 4; ++m) rs[ai][m] = tab[ai * HALF + m * 16];
}
__device__ __forceinline__ float silu_mul(float g, float u) { return g * __builtin_amdgcn_rcpf(1.0f + __expf(-g)) * u; }

struct EpiSwiGLU {
    static constexpr bool PERM = true;
    bf16_t* H; const float* ss;
    __device__ __forceinline__ void operator()(const f32x4 (&acc)[2][2][4][2], const Unit& u, int wr, int wc, int fr, int fq, int ui, LAS unsigned char* lds) const {
        float rs8[2][4]; rows_rstd8(lds, ui, wr * 64 + fr, rs8);
#pragma unroll
        for (int ai = 0; ai < 2; ++ai)
#pragma unroll
            for (int m = 0; m < 4; ++m) {
                const int row = u.pm * BM + ai * HALF + wr * 64 + m * 16 + fr;
                const float rs = rs8[ai][m];
                u32x4 w;
                { const f32x4 g = acc[ai][0][m][0] * rs, up = acc[ai][1][m][0] * rs; w.x = cvtpk(silu_mul(g[0], up[0]), silu_mul(g[1], up[1])); w.y = cvtpk(silu_mul(g[2], up[2]), silu_mul(g[3], up[3])); }
                { const f32x4 g = acc[ai][0][m][1] * rs, up = acc[ai][1][m][1] * rs; w.z = cvtpk(silu_mul(g[0], up[0]), silu_mul(g[1], up[1])); w.w = cvtpk(silu_mul(g[2], up[2]), silu_mul(g[3], up[3])); }
                *(u32x4*)(H + (size_t)row * FF + u.pn * 128 + wc * 32 + 8 * fq) = w;
            }
    }
};
template <int MODE> struct EpiResid {
    static constexpr int PERM = 2;
    const float* xin; float* out; bf16_t* xb; float* ss; float scale;
    __device__ __forceinline__ void operator()(const f32x4 (&acc)[2][2][4][2], const Unit& u, int wr, int wc, int fr, int fq, int ui, LAS unsigned char* lds) const {
        const size_t base = (size_t)(u.pm * BM + wr * 64 + fr) * DM + u.pn * BM + wc * 64 + 8 * fq;
        u32x4 rb[2][4][2];
#pragma unroll
        for (int ai = 0; ai < 2; ++ai)
#pragma unroll
            for (int m = 0; m < 4; ++m)
#pragma unroll
                for (int bj = 0; bj < 2; ++bj) rb[ai][m][bj] = *(const u32x4*)(xb + base + (size_t)(ai * HALF + m * 16) * DM + bj * 32);
#pragma unroll
        for (int ai = 0; ai < 2; ++ai)
#pragma unroll
            for (int m = 0; m < 4; ++m) {
                const size_t off = base + (size_t)(ai * HALF + m * 16) * DM;
                float s = 0.f;
#pragma unroll
                for (int bj = 0; bj < 2; ++bj) {
                    const u32x4 w = rb[ai][m][bj];
                    const f32x4 v0 = (f32x4){bflo(w.x), bfhi(w.x), bflo(w.y), bfhi(w.y)} + acc[ai][bj][m][0] * scale;
                    const f32x4 v1 = (f32x4){bflo(w.z), bfhi(w.z), bflo(w.w), bfhi(w.w)} + acc[ai][bj][m][1] * scale;
                    if (MODE == 2) { *(f32x4*)(out + off + bj * 32) = v0; *(f32x4*)(out + off + bj * 32 + 4) = v1; }
                    else { u32x4 o; o.x = cvtpk(v0[0], v0[1]); o.y = cvtpk(v0[2], v0[3]); o.z = cvtpk(v1[0], v1[1]); o.w = cvtpk(v1[2], v1[3]);
                        *(u32x4*)(xb + off + bj * 32) = o;
                        const float r0 = bflo(o.x), r1 = bfhi(o.x), r2 = bflo(o.y), r3 = bfhi(o.y), r4 = bflo(o.z), r5 = bfhi(o.z), r6 = bflo(o.w), r7 = bfhi(o.w);
                        s += ((r0 * r0 + r1 * r1) + (r2 * r2 + r3 * r3)) + ((r4 * r4 + r5 * r5) + (r6 * r6 + r7 * r7)); }
                }
                if (MODE != 2) { s += __shfl_xor(s, 16); s += __shfl_xor(s, 32); if (fq == 0) ss[(size_t)(u.pm * BM + ai * HALF + wr * 64 + m * 16 + fr) * 16 + u.pn * 4 + wc] = s; }
            }
    }
};
struct EpiWin {
    static constexpr int PERM = 2;
    bf16_t* P; float* AB; const float* ss;
    __device__ __forceinline__ void operator()(const f32x4 (&acc)[2][2][4][2], const Unit& u, int wr, int wc, int fr, int fq, int ui, LAS unsigned char* lds) const {
        float rs8[2][4]; rows_rstd8(lds, ui, wr * 64 + fr, rs8);
#pragma unroll
        for (int ai = 0; ai < 2; ++ai)
#pragma unroll
            for (int m = 0; m < 4; ++m) {
                const int row = u.pm * BM + ai * HALF + wr * 64 + m * 16 + fr;
                const float rs = rs8[ai][m];
                if (u.pn < 12) {
                    const bool gatecol = (u.pn == C_GZ / BM) || (u.pn == C_GZ / BM + 1);
#pragma unroll
                    for (int bj = 0; bj < 2; ++bj) {
                        f32x4 v0 = acc[ai][bj][m][0] * rs, v1 = acc[ai][bj][m][1] * rs;
                        if (gatecol) {
#pragma unroll
                            for (int i = 0; i < 4; ++i) { v0[i] = v0[i] * __builtin_amdgcn_rcpf(1.0f + __expf(-v0[i])); v1[i] = v1[i] * __builtin_amdgcn_rcpf(1.0f + __expf(-v1[i])); }
                        }
                        u32x4 w; w.x = cvtpk(v0[0], v0[1]); w.y = cvtpk(v0[2], v0[3]); w.z = cvtpk(v1[0], v1[1]); w.w = cvtpk(v1[2], v1[3]);
                        *(u32x4*)(P + (size_t)row * PP + u.pn * BM + wc * 64 + bj * 32 + 8 * fq) = w;
                    }
                } else if (wc == 0 && fq == 0) {
                    *(f32x4*)(AB + (size_t)row * 8) = acc[ai][0][m][0] * rs;
                    *(f32x4*)(AB + (size_t)row * 8 + 4) = acc[ai][0][m][1] * rs;
                }
            }
    }
};
struct EpiNullP { static constexpr bool PERM = true; float* sink;
    __device__ __forceinline__ void operator()(const f32x4 (&acc)[2][2][4][2], const Unit& u, int wr, int wc, int fr, int fq, int ui, LAS unsigned char* lds) const {
        float s = 0.f;
#pragma unroll
        for (int ai = 0; ai < 2; ++ai)
#pragma unroll
            for (int bj = 0; bj < 2; ++bj)
#pragma unroll
                for (int m = 0; m < 4; ++m)
#pragma unroll
                    for (int n = 0; n < 2; ++n) s += acc[ai][bj][m][n][0];
        if (s == 123456.789f) sink[0] = s;
    } };
struct EpiNullN { static constexpr bool PERM = false; float* sink;
    __device__ __forceinline__ void operator()(const f32x4 (&acc)[2][2][4][2], const Unit& u, int wr, int wc, int fr, int fq, int ui, LAS unsigned char* lds) const {
        float s = 0.f;
#pragma unroll
        for (int ai = 0; ai < 2; ++ai)
#pragma unroll
            for (int bj = 0; bj < 2; ++bj)
#pragma unroll
                for (int m = 0; m < 4; ++m)
#pragma unroll
                    for (int n = 0; n < 2; ++n) s += acc[ai][bj][m][n][0];
        if (s == 123456.789f) sink[0] = s;
    } };
struct EpiKV {
    static constexpr bool PERM = false;
    float* O; const float* rstdm;
    __device__ __forceinline__ void operator()(const f32x4 (&acc)[2][2][4][2], const Unit& u, int wr, int wc, int fr, int fq, int ui, LAS unsigned char* lds) const {
#pragma unroll
        for (int ai = 0; ai < 2; ++ai)
#pragma unroll
            for (int m = 0; m < 4; ++m) {
                const int row = u.pm * BM + ai * HALF + wr * 64 + m * 16 + fr;
                const float rs = rstdm[row];
                const size_t off = (size_t)row * 512 + u.pn * BM + wc * 32 + 4 * fq;
#pragma unroll
                for (int bj = 0; bj < 2; ++bj)
#pragma unroll
                    for (int n = 0; n < 2; ++n) *(f32x4*)(O + off + bj * HALF + n * 16) = acc[ai][bj][m][n] * rs;
            }
    }
};
__device__ __forceinline__ void rstd_table(LAS unsigned char* lds, const float* ss, const StaticOrder& S) {
    LAS float* tab = (LAS float*)(lds + RSTD_TAB_OFF);
    const int tid = threadIdx.x, half = tid >> 8, rl = tid & 255;
    for (int i = half; i < 12; i += 2) { Unit u; if (!S.next(i, u)) break; tab[i * 256 + rl] = row_rstd(ss, u.pm * BM + rl); }
    __syncthreads();
}
}


#define XB_TMO      128
#define XB_XCNT(j)  (256  + 64 * (j))
#define XB_XSUB(j)  (1280 + 64 * (j))
#define XB_XGEN(j)  (2304 + 64 * (j))
#define XB_TOP      3328
#define XB_TOPGEN   3392
#define XCD_BAR_WORDS 3456
#define XB_SPIN_CAP (1u << 18)
constexpr int CW_BAR = 1024;
constexpr int LDS_ST_OFF = 147440;
__device__ __forceinline__ unsigned xb_ld(unsigned* p)              { return __hip_atomic_load(p, __ATOMIC_RELAXED, __HIP_MEMORY_SCOPE_AGENT); }
__device__ __forceinline__ unsigned xb_add(unsigned* p, unsigned v) { return __hip_atomic_fetch_add(p, v, __ATOMIC_RELAXED, __HIP_MEMORY_SCOPE_AGENT); }
__device__ __forceinline__ unsigned xb_xcc_id() { return (unsigned)__builtin_amdgcn_s_getreg((3 << 11) | 20) & 0xFu; }
#define XB_SPIN(cond, bar) do { unsigned _sp = 0; while (cond) { __builtin_amdgcn_s_sleep(1); \
    if ((++_sp & 255u) == 0u) { if (xb_ld(&(bar)[XB_TMO])) break; if (_sp > XB_SPIN_CAP) { atomicAdd(&(bar)[XB_TMO], 1u); break; } } } } while (0)
struct XcdBarrier { unsigned* bar; unsigned x; volatile LAS unsigned* st; };
__device__ __forceinline__ XcdBarrier xcd_barrier_post(unsigned* bar, volatile LAS unsigned* st) {
    XcdBarrier b; b.bar = bar; b.x = xb_xcc_id(); b.st = st;
    if (threadIdx.x == 0) (void)xb_add(&bar[XB_XCNT(b.x)], 1u);
    return b;
}
__device__ __forceinline__ void xcd_barrier_complete(unsigned* bar, unsigned x, unsigned& nloc, unsigned& nx) {
    const unsigned G = gridDim.x * gridDim.y * gridDim.z;
    unsigned sum, cnt, mine, sp = 0u;
    for (;;) {
        sum = 0u; cnt = 0u; mine = 0u;
#pragma unroll
        for (unsigned j = 0; j < 16; ++j) { const unsigned c = xb_ld(&bar[XB_XCNT(j)]); sum += c; cnt += (c > 0u) ? 1u : 0u; mine = (j == x) ? c : mine; }
        if (sum == G) break;
        __builtin_amdgcn_s_sleep(1);
        if ((++sp & 255u) == 0u) { if (xb_ld(&bar[XB_TMO])) break; if (sp > XB_SPIN_CAP) { atomicAdd(&bar[XB_TMO], 1u); break; } }
    }
    nloc = mine > 0u ? mine : 1u; nx = cnt > 0u ? cnt : 1u;
}
__device__ __forceinline__ void xcd_barrier(const XcdBarrier& b) {
    asm volatile("s_waitcnt vmcnt(0)" ::: "memory");
    __syncthreads();
    if (threadIdx.x == 0) {
        unsigned* bar = b.bar;
        __builtin_amdgcn_s_waitcnt(0);
        unsigned nloc = b.st[0], nx = b.st[1];
        if (nloc == 0u) { xcd_barrier_complete(bar, b.x, nloc, nx); b.st[0] = nloc; b.st[1] = nx; }
        const unsigned old = xb_add(&bar[XB_XSUB(b.x)], 1u);
        const unsigned gen = old / nloc;
        if (old + 1u == (gen + 1u) * nloc) {
            __builtin_amdgcn_fence(__ATOMIC_RELEASE, "agent");
            asm volatile("s_waitcnt vmcnt(0)" ::: "memory");
            const unsigned og = xb_add(&bar[XB_TOP], 1u);
            const unsigned tg = og / nx;
            if (og + 1u == (tg + 1u) * nx) xb_add(&bar[XB_TOPGEN], 1u);
            else XB_SPIN(xb_ld(&bar[XB_TOPGEN]) == tg, bar);
            __builtin_amdgcn_fence(__ATOMIC_ACQUIRE, "agent");
            xb_add(&bar[XB_XGEN(b.x)], 1u);
            asm volatile("s_waitcnt vmcnt(0)" ::: "memory");
        } else {
            asm volatile("buffer_inv sc1" ::: "memory");
            XB_SPIN(xb_ld(&bar[XB_XGEN(b.x)]) == gen, bar);
            asm volatile("s_waitcnt vmcnt(0)" ::: "memory");
        }
    }
    __syncthreads();
}

struct Args;
struct Frame {
    LAS unsigned char* lds;
    int tid, lane, wave, vcu, G;
    float* out; unsigned char* ws;
};
struct Args { const float* in[23]; float* out; unsigned char* ws; int ph_lo, ph_hi; };

template <class SrcCol>
__device__ __forceinline__ void tr_item(const float* W, int ldw, int k0, int d0, SrcCol src, const float* gain, bf16_t* WT, int Kdim, LAS float* scr, int lane) {
    const int dl = lane & 31, sc = src(d0 + dl);
#pragma unroll 8
    for (int i = 0; i < 32; ++i) { const int kk = 2 * i + (lane >> 5);
        float v = 0.f; if (sc >= 0) { v = W[(size_t)(k0 + kk) * ldw + sc]; if (gain) v *= gain[k0 + kk]; }
        scr[kk * 33 + dl] = v; }
    asm volatile("s_waitcnt lgkmcnt(0)" ::: "memory");
    const int c = lane & 7;
#pragma unroll
    for (int j = 0; j < 4; ++j) { const int n = (lane >> 3) + 8 * j; const LAS float* s = scr + (8 * c) * 33 + n;
        u32x4 o; o.x = pk2(s[0 * 33], s[1 * 33]); o.y = pk2(s[2 * 33], s[3 * 33]); o.z = pk2(s[4 * 33], s[5 * 33]); o.w = pk2(s[6 * 33], s[7 * 33]);
        *(u32x4*)(WT + (size_t)(d0 + n) * Kdim + k0 + 8 * c) = o; }
    asm volatile("s_waitcnt lgkmcnt(0)" ::: "memory");
}
__device__ __forceinline__ void tr_item64(const float* W, int ldw, int k0, int d0, int sc0, const float* gain, bf16_t* WT, int Kdim, LAS float* scr, int lane) {
    const int n4 = (lane & 15) * 4;
#pragma unroll 8
    for (int i = 0; i < 16; ++i) { const int kk = 4 * i + (lane >> 4);
        f32x4 v = *(const f32x4*)(W + (size_t)(k0 + kk) * ldw + sc0 + n4); if (gain) v = v * gain[k0 + kk];
        scr[kk * 65 + n4] = v[0]; scr[kk * 65 + n4 + 1] = v[1]; scr[kk * 65 + n4 + 2] = v[2]; scr[kk * 65 + n4 + 3] = v[3]; }
    asm volatile("s_waitcnt lgkmcnt(0)" ::: "memory");
    const int c = lane & 7;
#pragma unroll
    for (int j = 0; j < 8; ++j) { const int n = (lane >> 3) + 8 * j; const LAS float* sp = scr + (8 * c) * 65 + n;
        u32x4 o; o.x = cvtpk(sp[0 * 65], sp[1 * 65]); o.y = cvtpk(sp[2 * 65], sp[3 * 65]); o.z = cvtpk(sp[4 * 65], sp[5 * 65]); o.w = cvtpk(sp[6 * 65], sp[7 * 65]);
        *(u32x4*)(WT + (size_t)(d0 + n) * Kdim + k0 + 8 * c) = o; }
    asm volatile("s_waitcnt lgkmcnt(0)" ::: "memory");
}
struct SrcGU { int up; __device__ int operator()(int d) const { const int pn = d >> 8, r = d & 255; return ((r >> 7) == up) ? pn * 128 + (r & 127) : -2; } };
struct SrcId { __device__ int operator()(int d) const { return d; } };
struct SrcWin { __device__ int operator()(int d) const { if (d < 2048) return d; if (d < 3072) return d + 8; if (d < 3080) return d - 3072 + 2048; return -1; } };

__device__ __forceinline__ float row_to_bf16(const float* xrow, bf16_t* orow, int lane) {
    const f32x4* xr = (const f32x4*)xrow + lane; f32x4 v[4]; float s = 0.f;
#pragma unroll
    for (int j = 0; j < 4; ++j) { v[j] = xr[64 * j]; s += (v[j][0] * v[j][0] + v[j][1] * v[j][1]) + (v[j][2] * v[j][2] + v[j][3] * v[j][3]); }
    u32x2* o8 = (u32x2*)orow + lane;
#pragma unroll
    for (int j = 0; j < 4; ++j) { u32x2 w; w.x = pk2(v[j][0], v[j][1]); w.y = pk2(v[j][2], v[j][3]); o8[64 * j] = w; }
    return wave_sum(s);
}

template <int PART>
__device__ __forceinline__ void tr_weights(Frame& F, const Args& A, int gw, int NGW) {
    LAS float* scr = (LAS float*)(F.lds + F.wave * 16640);
    const int lane = F.lane;
    unsigned char* ws = F.ws;
    constexpr int I_GU = (DM / 64) * (NGU / 64);
    constexpr int I_D = (FF / 64) * (DM / 64);
    constexpr int I_IN = (DM / 64) * (NINR / 64);
    constexpr int I_AB = (DM / 64) * 8;
    constexpr int I_O = (DM / 64) * (DM / 64);
    constexpr int I_KV = (DM / 64) * (512 / 64);
    constexpr int NITEMS = PART ? (I_GU + I_D + I_O) : (I_GU + I_D + I_IN + I_AB + I_KV);
    constexpr int l = PART;
    for (int it = gw; it < NITEMS; it += NGW) {
        int r = it;
        if (r < I_GU) { const int kb = r / (NGU / 64), db = r % (NGU / 64); const int d0 = db * 64; const int up = (d0 >> 7) & 1;
            const float* W = A.in[(l ? 20 : 3) + up]; const float* gain = A.in[l ? 19 : 2];
            tr_item64(W, FF, kb * 64, d0, (d0 >> 8) * 128 + (d0 & 127), gain, (bf16_t*)(ws + (l ? WS_WGU2 : WS_WGU1)), DM, scr, lane); continue; }
        r -= I_GU;
        if (r < I_D) { const int kb = r / (DM / 64), db = r % (DM / 64);
            tr_item64(A.in[l ? 22 : 5], DM, kb * 64, db * 64, db * 64, nullptr, (bf16_t*)(ws + (l ? WS_WD2 : WS_WD1)), FF, scr, lane); continue; }
        r -= I_D;
        if (PART) { const int kb = r / (DM / 64), db = r % (DM / 64);
            tr_item64(A.in[18], DM, kb * 64, db * 64, db * 64, nullptr, (bf16_t*)(ws + WS_WOUT), DM, scr, lane); continue; }
        if (r < I_IN) { const int kb = r / (NINR / 64), db = r % (NINR / 64); const int d0 = db * 64;
            tr_item64(A.in[7], 3080, kb * 64, d0, d0 < 2048 ? d0 : d0 + 8, A.in[6], (bf16_t*)(ws + WS_WIN), DM, scr, lane); continue; }
        r -= I_IN;
        if (r < I_AB) { const int kb = r / 8, db = r % 8;
            tr_item(A.in[7], 3080, kb * 64, NINR + db * 32, SrcWin{}, A.in[6], (bf16_t*)(ws + WS_WIN), DM, scr, lane); continue; }
        r -= I_AB;
        { const int kb = r / 8, db = r % 8;
            tr_item64(A.in[15], 512, kb * 64, db * 64, db * 64, A.in[14], (bf16_t*)(ws + WS_WKV), DM, scr, lane); }
    }
}

__device__ __forceinline__ void p0_prologue(Frame& F, const Args& A) {
    const int gw = F.vcu * NWAVES + F.wave, NGW = F.G * NWAVES, lane = F.lane;
    unsigned char* ws = F.ws;
    tr_weights<0>(F, A, gw, NGW);
    float* ss = (float*)(ws + WS_SS);
    for (int m = gw; m < T; m += NGW) {
        const float s = row_to_bf16(A.in[0] + (size_t)m * DM, (bf16_t*)(ws + WS_XB) + (size_t)m * DM, lane);
        if (lane < 16) ss[(size_t)m * 16 + lane] = (lane == 0) ? s : 0.f;
    }
    for (int m = gw; m < BATCH * MEMT; m += NGW) {
        const float s = row_to_bf16(A.in[1] + (size_t)m * DM, (bf16_t*)(ws + WS_MEMB) + (size_t)m * DM, lane);
        if (lane == 0) ((float*)(ws + WS_RSTDM))[m] = __builtin_amdgcn_rsqf(s * (1.0f / DM) + EPS);
    }
}

__device__ __forceinline__ void p4a_naive(Frame& F, const Args& A) {
    const int gw = F.vcu * NWAVES + F.wave, NGW = F.G * NWAVES, lane = F.lane;
    unsigned char* ws = F.ws;
    const bf16_t* P = (const bf16_t*)(ws + WS_C);
    const float* convw = A.in[8];
    const int h = lane >> 4;
#if GDN_NAIVE
    float cw[3][4][8];
#pragma unroll
    for (int s = 0; s < 3; ++s)
#pragma unroll
        for (int j = 0; j < 4; ++j)
#pragma unroll
            for (int i = 0; i < 8; ++i) cw[s][j][i] = convw[j * 1536 + s * 512 + lane * 8 + i];
    const float alog = A.in[9][h], dtb = A.in[10][h];
    const float* AB = (const float*)(ws + WS_AB);
    for (int t = gw; t < T; t += NGW) {
        const int tl = t & (SEQ - 1);
        float y[3][8];
#pragma unroll
        for (int s = 0; s < 3; ++s) {
#pragma unroll
            for (int i = 0; i < 8; ++i) y[s][i] = 0.f;
#pragma unroll
            for (int j = 0; j < 4; ++j) { const int tt = tl - 3 + j;
                if (tt >= 0) { const u32x4 w = *(const u32x4*)(P + (size_t)(t - 3 + j) * PP + s * 512 + lane * 8);
                    y[s][0] += cw[s][j][0] * bflo(w.x); y[s][1] += cw[s][j][1] * bfhi(w.x); y[s][2] += cw[s][j][2] * bflo(w.y); y[s][3] += cw[s][j][3] * bfhi(w.y);
                    y[s][4] += cw[s][j][4] * bflo(w.z); y[s][5] += cw[s][j][5] * bfhi(w.z); y[s][6] += cw[s][j][6] * bflo(w.w); y[s][7] += cw[s][j][7] * bfhi(w.w); } }
#pragma unroll
            for (int i = 0; i < 8; ++i) { const float v = y[s][i]; y[s][i] = v * __builtin_amdgcn_rcpf(1.0f + __expf(-v)); }
        }
        float sq = 0.f, sk = 0.f;
#pragma unroll
        for (int i = 0; i < 8; ++i) { sq += y[0][i] * y[0][i]; sk += y[1][i] * y[1][i]; }
#pragma unroll
        for (int o = 1; o < 16; o <<= 1) { sq += __shfl_xor(sq, o); sk += __shfl_xor(sk, o); }
        const float rq = __builtin_amdgcn_rsqf(sq + EPS) * 0.08838834764831845f, rk = __builtin_amdgcn_rsqf(sk + EPS);
        u32x4 wq, wk, wv;
        wq.x = pk2(y[0][0] * rq, y[0][1] * rq); wq.y = pk2(y[0][2] * rq, y[0][3] * rq); wq.z = pk2(y[0][4] * rq, y[0][5] * rq); wq.w = pk2(y[0][6] * rq, y[0][7] * rq);
        wk.x = pk2(y[1][0] * rk, y[1][1] * rk); wk.y = pk2(y[1][2] * rk, y[1][3] * rk); wk.z = pk2(y[1][4] * rk, y[1][5] * rk); wk.w = pk2(y[1][6] * rk, y[1][7] * rk);
        wv.x = pk2(y[2][0], y[2][1]); wv.y = pk2(y[2][2], y[2][3]); wv.z = pk2(y[2][4], y[2][5]); wv.w = pk2(y[2][6], y[2][7]);
        *(u32x4*)((bf16_t*)(ws + WS_GQ) + (size_t)t * 512 + lane * 8) = wq;
        *(u32x4*)((bf16_t*)(ws + WS_GK) + (size_t)t * 512 + lane * 8) = wk;
        *(u32x4*)((bf16_t*)(ws + WS_GV) + (size_t)t * 512 + lane * 8) = wv;
        if ((lane & 15) == 0) {
            const float a = AB[(size_t)t * 8 + h], b = AB[(size_t)t * 8 + 4 + h];
            const float xx = a + dtb; const float sp = (xx > 20.f) ? xx : log1pf(__expf(xx));
            ((float*)(ws + WS_GG))[(size_t)t * 4 + h] = -__expf(alog) * sp;
            ((float*)(ws + WS_GB))[(size_t)t * 4 + h] = 1.0f / (1.0f + __expf(-b));
        }
    }
#endif
    {
        const float* kg = A.in[13]; const int d0 = (lane & 15) * 4;
        const float g0 = kg[d0], g1 = kg[d0 + 1], g2 = kg[d0 + 2], g3 = kg[d0 + 3];
        bf16_t* KNM = (bf16_t*)(ws + WS_KNM);
        for (int t = gw; t < T; t += NGW) {
            const int b = t >> 13, tl = t & (SEQ - 1);
            const u32x2 w = *(const u32x2*)(P + (size_t)t * PP + C_MK + lane * 4);
            float v0 = bflo(w.x), v1 = bfhi(w.x), v2 = bflo(w.y), v3 = bfhi(w.y);
            float s = v0 * v0 + v1 * v1 + v2 * v2 + v3 * v3;
#pragma unroll
            for (int o = 1; o < 16; o <<= 1) s += __shfl_xor(s, o);
            const float r = __builtin_amdgcn_rsqf(s * (1.0f / 64) + EPS);
            u32x2 o; o.x = pk2(v0 * r * g0, v1 * r * g1); o.y = pk2(v2 * r * g2, v3 * r * g3);
            *(u32x2*)(KNM + ((size_t)(b * 4 + h) * SEQ + tl) * 64 + d0) = o;
        }
        float* KM = (float*)(ws + WS_KMEAN);
        for (int it = gw; it < BATCH * 32; it += NGW) {
            const int b = it >> 5, j = it & 31;
            float a0 = 0.f, a1 = 0.f, a2 = 0.f, a3 = 0.f;
            for (int k = 0; k < 256; ++k) {
                const int t = b * SEQ + j * 256 + k;
                const u32x2 w = *(const u32x2*)(P + (size_t)t * PP + C_MK + lane * 4);
                float v0 = bflo(w.x), v1 = bfhi(w.x), v2 = bflo(w.y), v3 = bfhi(w.y);
                float s = v0 * v0 + v1 * v1 + v2 * v2 + v3 * v3;
#pragma unroll
                for (int o = 1; o < 16; o <<= 1) s += __shfl_xor(s, o);
                const float r = __builtin_amdgcn_rsqf(s * (1.0f / 64) + EPS);
                a0 += bf2f((unsigned short)f2bf(v0 * r * g0)); a1 += bf2f((unsigned short)f2bf(v1 * r * g1)); a2 += bf2f((unsigned short)f2bf(v2 * r * g2)); a3 += bf2f((unsigned short)f2bf(v3 * r * g3));
            }
            f32x4 o = {a0 * (1.0f / 256), a1 * (1.0f / 256), a2 * (1.0f / 256), a3 * (1.0f / 256)};
            *(f32x4*)(KM + ((size_t)(b * 4 + h) * 32 + j) * 64 + d0) = o;
        }
    }
}


constexpr int GREC = 73728;
constexpr int CW_PROG = 12288;
constexpr int CW_PQ = 14336;
constexpr int CW_FLG = 16384;
constexpr int N_PREP = T / 64 * 4;
constexpr int R_W = 0, R_QG = 16384, R_KD = 32768, R_QK = 49152, R_U = 55296, R_GL = 71680;
constexpr int R_OPS = 55296;
constexpr int L_QN = 0, L_KN = 17408, L_KNT = 34816, L_VT = 53248, L_AT = 71680, L_TP = 89088, L_KGT = 98304, L_SC = 116736, L_AB = 117760, L_TT = 126976, L_CW = 147456;
constexpr int PQ = 272, PT = 144;
__device__ __forceinline__ u32x4 pack8(const float (&v)[8]) { u32x4 w; w.x = cvtpk(v[0], v[1]); w.y = cvtpk(v[2], v[3]); w.z = cvtpk(v[4], v[5]); w.w = cvtpk(v[6], v[7]); return w; }

__device__ __forceinline__ bf16x8 cvt8(const f32x16& x, int s) {
    u32x4 w;
    if (s == 0) { w.x = cvtpk(x[0], x[1]); w.y = cvtpk(x[2], x[3]); w.z = cvtpk(x[4], x[5]); w.w = cvtpk(x[6], x[7]); }
    else { w.x = cvtpk(x[8], x[9]); w.y = cvtpk(x[10], x[11]); w.z = cvtpk(x[12], x[13]); w.w = cvtpk(x[14], x[15]); }
    return __builtin_bit_cast(bf16x8, w);
}

__device__ __forceinline__ void gdn_prep_fetch(Frame& F, int item, u32x4 (&praw)[11], float& pa, float& pb) {
    const int cidx = item >> 2, h = item & 3; const int t0 = cidx * 64, tl0 = t0 & (SEQ - 1);
    const bf16_t* P = (const bf16_t*)(F.ws + WS_C); const int tid2 = F.tid & 127, cg = tid2 & 15, c0 = (tid2 >> 4) * 8; const int s = F.wave >> 1;
    if (F.wave < 6) {
#pragma unroll
        for (int k = 0; k < 11; ++k)
            praw[k] = (tl0 + c0 - 3 + k >= 0) ? *(const u32x4*)(P + (size_t)(t0 + c0 - 3 + k) * PP + s * 512 + h * 128 + cg * 8) : (u32x4){0u, 0u, 0u, 0u};
    }
    if (F.wave == 0) { const float* AB = (const float*)(F.ws + WS_AB); pa = AB[(size_t)(t0 + F.lane) * 8 + h]; pb = AB[(size_t)(t0 + F.lane) * 8 + 4 + h]; }
}
typedef int i32x4 __attribute__((ext_vector_type(4)));
__device__ __forceinline__ void st16_wt(__amdgpu_buffer_rsrc_t rsrc, int off, u32x4 v) { __builtin_amdgcn_raw_buffer_store_b128(__builtin_bit_cast(i32x4, v), rsrc, off, 0, 16); }
__device__ __forceinline__ void gdn_prep_item(Frame& F, const Args& A, int item, int next_item, u32x4 (&praw)[11], float& pa, float& pb, int& cw_head, int& pend) {
    const int cidx = item >> 2, h = item & 3;
    const int t0 = cidx * 64, tl0 = t0 & (SEQ - 1);
    LAS unsigned char* L = F.lds;
    int tid = F.tid; asm volatile("" : "+v"(tid));
    const int lane = tid & 63, wave = F.wave;
    unsigned char* rec = F.ws + WS_G + (size_t)item * GREC;
    const __amdgpu_buffer_rsrc_t rsrc = __builtin_amdgcn_make_buffer_rsrc(rec, 0, GREC, 0x00020000);
    const bf16_t* P = (const bf16_t*)(F.ws + WS_C);
    LAS float* sc_beta = (LAS float*)(L + L_SC); LAS float* sc_gc = sc_beta + 64; LAS float* sc_eg = sc_beta + 128; LAS float* sc_ekd = sc_beta + 192;
    if (wave == 0) {
        const float a = pa, bb = pb;
        const float xx = a + A.in[10][h]; const float sp = (xx > 20.f) ? xx : log1pf(__expf(xx));
        float g = -__expf(A.in[9][h]) * sp;
        const float beta = 1.0f / (1.0f + __expf(-bb));
#pragma unroll
        for (int o = 1; o < 64; o <<= 1) { const float u = __shfl_up(g, o); if (lane >= o) g += u; }
        const float gl = __shfl(g, 63);
        sc_beta[lane] = beta; sc_gc[lane] = g; sc_eg[lane] = __expf(g); sc_ekd[lane] = __expf(gl - g);
        if (lane == 0) __hip_atomic_store((float*)(rec + R_GL), __expf(gl), __ATOMIC_RELAXED, __HIP_MEMORY_SCOPE_AGENT);
    }
    for (int i = tid; i < 576; i += NTHREADS) { *(LAS u32x4*)(L + L_TP + i * 16) = (u32x4){0u, 0u, 0u, 0u}; *(LAS u32x4*)(L + L_TT + i * 16) = (u32x4){0u, 0u, 0u, 0u}; }
    if (h != cw_head) {
        LAS float* cwl = (LAS float*)(L + L_CW);
        for (int i = tid; i < 1536; i += NTHREADS) { const int e = i & 7, j = (i >> 3) & 3, s3 = (i >> 5) % 3, cg2 = i / 96;
            cwl[i] = A.in[8][j * 1536 + s3 * 512 + h * 128 + cg2 * 8 + e]; }
        cw_head = h;
    }
    __syncthreads();
    if (wave < 6) {
        const int s = wave >> 1, tid2 = tid & 127, cg = tid2 & 15, c0 = (tid2 >> 4) * 8;
        const LAS float* cwl = (const LAS float*)(L + L_CW) + cg * 96 + s * 32;
        f32x4 cw0[4], cw1[4];
#pragma unroll
        for (int j = 0; j < 4; ++j) { cw0[j] = *(const LAS f32x4*)(cwl + j * 8); cw1[j] = *(const LAS f32x4*)(cwl + j * 8 + 4); }
        const int cst = ((c0 + 8 * (cg & 7)) & 63) * 2;
#pragma unroll
        for (int g4 = 0; g4 < 2; ++g4) {
            float y[4][8];
#pragma unroll
            for (int k = 0; k < 4; ++k)
#pragma unroll
                for (int i = 0; i < 8; ++i) y[k][i] = 0.f;
#pragma unroll
            for (int r7 = 0; r7 < 7; ++r7) {
                const u32x4 w = praw[4 * g4 + r7];
                const float x0 = bflo(w.x), x1 = bfhi(w.x), x2 = bflo(w.y), x3 = bfhi(w.y), x4 = bflo(w.z), x5 = bfhi(w.z), x6 = bflo(w.w), x7 = bfhi(w.w);
#pragma unroll
                for (int j = 0; j < 4; ++j) { const int k = r7 - j;
                    if (k >= 0 && k < 4) {
                        y[k][0] += cw0[j][0] * x0; y[k][1] += cw0[j][1] * x1; y[k][2] += cw0[j][2] * x2; y[k][3] += cw0[j][3] * x3;
                        y[k][4] += cw1[j][0] * x4; y[k][5] += cw1[j][1] * x5; y[k][6] += cw1[j][2] * x6; y[k][7] += cw1[j][3] * x7; } }
            }
#pragma unroll
            for (int k = 0; k < 4; ++k)
#pragma unroll
                for (int i = 0; i < 8; ++i) { const float v = y[k][i]; y[k][i] = v * __builtin_amdgcn_rcpf(1.0f + __expf(-v)); }
            if (s < 2) {
#pragma unroll
                for (int k = 0; k < 4; ++k) {
                    float sq = 0.f;
#pragma unroll
                    for (int i = 0; i < 8; ++i) sq += y[k][i] * y[k][i];
#pragma unroll
                    for (int o = 1; o < 16; o <<= 1) sq += __shfl_xor(sq, o);
                    const float rn = __builtin_amdgcn_rsqf(sq + EPS) * (s == 0 ? 0.08838834764831845f : 1.0f);
#pragma unroll
                    for (int i = 0; i < 8; ++i) y[k][i] *= rn;
                }
            }
            const int cb = c0 + 4 * g4;
            if (s == 0) {
#pragma unroll
                for (int k = 0; k < 4; ++k) *(LAS u32x4*)(L + L_QN + (cb + k) * PQ + cg * 16) = pack8(y[k]);
            } else if (s == 1) {
#pragma unroll
                for (int k = 0; k < 4; ++k) *(LAS u32x4*)(L + L_KN + (cb + k) * PQ + cg * 16) = pack8(y[k]);
                float be[4];
#pragma unroll
                for (int k = 0; k < 4; ++k) be[k] = sc_beta[cb + k] * sc_eg[cb + k];
#pragma unroll
                for (int i = 0; i < 8; ++i) {
                    u32x2 kw, gw;
                    kw.x = cvtpk(y[0][i], y[1][i]); kw.y = cvtpk(y[2][i], y[3][i]);
                    gw.x = cvtpk(y[0][i] * be[0], y[1][i] * be[1]); gw.y = cvtpk(y[2][i] * be[2], y[3][i] * be[3]);
                    *(LAS u32x2*)(L + L_KNT + (cg * 8 + i) * PT + cst + 8 * g4) = kw;
                    *(LAS u32x2*)(L + L_KGT + (cg * 8 + i) * PT + cst + 8 * g4) = gw;
                }
            } else {
                float bt[4];
#pragma unroll
                for (int k = 0; k < 4; ++k) bt[k] = sc_beta[cb + k];
#pragma unroll
                for (int i = 0; i < 8; ++i) {
                    u32x2 vw; vw.x = cvtpk(y[0][i] * bt[0], y[1][i] * bt[1]); vw.y = cvtpk(y[2][i] * bt[2], y[3][i] * bt[3]);
                    *(LAS u32x2*)(L + L_VT + (cg * 8 + i) * PT + cst + 8 * g4) = vw;
                }
            }
        }
    }
    if (pend >= 0) asm volatile("s_waitcnt vmcnt(0)" ::: "memory");
    __syncthreads();
    if (pend >= 0 && tid == 0) __hip_atomic_store((unsigned*)(F.ws + WS_CTL) + CW_FLG + pend, 1u, __ATOMIC_RELAXED, __HIP_MEMORY_SCOPE_AGENT);
    if (next_item < T / 64 * 4) gdn_prep_fetch(F, next_item, praw, pa, pb);
    const int r = lane & 31, hh = lane >> 5;
    if (wave < 6) {
        int tm, tn; const LAS unsigned char* Ab; const LAS unsigned char* Bb;
        if (wave < 3) { tm = (wave >= 1); tn = (wave == 2); Ab = L + L_KN + (32 * tm + r) * PQ; Bb = L + L_KN + (32 * tn + r) * PQ; }
        else { tm = (wave == 5); tn = (wave >= 4); Ab = L + L_KN + (32 * tm + r) * PQ; Bb = L + L_QN + (32 * tn + r) * PQ; }
        f32x16 acc;
#pragma unroll
        for (int i = 0; i < 16; ++i) acc[i] = 0.f;
#pragma unroll
        for (int s = 0; s < 8; ++s) { const bf16x8 a = *(const LAS bf16x8*)(Ab + s * 32 + hh * 16), b = *(const LAS bf16x8*)(Bb + s * 32 + hh * 16);
            acc = __builtin_amdgcn_mfma_f32_32x32x16_bf16(a, b, acc, 0, 0, 0); }
        const int col = tn * 32 + r; const float gcc = sc_gc[col];
        if (wave < 3) {
#pragma unroll
            for (int i = 0; i < 16; ++i) { const int row = tm * 32 + (i & 3) + 8 * (i >> 2) + 4 * hh;
                const float v = (row > col) ? acc[i] * sc_beta[row] * __expf(sc_gc[row] - gcc) : 0.f;
                *(LAS float*)(L + L_AT + col * PQ + row * 4) = v;
                *(LAS unsigned short*)(L + L_AB + row * PT + col * 2) = (unsigned short)(cvtpk(v, 0.f) & 0xffffu); }
        } else {
            float v[16];
#pragma unroll
            for (int i = 0; i < 16; ++i) { const int row = tm * 32 + (i & 3) + 8 * (i >> 2) + 4 * hh;
                v[i] = (row <= col) ? acc[i] * __expf(gcc - sc_gc[row]) : 0.f; }
            const int f0 = (tn == 0) ? 0 : 2 + 2 * tm;
            u32x4 w0, w1; w0.x = cvtpk(v[0], v[1]); w0.y = cvtpk(v[2], v[3]); w0.z = cvtpk(v[4], v[5]); w0.w = cvtpk(v[6], v[7]);
            w1.x = cvtpk(v[8], v[9]); w1.y = cvtpk(v[10], v[11]); w1.z = cvtpk(v[12], v[13]); w1.w = cvtpk(v[14], v[15]);
            st16_wt(rsrc, R_QK + f0 * 1024 + lane * 16, w0);
            st16_wt(rsrc, R_QK + (f0 + 1) * 1024 + lane * 16, w1);
        }
    }
    __syncthreads();
    if (wave == 0) {
        {
            const int g = lane >> 4, rr = lane & 15;
            const LAS unsigned char* ab = L + L_AT + (16 * g) * PQ + (16 * g) * 4;
            float Dr[16];
#pragma unroll
            for (int i = 0; i < 16; ++i) Dr[i] = 0.f;
            Dr[15] = (rr == 15) ? 1.0f : 0.f;
#define GDN_L0_BATCH(JHI, JLO) { asm volatile("" : "+v"(ab)); f32x4 av[(JHI) - (JLO) + 1][4]; \
            _Pragma("unroll") for (int jj = (JHI); jj >= (JLO); --jj) _Pragma("unroll") for (int k = 0; k < 4; ++k) if (k >= ((jj + 1) >> 2)) av[jj - (JLO)][k] = *(const LAS f32x4*)(ab + jj * PQ + k * 16); \
            _Pragma("unroll") for (int jj = (JHI); jj >= (JLO); --jj) { f32x2 a0 = {0.f, 0.f}, a1 = {0.f, 0.f}; \
                _Pragma("unroll") for (int k = 0; k < 4; ++k) if (k >= ((jj + 1) >> 2)) { \
                    a0 += (f32x2){Dr[4 * k], Dr[4 * k + 1]} * (f32x2){av[jj - (JLO)][k][0], av[jj - (JLO)][k][1]}; \
                    a1 += (f32x2){Dr[4 * k + 2], Dr[4 * k + 3]} * (f32x2){av[jj - (JLO)][k][2], av[jj - (JLO)][k][3]}; } \
                Dr[jj] = (rr == jj) ? 1.0f : -((a0[0] + a0[1]) + (a1[0] + a1[1])); } }
            GDN_L0_BATCH(14, 7)
            GDN_L0_BATCH(6, 3)
            GDN_L0_BATCH(2, 0)
#undef GDN_L0_BATCH
            u32x4 w0, w1; w0.x = cvtpk(Dr[0], Dr[1]); w0.y = cvtpk(Dr[2], Dr[3]); w0.z = cvtpk(Dr[4], Dr[5]); w0.w = cvtpk(Dr[6], Dr[7]);
            w1.x = cvtpk(Dr[8], Dr[9]); w1.y = cvtpk(Dr[10], Dr[11]); w1.z = cvtpk(Dr[12], Dr[13]); w1.w = cvtpk(Dr[14], Dr[15]);
            *(LAS u32x4*)(L + L_TP + (16 * g + rr) * PT + 32 * g) = w0; *(LAS u32x4*)(L + L_TP + (16 * g + rr) * PT + 32 * g + 16) = w1;
            const unsigned dw[8] = {w0.x, w0.y, w0.z, w0.w, w1.x, w1.y, w1.z, w1.w};
#pragma unroll
            for (int c = 0; c < 16; ++c) *(LAS unsigned short*)(L + L_TT + (16 * g + c) * PT + (16 * g + rr) * 2) = (unsigned short)((c & 1) ? (dw[c >> 1] >> 16) : (dw[c >> 1] & 0xffffu));
        }
        asm volatile("s_waitcnt lgkmcnt(0)" ::: "memory");
#pragma unroll
        for (int q = 0; q < 2; ++q) {
            f32x16 G, M;
#pragma unroll
            for (int i = 0; i < 16; ++i) { G[i] = 0.f; M[i] = 0.f; }
            G = __builtin_amdgcn_mfma_f32_32x32x16_bf16(*(const LAS bf16x8*)(L + L_AB + (32 * q + r) * PT + (32 * q + 8 * hh) * 2),
                                                         *(const LAS bf16x8*)(L + L_TT + (32 * q + r) * PT + (32 * q + 8 * hh) * 2), G, 0, 0, 0);
            const bf16x8 gb = cvt8(G, 1);
            const u32x2 d0 = *(const LAS u32x2*)(L + L_TP + (32 * q + r) * PT + (32 * q + 16 + 4 * hh) * 2), d1 = *(const LAS u32x2*)(L + L_TP + (32 * q + r) * PT + (32 * q + 16 + 8 + 4 * hh) * 2);
            u32x4 da; da.x = d0.x; da.y = d0.y; da.z = d1.x; da.w = d1.y;
            M = __builtin_amdgcn_mfma_f32_32x32x16_bf16(__builtin_bit_cast(bf16x8, da), gb, M, 0, 0, 0);
            if (r < 16) {
#pragma unroll
                for (int i = 8; i < 16; ++i) { const int m = (i & 3) + 8 * (i >> 2) + 4 * hh;
                    *(LAS unsigned short*)(L + L_TP + (32 * q + m) * PT + (32 * q + r) * 2) = (unsigned short)(cvtpk(-M[i], 0.f) & 0xffffu); }
                u32x2 t0, t1; t0.x = cvtpk(-M[8], -M[9]); t0.y = cvtpk(-M[10], -M[11]); t1.x = cvtpk(-M[12], -M[13]); t1.y = cvtpk(-M[14], -M[15]);
                *(LAS u32x2*)(L + L_TT + (32 * q + r) * PT + (32 * q + 16 + 4 * hh) * 2) = t0;
                *(LAS u32x2*)(L + L_TT + (32 * q + r) * PT + (32 * q + 24 + 4 * hh) * 2) = t1;
            }
        }
        asm volatile("s_waitcnt lgkmcnt(0)" ::: "memory");
        {
            f32x16 G, M;
#pragma unroll
            for (int i = 0; i < 16; ++i) { G[i] = 0.f; M[i] = 0.f; }
#pragma unroll
            for (int sx = 0; sx < 2; ++sx)
                G = __builtin_amdgcn_mfma_f32_32x32x16_bf16(*(const LAS bf16x8*)(L + L_AB + (32 + r) * PT + (16 * sx + 8 * hh) * 2),
                                                             *(const LAS bf16x8*)(L + L_TT + r * PT + (16 * sx + 8 * hh) * 2), G, 0, 0, 0);
#pragma unroll
            for (int sx = 0; sx < 2; ++sx) {
                const bf16x8 gb = cvt8(G, sx);
                const u32x2 d0 = *(const LAS u32x2*)(L + L_TP + (32 + r) * PT + (32 + 16 * sx + 4 * hh) * 2), d1 = *(const LAS u32x2*)(L + L_TP + (32 + r) * PT + (32 + 16 * sx + 8 + 4 * hh) * 2);
                u32x4 da; da.x = d0.x; da.y = d0.y; da.z = d1.x; da.w = d1.y;
                M = __builtin_amdgcn_mfma_f32_32x32x16_bf16(__builtin_bit_cast(bf16x8, da), gb, M, 0, 0, 0);
            }
#pragma unroll
            for (int i = 0; i < 16; ++i) { const int m = (i & 3) + 8 * (i >> 2) + 4 * hh;
                *(LAS unsigned short*)(L + L_TP + (32 + m) * PT + r * 2) = (unsigned short)(cvtpk(-M[i], 0.f) & 0xffffu); }
        }
    } else {
        for (int f = wave - 1; f < 32; f += 7) {
            if (f < 16) {
                const int mt = f >> 3, dblk = (f >> 1) & 3, s = f & 1; const int c = 32 * mt + r, d0 = 32 * dblk + 16 * s + 4 * hh;
                const u32x2 lo = *(const LAS u32x2*)(L + L_QN + c * PQ + d0 * 2), hi = *(const LAS u32x2*)(L + L_QN + c * PQ + (d0 + 8) * 2);
                const float e = sc_eg[c];
                float v[8] = {bflo(lo.x) * e, bfhi(lo.x) * e, bflo(lo.y) * e, bfhi(lo.y) * e, bflo(hi.x) * e, bfhi(hi.x) * e, bflo(hi.y) * e, bfhi(hi.y) * e};
                st16_wt(rsrc, R_QG + f * 1024 + lane * 16, pack8(v));
            } else {
                const int g = f - 16; const int dblk = g >> 2, blk = (g >> 1) & 1, s = g & 1; const int d = 32 * dblk + r, c0 = 32 * blk + 16 * s + 4 * hh;
                const int rot = 8 * ((d >> 3) & 7);
                const u32x2 lo = *(const LAS u32x2*)(L + L_KNT + d * PT + ((c0 + rot) & 63) * 2), hi = *(const LAS u32x2*)(L + L_KNT + d * PT + ((c0 + 8 + rot) & 63) * 2);
                const f32x4 e0 = *(const LAS f32x4*)(sc_ekd + c0), e1 = *(const LAS f32x4*)(sc_ekd + c0 + 8);
                float v[8] = {bflo(lo.x) * e0[0], bfhi(lo.x) * e0[1], bflo(lo.y) * e0[2], bfhi(lo.y) * e0[3], bflo(hi.x) * e1[0], bfhi(hi.x) * e1[1], bflo(hi.y) * e1[2], bfhi(hi.y) * e1[3]};
                st16_wt(rsrc, R_KD + g * 1024 + lane * 16, pack8(v));
            }
        }
    }
    __syncthreads();
    {
        const int ct = wave >> 2, et = wave & 3, dt = wave & 3;
        f32x16 acc;
#pragma unroll
        for (int i = 0; i < 16; ++i) acc[i] = 0.f;
        const LAS unsigned char* Ab = L + L_TP + (32 * ct + r) * PT + hh * 16; const LAS unsigned char* Bb = L + L_VT + (32 * et + r) * PT; const int rotv = (4 * et + (r >> 3)) & 7;
#define ROTC(s_, hh_, rot_) ((((2 * (s_) + (hh_)) + (rot_)) & 7) * 16)
#pragma unroll
        for (int s = 0; s < 2; ++s) acc = __builtin_amdgcn_mfma_f32_32x32x16_bf16(*(const LAS bf16x8*)(Ab + s * 32), *(const LAS bf16x8*)(Bb + ROTC(s, hh, rotv)), acc, 0, 0, 0);
        if (ct) {
#pragma unroll
            for (int s = 2; s < 4; ++s) acc = __builtin_amdgcn_mfma_f32_32x32x16_bf16(*(const LAS bf16x8*)(Ab + s * 32), *(const LAS bf16x8*)(Bb + ROTC(s, hh, rotv)), acc, 0, 0, 0);
        }
        { u32x4 w0, w1; w0.x = cvtpk(acc[0], acc[1]); w0.y = cvtpk(acc[2], acc[3]); w0.z = cvtpk(acc[4], acc[5]); w0.w = cvtpk(acc[6], acc[7]);
          w1.x = cvtpk(acc[8], acc[9]); w1.y = cvtpk(acc[10], acc[11]); w1.z = cvtpk(acc[12], acc[13]); w1.w = cvtpk(acc[14], acc[15]);
          st16_wt(rsrc, R_U + (et * 2 + ct) * 2048 + lane * 32, w0); st16_wt(rsrc, R_U + (et * 2 + ct) * 2048 + lane * 32 + 16, w1); }
#pragma unroll
        for (int i = 0; i < 16; ++i) acc[i] = 0.f;
        Ab = L + L_KGT + (32 * dt + r) * PT; Bb = L + L_TP + (32 * ct + r) * PT + hh * 16;
#pragma unroll
        for (int s = 0; s < 2; ++s) acc = __builtin_amdgcn_mfma_f32_32x32x16_bf16(*(const LAS bf16x8*)(Ab + ROTC(s, hh, rotv)), *(const LAS bf16x8*)(Bb + s * 32), acc, 0, 0, 0);
        if (ct) {
#pragma unroll
            for (int s = 2; s < 4; ++s) acc = __builtin_amdgcn_mfma_f32_32x32x16_bf16(*(const LAS bf16x8*)(Ab + ROTC(s, hh, rotv)), *(const LAS bf16x8*)(Bb + s * 32), acc, 0, 0, 0);
        }
#undef ROTC
        { u32x4 w0, w1; w0.x = cvtpk(acc[0], acc[1]); w0.y = cvtpk(acc[2], acc[3]); w0.z = cvtpk(acc[4], acc[5]); w0.w = cvtpk(acc[6], acc[7]);
          w1.x = cvtpk(acc[8], acc[9]); w1.y = cvtpk(acc[10], acc[11]); w1.z = cvtpk(acc[12], acc[13]); w1.w = cvtpk(acc[14], acc[15]);
          const int f0 = (ct * 4 + dt) * 2;
          st16_wt(rsrc, R_W + f0 * 1024 + lane * 16, w0); st16_wt(rsrc, R_W + (f0 + 1) * 1024 + lane * 16, w1); }
    }
    pend = item;
}

constexpr int S_OP0 = 0, S_OP1 = 55296, S_OB0 = 110592, S_OB1 = 128000;
__device__ __forceinline__ void gdn_scan(Frame& F, const Args& A, int b, int h) {
    LAS unsigned char* L = F.lds;
    int tid = F.tid; asm volatile("" : "+v"(tid));
    const int lane = tid & 63, wave = F.wave;
    const unsigned char* rec0 = F.ws + WS_G + ((size_t)(b * 128) * 4 + h) * GREC;
    const size_t rstep = (size_t)4 * GREC;
    bf16_t* P = (bf16_t*)(F.ws + WS_C);
    const int r = lane & 31, hh = lane >> 5;
    auto stage = [&](int n) {
        const unsigned char* src = rec0 + (size_t)n * rstep; const int lw = wave - 4; const int ob = (n & 1) ? S_OP1 : S_OP0;
        for (int k = lw; k < 54; k += 4)
            __builtin_amdgcn_global_load_lds((const unsigned*)(src + k * 1024 + lane * 16), (LAS unsigned*)(L + ob + k * 1024), 16, 0, 0);
    };
    auto warm = [&](int n) {
        const unsigned char* src = rec0 + (size_t)(n < 127 ? n : 127) * rstep; const int lw = wave - 4;
#pragma unroll
        for (int k = 0; k < 3; ++k) { const int p = lw + 4 * k; const int off = (p < 9 ? p : p - 3) * 8192;
            __builtin_amdgcn_global_load_lds((const unsigned*)(src + off + lane * 128), (LAS unsigned*)(L + 145920 + lw * 256), 4, 0, 0); }
    };
    auto zstage = [&](int m) {
        const int lw = wave - 4;
#pragma unroll
        for (int k = 0; k < 4; ++k) { const int p = lw * 4 + k;
            const bf16_t* zp = P + ((size_t)b * SEQ + m * 64 + 4 * p + (lane >> 4)) * PP + C_GZ + h * 128 + (lane & 15) * 8;
            __builtin_amdgcn_global_load_lds((const unsigned*)zp, (LAS unsigned*)(L + 147456 + p * 1024), 16, 0, 0); }
    };
    unsigned* flags = (unsigned*)(F.ws + WS_CTL) + CW_FLG + (size_t)(b * 128) * 4 + h;
    auto ensure = [&](int first, int count) {
        unsigned spins = 0;
        for (;;) {
            const unsigned v = (lane < count) ? __hip_atomic_load(flags + 4 * (first + lane), __ATOMIC_RELAXED, __HIP_MEMORY_SCOPE_AGENT) : 1u;
            if (__ballot(v == 0u) == 0ull) break;
            __builtin_amdgcn_s_sleep(4);
            if (++spins > (1u << 20)) break;
        }
        __builtin_amdgcn_fence(__ATOMIC_ACQUIRE, "agent");
        asm volatile("s_waitcnt vmcnt(0)" ::: "memory");
    };
    if (wave == 4) ensure(0, 8);
    __syncthreads();
    if (wave >= 4) { stage(0);
        const unsigned char* src1 = rec0 + rstep; const int lw = wave - 4;
#pragma unroll
        for (int j = 0; j < 8; ++j) { const int k = lw + 4 * j; __builtin_amdgcn_global_load_lds((const unsigned*)(src1 + k * 1024 + lane * 16), (LAS unsigned*)(L + S_OP1 + k * 1024), 16, 0, 0); } }
    f32x16 S[4];
#pragma unroll
    for (int d = 0; d < 4; ++d)
#pragma unroll
        for (int i = 0; i < 16; ++i) S[d][i] = 0.f;
    u32x4 Uc[4]; float glc = 0.f;
    if (wave < 4) {
        const unsigned char* up = rec0 + R_U + wave * 4096 + lane * 32;
        Uc[0] = *(const u32x4*)(up); Uc[1] = *(const u32x4*)(up + 16); Uc[2] = *(const u32x4*)(up + 2048); Uc[3] = *(const u32x4*)(up + 2048 + 16);
        glc = *(const float*)(rec0 + R_GL);
    }
    LAS float* ogl = (LAS float*)(L + 145408);
    if (tid < 128) ogl[tid] = A.in[11][tid];
    asm volatile("s_waitcnt vmcnt(0)" ::: "memory");
    __syncthreads();
    unsigned* prog = (unsigned*)(F.ws + WS_CTL) + CW_PROG + 64 * (b * 4 + h);
    for (int n = 0; n < 128; ++n) {
        if (tid == 0) __hip_atomic_store(prog, (unsigned)(n + 1), __ATOMIC_RELAXED, __HIP_MEMORY_SCOPE_AGENT);
        if (wave < 4) {
            const LAS unsigned char* ob = L + ((n & 1) ? S_OP1 : S_OP0) + lane * 16;
            f32x16 w0, w1, o0, o1;
#pragma unroll
            for (int i = 0; i < 16; ++i) { w0[i] = 0.f; w1[i] = 0.f; o0[i] = 0.f; o1[i] = 0.f; }
            bf16x8 sb[4][2];
#pragma unroll
            for (int d = 0; d < 4; ++d)
#pragma unroll
                for (int s = 0; s < 2; ++s) sb[d][s] = cvt8(S[d], s);
#pragma unroll
            for (int d = 0; d < 4; ++d)
#pragma unroll
                for (int s = 0; s < 2; ++s) {
                    w0 = __builtin_amdgcn_mfma_f32_32x32x16_bf16(*(const LAS bf16x8*)(ob + R_W + ((0 * 4 + d) * 2 + s) * 1024), sb[d][s], w0, 0, 0, 0);
                    w1 = __builtin_amdgcn_mfma_f32_32x32x16_bf16(*(const LAS bf16x8*)(ob + R_W + ((1 * 4 + d) * 2 + s) * 1024), sb[d][s], w1, 0, 0, 0);
                }
#define QGF(a_, d_, s_) (*(const LAS bf16x8*)(ob + R_QG + (((a_) * 4 + (d_)) * 2 + (s_)) * 1024))
            bf16x8 qa[4], qb[4];
            qa[0] = QGF(0, 0, 0); qa[1] = QGF(0, 0, 1); qa[2] = QGF(1, 0, 0); qa[3] = QGF(1, 0, 1);
            __builtin_amdgcn_sched_group_barrier(0x2, 32, 0);
            __builtin_amdgcn_sched_group_barrier(0x100, 8, 0);
#pragma unroll
            for (int g = 0; g < 12; ++g) { __builtin_amdgcn_sched_group_barrier(0x8, 1, 0); __builtin_amdgcn_sched_group_barrier(0x100, 1, 0); }
            __builtin_amdgcn_sched_group_barrier(0x8, 4, 0);
            __builtin_amdgcn_sched_barrier(0);
            const unsigned u0[8] = {Uc[0].x, Uc[0].y, Uc[0].z, Uc[0].w, Uc[1].x, Uc[1].y, Uc[1].z, Uc[1].w};
            const unsigned u1[8] = {Uc[2].x, Uc[2].y, Uc[2].z, Uc[2].w, Uc[3].x, Uc[3].y, Uc[3].z, Uc[3].w};
            bf16x8 vb[2][2];
            const float gl = glc;
#define QG_RUN(d_, qc_) do { o0 = __builtin_amdgcn_mfma_f32_32x32x16_bf16(qc_[0], sb[d_][0], o0, 0, 0, 0); o1 = __builtin_amdgcn_mfma_f32_32x32x16_bf16(qc_[2], sb[d_][0], o1, 0, 0, 0); \
                             o0 = __builtin_amdgcn_mfma_f32_32x32x16_bf16(qc_[1], sb[d_][1], o0, 0, 0, 0); o1 = __builtin_amdgcn_mfma_f32_32x32x16_bf16(qc_[3], sb[d_][1], o1, 0, 0, 0); } while (0)
#define QG_SGB(nds_) do { _Pragma("unroll") for (int g_ = 0; g_ < 4; ++g_) { __builtin_amdgcn_sched_group_barrier(0x8, 1, 0); if (nds_) __builtin_amdgcn_sched_group_barrier(0x100, 1, 0); __builtin_amdgcn_sched_group_barrier(0x2, 6, 0); } } while (0)
            qb[0] = QGF(0, 1, 0); qb[1] = QGF(0, 1, 1); qb[2] = QGF(1, 1, 0); qb[3] = QGF(1, 1, 1);
            QG_RUN(0, qa);
#pragma unroll
            for (int i = 0; i < 8; ++i) { w0[2 * i] = bflo(u0[i]) - w0[2 * i]; w0[2 * i + 1] = bfhi(u0[i]) - w0[2 * i + 1]; }
            QG_SGB(1); __builtin_amdgcn_sched_barrier(0);
            qa[0] = QGF(0, 2, 0); qa[1] = QGF(0, 2, 1); qa[2] = QGF(1, 2, 0); qa[3] = QGF(1, 2, 1);
            QG_RUN(1, qb);
            vb[0][0] = cvt8(w0, 0); vb[0][1] = cvt8(w0, 1);
#pragma unroll
            for (int i = 0; i < 4; ++i) { w1[2 * i] = bflo(u1[i]) - w1[2 * i]; w1[2 * i + 1] = bfhi(u1[i]) - w1[2 * i + 1]; }
            QG_SGB(1); __builtin_amdgcn_sched_barrier(0);
            qb[0] = QGF(0, 3, 0); qb[1] = QGF(0, 3, 1); qb[2] = QGF(1, 3, 0); qb[3] = QGF(1, 3, 1);
            QG_RUN(2, qa);
#pragma unroll
            for (int i = 4; i < 8; ++i) { w1[2 * i] = bflo(u1[i]) - w1[2 * i]; w1[2 * i + 1] = bfhi(u1[i]) - w1[2 * i + 1]; }
            vb[1][0] = cvt8(w1, 0); vb[1][1] = cvt8(w1, 1);
            QG_SGB(1); __builtin_amdgcn_sched_barrier(0);
            QG_RUN(3, qb);
#pragma unroll
            for (int d = 0; d < 2; ++d)
#pragma unroll
                for (int i = 0; i < 16; ++i) S[d][i] *= gl;
            QG_SGB(0);
#undef QGF
#undef QG_RUN
#undef QG_SGB
            __builtin_amdgcn_sched_barrier(0); asm volatile("" ::: "memory"); __builtin_amdgcn_s_barrier(); asm volatile("" ::: "memory"); __builtin_amdgcn_sched_barrier(0);
            bf16x8 qkf[6], kdA[8];
#pragma unroll
            for (int f = 0; f < 6; ++f) qkf[f] = *(const LAS bf16x8*)(ob + R_QK + f * 1024);
#pragma unroll
            for (int f = 0; f < 8; ++f) kdA[f] = *(const LAS bf16x8*)(ob + R_KD + f * 1024);
#pragma unroll
            for (int d = 2; d < 4; ++d)
#pragma unroll
                for (int i = 0; i < 16; ++i) S[d][i] *= gl;
            __builtin_amdgcn_sched_barrier(0);
            bf16x8 kdB[8];
#pragma unroll
            for (int f = 0; f < 8; ++f) kdB[f] = *(const LAS bf16x8*)(ob + R_KD + (8 + f) * 1024);
#pragma unroll
            for (int s = 0; s < 2; ++s) {
                o0 = __builtin_amdgcn_mfma_f32_32x32x16_bf16(qkf[0 + s], vb[0][s], o0, 0, 0, 0);
                o1 = __builtin_amdgcn_mfma_f32_32x32x16_bf16(qkf[2 + s], vb[0][s], o1, 0, 0, 0);
                o1 = __builtin_amdgcn_mfma_f32_32x32x16_bf16(qkf[4 + s], vb[1][s], o1, 0, 0, 0);
            }
            __builtin_amdgcn_sched_group_barrier(0x8, 2, 1);
            __builtin_amdgcn_sched_group_barrier(0x100, 8, 1);
            __builtin_amdgcn_sched_group_barrier(0x8, 4, 1);
            __builtin_amdgcn_sched_barrier(0);
            LAS unsigned char* obuf = L + ((n & 1) ? S_OB1 : S_OB0) + (wave * 32 + r) * 2;
#define OW2(ov_, base_, i_) do { const int r0_ = ((i_) & 3) + 8 * ((i_) >> 2) + 4 * hh, r1_ = (((i_) + 1) & 3) + 8 * (((i_) + 1) >> 2) + 4 * hh; \
                *(LAS unsigned short*)(obuf + ((base_) + r0_) * PQ) = (unsigned short)(cvtpk(ov_[(i_)], 0.f) & 0xffffu); \
                *(LAS unsigned short*)(obuf + ((base_) + r1_) * PQ) = (unsigned short)(cvtpk(ov_[(i_) + 1], 0.f) & 0xffffu); } while (0)
#pragma unroll
            for (int d = 0; d < 2; ++d)
#pragma unroll
                for (int bk = 0; bk < 2; ++bk)
#pragma unroll
                    for (int s = 0; s < 2; ++s) { const int g = (d * 2 + bk) * 2 + s;
                        S[d] = __builtin_amdgcn_mfma_f32_32x32x16_bf16(kdA[g], vb[bk][s], S[d], 0, 0, 0);
                        OW2(o0, 0, 2 * g);
                        __builtin_amdgcn_sched_barrier(0); }
            {   const int nn = (n + 1 < 128) ? n + 1 : 127;
                const unsigned char* up = rec0 + (size_t)nn * rstep + R_U + wave * 4096 + lane * 32;
                Uc[0] = *(const u32x4*)(up); Uc[1] = *(const u32x4*)(up + 16); Uc[2] = *(const u32x4*)(up + 2048); Uc[3] = *(const u32x4*)(up + 2048 + 16);
                glc = *(const float*)(rec0 + (size_t)nn * rstep + R_GL); }
            __builtin_amdgcn_sched_barrier(0);
#pragma unroll
            for (int d = 2; d < 4; ++d)
#pragma unroll
                for (int bk = 0; bk < 2; ++bk)
#pragma unroll
                    for (int s = 0; s < 2; ++s) { const int g = ((d - 2) * 2 + bk) * 2 + s;
                        S[d] = __builtin_amdgcn_mfma_f32_32x32x16_bf16(kdB[g], vb[bk][s], S[d], 0, 0, 0);
                        OW2(o1, 32, 2 * g);
                        __builtin_amdgcn_sched_barrier(0); }
#undef OW2
        } else {
            const int m = n - 1; const int tt = tid - 256, row = tt >> 2, qd = tt & 3;
            const size_t t = (size_t)b * SEQ + (m < 0 ? 0 : m) * 64 + row;
            u32x4 zv0, zv1, zv2, zv3;
            { const bf16_t* zp = P + t * PP + C_GZ + h * 128 + qd * 32;
              asm volatile("global_load_dwordx4 %0, %4, off\n\tglobal_load_dwordx4 %1, %4, off offset:16\n\tglobal_load_dwordx4 %2, %4, off offset:32\n\tglobal_load_dwordx4 %3, %4, off offset:48"
                           : "=&v"(zv0), "=&v"(zv1), "=&v"(zv2), "=&v"(zv3) : "v"(zp) : "memory"); }
            { const int nn = (n + 1 < 128) ? n + 1 : 127; const unsigned char* src = rec0 + (size_t)nn * rstep; const int lw = wave - 4; const int obn = (nn & 1) ? S_OP1 : S_OP0;
#pragma unroll
              for (int j = 8; j < 14; ++j) { const int k = lw + 4 * j;
                  if (k < 54) __builtin_amdgcn_global_load_lds((const unsigned*)(src + k * 1024 + lane * 16), (LAS unsigned*)(L + obn + k * 1024), 16, 0, 0);
                  else __builtin_amdgcn_global_load_lds((const unsigned*)(src + lane * 16), (LAS unsigned*)(L + 147456 + (lw & 1) * 1024), 16, 0, 0); } }
            if (n >= 2) asm volatile("s_waitcnt vmcnt(22)" ::: "memory"); else asm volatile("s_waitcnt vmcnt(18)" ::: "memory");
            __builtin_amdgcn_s_barrier();
            { const int nn = (n + 2 < 128) ? n + 2 : 127; const unsigned char* src = rec0 + (size_t)nn * rstep; const int lw = wave - 4; const int obn = (n & 1) ? S_OP1 : S_OP0;
#pragma unroll
              for (int j = 0; j < 8; ++j) { const int k = lw + 4 * j;
                  __builtin_amdgcn_global_load_lds((const unsigned*)(src + k * 1024 + lane * 16), (LAS unsigned*)(L + obn + k * 1024), 16, 0, 0); } }
            asm volatile("s_waitcnt vmcnt(14)" : "+v"(zv0), "+v"(zv1), "+v"(zv2), "+v"(zv3) :: "memory");
            const u32x4 zv[4] = {zv0, zv1, zv2, zv3};
            if (n >= 1) {
                const LAS unsigned char* ob = L + ((m & 1) ? S_OB1 : S_OB0) + row * PQ + qd * 64;
                float v[32], z[32]; float ssq = 0.f;
#pragma unroll
                for (int k = 0; k < 4; ++k) {
                    const u32x4 o4 = *(const LAS u32x4*)(ob + k * 16);
                    const unsigned ow[4] = {o4.x, o4.y, o4.z, o4.w}, zw[4] = {zv[k].x, zv[k].y, zv[k].z, zv[k].w};
#pragma unroll
                    for (int i = 0; i < 4; ++i) { v[k * 8 + 2 * i] = bflo(ow[i]); v[k * 8 + 2 * i + 1] = bfhi(ow[i]); z[k * 8 + 2 * i] = bflo(zw[i]); z[k * 8 + 2 * i + 1] = bfhi(zw[i]); }
                }
#pragma unroll
                for (int i = 0; i < 32; ++i) ssq += v[i] * v[i];
                ssq += __shfl_xor(ssq, 1); ssq += __shfl_xor(ssq, 2);
                const float rs = __builtin_amdgcn_rsqf(ssq * (1.0f / 128) + EPS);
#pragma unroll
                for (int k = 0; k < 4; ++k) {
                    float o[8];
#pragma unroll
                    for (int i = 0; i < 8; ++i) o[i] = v[k * 8 + i] * rs * ogl[qd * 32 + k * 8 + i] * z[k * 8 + i];
                    *(u32x4*)(P + t * PP + h * 128 + qd * 32 + k * 8) = pack8(o);
                }
            }
            if (n >= 2) asm volatile("s_waitcnt vmcnt(26)" ::: "memory"); else asm volatile("s_waitcnt vmcnt(22)" ::: "memory");
            if (wave == 4 && n + 3 < 128 && ((n + 3) & 31) == 8) ensure(n + 3, (n + 3 + 32 <= 128) ? 32 : 128 - (n + 3));
        }
        asm volatile("s_waitcnt lgkmcnt(0)" ::: "memory"); __builtin_amdgcn_s_barrier(); asm volatile("" ::: "memory");
    }
    asm volatile("s_waitcnt vmcnt(0)" ::: "memory");
    if (tid == 0) __hip_atomic_store(prog, 1000u, __ATOMIC_RELAXED, __HIP_MEMORY_SCOPE_AGENT);
    if (wave >= 4) {
        const int m = 127; const int tt = tid - 256, row = tt >> 2, qd = tt & 3;
        const LAS unsigned char* ob = L + ((m & 1) ? S_OB1 : S_OB0) + row * PQ + qd * 64;
        const size_t t = (size_t)b * SEQ + m * 64 + row;
        float ssq = 0.f; float v[32], z[32];
#pragma unroll
        for (int k = 0; k < 4; ++k) {
            const u32x4 o4 = *(const LAS u32x4*)(ob + k * 16), z4 = *(const u32x4*)(P + t * PP + C_GZ + h * 128 + qd * 32 + k * 8);
            const unsigned ow[4] = {o4.x, o4.y, o4.z, o4.w}, zw[4] = {z4.x, z4.y, z4.z, z4.w};
#pragma unroll
            for (int i = 0; i < 4; ++i) { v[k * 8 + 2 * i] = bflo(ow[i]); v[k * 8 + 2 * i + 1] = bfhi(ow[i]); z[k * 8 + 2 * i] = bflo(zw[i]); z[k * 8 + 2 * i + 1] = bfhi(zw[i]); }
        }
#pragma unroll
        for (int i = 0; i < 32; ++i) ssq += v[i] * v[i];
        ssq += __shfl_xor(ssq, 1); ssq += __shfl_xor(ssq, 2);
        const float rs = __builtin_amdgcn_rsqf(ssq * (1.0f / 128) + EPS);
#pragma unroll
        for (int k = 0; k < 4; ++k) {
            float o[8];
#pragma unroll
            for (int i = 0; i < 8; ++i) o[i] = v[k * 8 + i] * rs * ogl[qd * 32 + k * 8 + i] * z[k * 8 + i];
            *(u32x4*)(P + t * PP + h * 128 + qd * 32 + k * 8) = pack8(o);
        }
    }
}


__device__ __forceinline__ void scan_helper(Frame& F, int i, int part) {
    LAS unsigned char* L = F.lds; const int lane = F.lane, wave = F.wave;
#if HELP2
    const int tid = F.tid & 255; constexpr int HSTRIDE = 256; i += 8 * (wave >> 2);
#else
    const int tid = F.tid; constexpr int HSTRIDE = NTHREADS;
#endif
    const int b = i >> 2, h = i & 3;
    const unsigned char* rec0 = F.ws + WS_G + ((size_t)(b * 128) * 4 + h) * GREC; const size_t rstep = (size_t)4 * GREC;
    const bf16_t* P = (const bf16_t*)(F.ws + WS_C);
    unsigned* prog = (unsigned*)(F.ws + WS_CTL) + CW_PROG + 64 * i;
    constexpr int LA = 8;
    for (int n = 1; n < 128; ++n) {
        unsigned spins = 0;
        for (;;) {
            const unsigned p = __builtin_amdgcn_readfirstlane(__hip_atomic_load(prog, __ATOMIC_RELAXED, __HIP_MEMORY_SCOPE_AGENT));
            const unsigned f = __builtin_amdgcn_readfirstlane(__hip_atomic_load((unsigned*)(F.ws + WS_CTL) + CW_FLG + ((size_t)(b * 128 + n) * 4 + h), __ATOMIC_RELAXED, __HIP_MEMORY_SCOPE_AGENT));
            if ((int)p + LA >= n && f != 0u) break;
            __builtin_amdgcn_s_sleep(8);
            if (++spins > 20000u) break;
        }
        constexpr int NL = 576 / NHELP;
        for (int line = tid; line < NL + (part == 0 ? 128 : 0); line += HSTRIDE) {
        if (line < NL) __builtin_amdgcn_global_load_lds((const unsigned*)(rec0 + (size_t)n * rstep + part * (NL * 128) + line * 128), (LAS unsigned*)(L + wave * 256), 4, 0, 0);
        else { const int zl = line - NL; const int row = zl >> 1, hf = zl & 1;
            __builtin_amdgcn_global_load_lds((const unsigned*)(P + ((size_t)b * SEQ + n * 64 + row) * PP + C_GZ + h * 128 + hf * 64), (LAS unsigned*)(L + wave * 256), 4, 0, 0); }
        }
        asm volatile("s_waitcnt vmcnt(4)" ::: "memory");
    }
    asm volatile("s_waitcnt vmcnt(0)" ::: "memory");
}

constexpr size_t WS_IMG = 460 * MiB;
constexpr size_t WS_IMGM = 492 * MiB;
constexpr int CW_QUEUE = 8192;
constexpr float LOG2E = 1.4426950408889634f;

__device__ __forceinline__ void img_item(Frame& F, const Args& A, int item) {
    LAS unsigned char* L = F.lds; int tid = F.tid; asm volatile("" : "+v"(tid));
    const bool mem = item >= 512; const int bh = mem ? item - 512 : item >> 5, j = item & 31, b = bh >> 2, h = bh & 3;
    unsigned char* img = F.ws + (mem ? WS_IMGM + (size_t)bh * 65536 : WS_IMG + ((size_t)bh * 32 + j) * 65536);
    const int key = tid >> 1, half = tid & 1;
    LAS unsigned* TK = (LAS unsigned*)L;
    LAS unsigned* TV = TK + 256 * 33;
    LAS float* part = (LAS float*)(TV + 256 * 33);
    float kv[32], vv[32];
    if (!mem) {
        const bf16_t* P = (const bf16_t*)(F.ws + WS_C); const size_t t = (size_t)b * SEQ + j * 256 + key;
#pragma unroll
        for (int c4 = 0; c4 < 4; ++c4) {
            const u32x4 kw = *(const u32x4*)(P + t * PP + C_MK + h * 64 + half * 32 + c4 * 8), vw = *(const u32x4*)(P + t * PP + C_MV + h * 64 + half * 32 + c4 * 8);
            const unsigned ka[4] = {kw.x, kw.y, kw.z, kw.w}, va[4] = {vw.x, vw.y, vw.z, vw.w};
#pragma unroll
            for (int i = 0; i < 4; ++i) { kv[c4 * 8 + 2 * i] = bflo(ka[i]); kv[c4 * 8 + 2 * i + 1] = bfhi(ka[i]); vv[c4 * 8 + 2 * i] = bflo(va[i]); vv[c4 * 8 + 2 * i + 1] = bfhi(va[i]); }
        }
    } else {
        const float* KV = (const float*)(F.ws + WS_KVMEM) + ((size_t)b * MEMT + key) * 512 + h * 64 + half * 32;
#pragma unroll
        for (int c4 = 0; c4 < 8; ++c4) { const f32x4 kw = *(const f32x4*)(KV + c4 * 4), vw = *(const f32x4*)(KV + 256 + c4 * 4);
#pragma unroll
            for (int i = 0; i < 4; ++i) { kv[c4 * 4 + i] = kw[i]; vv[c4 * 4 + i] = vw[i]; } }
    }
    float ss = 0.f;
#pragma unroll
    for (int i = 0; i < 32; ++i) ss += kv[i] * kv[i];
    ss += __shfl_xor(ss, 1);
    const float rs = __builtin_amdgcn_rsqf(ss * (1.0f / 64) + EPS);
    const float* kg = (mem ? A.in[17] : A.in[13]) + half * 32;
    unsigned kp[16], vp[16];
#pragma unroll
    for (int i = 0; i < 16; ++i) { kp[i] = cvtpk(kv[2 * i] * rs * kg[2 * i], kv[2 * i + 1] * rs * kg[2 * i + 1]); vp[i] = cvtpk(vv[2 * i], vv[2 * i + 1]); }
#pragma unroll
    for (int i = 0; i < 16; ++i) { TK[key * 33 + half * 16 + i] = kp[i]; TV[key * 33 + half * 16 + i] = vp[i]; }
#pragma unroll
    for (int cc = 0; cc < 4; ++cc) { const int ch = half * 4 + cc; u32x4 w; w.x = kp[cc * 4]; w.y = kp[cc * 4 + 1]; w.z = kp[cc * 4 + 2]; w.w = kp[cc * 4 + 3];
        *(u32x4*)(img + key * 128 + ((ch ^ ((key >> 1) & 7)) * 16)) = w; }
    __syncthreads();
    const LAS unsigned short* TKh = (const LAS unsigned short*)TK; const LAS unsigned short* TVh = (const LAS unsigned short*)TV;
    if (!mem) { const int d = tid & 63, kq = tid >> 6; float a = 0.f;
#pragma unroll 8
        for (int k = 0; k < 32; ++k) a += bf2f(TKh[(kq * 32 + k) * 66 + d]);
        part[kq * 64 + d] = a; }
    {
        const int d = tid >> 3, pt = tid & 7;
#pragma unroll
        for (int cc = 0; cc < 4; ++cc) { const int ch = pt * 4 + cc; unsigned short e[8];
#pragma unroll
            for (int x = 0; x < 8; ++x) { const int pos = ch * 8 + x, kt = pos >> 5, p5 = pos & 31; const int kap = (p5 & 16) | ((p5 & 4) << 1) | ((p5 & 8) >> 1) | (p5 & 3);
                e[x] = TVh[(kt * 32 + kap) * 66 + d]; }
            u32x4 w; w.x = e[0] | ((unsigned)e[1] << 16); w.y = e[2] | ((unsigned)e[3] << 16); w.z = e[4] | ((unsigned)e[5] << 16); w.w = e[6] | ((unsigned)e[7] << 16);
            *(u32x4*)(img + 32768 + d * 512 + ((ch ^ (d & 15)) * 16)) = w; }
    }
    __syncthreads();
    if (!mem && tid < 64) { float a = 0.f;
#pragma unroll
        for (int k = 0; k < 8; ++k) a += part[k * 64 + tid];
        ((float*)(F.ws + WS_KMEAN))[((size_t)bh * 32 + j) * 64 + tid] = a * (1.0f / 256); }
    __syncthreads();
}

__device__ __forceinline__ void attn_item(Frame& F, const Args& A, const int kind, const int bh, const int c) {
    LAS unsigned char* L = F.lds; int tid = F.tid; asm volatile("" : "+v"(tid)); const int lane = tid & 63, wave = F.wave;
    const int b = bh >> 2, h = bh & 3, r = lane & 31, hh = lane >> 5;
    bf16_t* P = (bf16_t*)(F.ws + WS_C);
    const unsigned char* img0 = F.ws + (kind ? WS_IMGM + (size_t)bh * 65536 : WS_IMG + (size_t)bh * 32 * 65536);
    const int nb = kind ? 1 : c + 1, nst = 2 * nb;
    auto stage = [&](int st) {
        const unsigned char* src = img0 + (size_t)(st >> 1) * 65536; const int hf = st & 1; LAS unsigned char* dst = L + (st & 3) * 32768;
#pragma unroll
        for (int k = 0; k < 4; ++k) { const int p = wave * 4 + k;
            if (p < 16) __builtin_amdgcn_global_load_lds((const unsigned*)(src + hf * 16384 + p * 1024 + lane * 16), (LAS unsigned*)(dst + p * 1024), 16, 0, 0);
            else { const int pp = p - 16;
                __builtin_amdgcn_global_load_lds((const unsigned*)(src + 32768 + (4 * pp + (lane >> 4)) * 512 + hf * 256 + (lane & 15) * 16), (LAS unsigned*)(dst + 16384 + pp * 1024), 16, 0, 0); } }
    };
    LAS float* KM = (LAS float*)(L + 131072);
    if (!kind) { const float* kmg = (const float*)(F.ws + WS_KMEAN) + (size_t)bh * 32 * 64; for (int i = tid; i < c * 64; i += NTHREADS) KM[i] = kmg[i]; }
    const int qloc = 32 * wave + r, qpos = c * 256 + qloc; const size_t t = (size_t)b * SEQ + qpos;
    const bf16_t* qp = P + t * PP + (kind ? C_CQ : C_MQ) + h * 64;
    const float* qgain = kind ? A.in[16] : A.in[12]; const float* kgain = kind ? A.in[17] : A.in[13];
    const float mq = wave_max(fabsf(qgain[lane])), mk = wave_max(fabsf(kgain[lane]));
    const float M2 = (8.0f * mq * mk * 1.02f + 0.05f) * LOG2E;
    const float slope2 = kind ? 0.f : exp2f(-2.0f * (float)(h + 1)) * LOG2E;
    float qg[32];
    {
#pragma unroll
        for (int c4 = 0; c4 < 4; ++c4) { const u32x4 w = *(const u32x4*)(qp + hh * 32 + c4 * 8); const unsigned wa[4] = {w.x, w.y, w.z, w.w};
#pragma unroll
            for (int i = 0; i < 4; ++i) { qg[c4 * 8 + 2 * i] = bflo(wa[i]); qg[c4 * 8 + 2 * i + 1] = bfhi(wa[i]); } }
    }
    float ss = 0.f;
#pragma unroll
    for (int i = 0; i < 32; ++i) ss += qg[i] * qg[i];
    ss += __shfl_xor(ss, 32);
    const float rs = __builtin_amdgcn_rsqf(ss * (1.0f / 64) + EPS);
    bf16x8 Qf[4];
#pragma unroll
    for (int s = 0; s < 4; ++s) { const int d0 = 16 * s + 8 * hh; const u32x4 w = *(const u32x4*)(qp + d0); const unsigned wa[4] = {w.x, w.y, w.z, w.w}; const float sc = rs * (0.125f * LOG2E);
        float v[8];
#pragma unroll
        for (int i = 0; i < 4; ++i) { v[2 * i] = bflo(wa[i]) * sc * qgain[d0 + 2 * i]; v[2 * i + 1] = bfhi(wa[i]) * sc * qgain[d0 + 2 * i + 1]; }
        Qf[s] = __builtin_bit_cast(bf16x8, pack8(v)); }
    unsigned selmask = 0u;
    if (!kind) {
#pragma unroll
        for (int i = 0; i < 32; ++i) qg[i] *= rs * qgain[hh * 32 + i];
    }
    asm volatile("s_waitcnt vmcnt(0)" : "+v"(qg[0]), "+v"(qg[31]) :: "memory");
    __syncthreads();
    stage(0); stage(1); if (nst > 2) stage(2);
    if (!kind && c > 0) {
        float v0 = -INFINITY, v1 = -INFINITY, v2 = -INFINITY; int i0 = -1, i1 = -1, i2 = -1;
        for (int j = 0; j < c; ++j) {
            const LAS f32x4* km = (const LAS f32x4*)(KM + j * 64 + hh * 32);
            float g = 0.f;
#pragma unroll
            for (int k = 0; k < 8; ++k) { const f32x4 m4 = km[k]; g += qg[4 * k] * m4[0] + qg[4 * k + 1] * m4[1] + qg[4 * k + 2] * m4[2] + qg[4 * k + 3] * m4[3]; }
            g += __shfl_xor(g, 32);
            if (g > v0) { v2 = v1; i2 = i1; v1 = v0; i1 = i0; v0 = g; i0 = j; }
            else if (g > v1) { v2 = v1; i2 = i1; v1 = g; i1 = j; }
            else if (g > v2) { v2 = g; i2 = j; }
        }
        if (i0 >= 0) selmask |= 1u << i0; if (i1 >= 0) selmask |= 1u << i1; if (i2 >= 0) selmask |= 1u << i2;
    }
    unsigned chs[4];
#pragma unroll
    for (int s = 0; s < 4; ++s) chs[s] = (unsigned)(r * 128 + (((2 * s + hh) ^ ((r >> 1) & 7)) * 16));
    const float lo4 = slope2 * (float)(4 * hh);
    f32x16 O0, O1;
#pragma unroll
    for (int i = 0; i < 16; ++i) { O0[i] = 0.f; O1[i] = 0.f; }
    float lsum = 0.f;
    for (int st = 0; st < nst; ++st) {
        const int younger = (nst - 1 - st) < 2 ? (nst - 1 - st) : 2;
        if (younger == 2) asm volatile("s_waitcnt vmcnt(8)" ::: "memory"); else if (younger == 1) asm volatile("s_waitcnt vmcnt(4)" ::: "memory"); else asm volatile("s_waitcnt vmcnt(0)" ::: "memory");
        asm volatile("s_waitcnt lgkmcnt(0)" ::: "memory"); __builtin_amdgcn_s_barrier(); asm volatile("" ::: "memory");
        if (st + 3 < nst) stage(st + 3);
        const int i = st >> 1, hf = st & 1;
        const bool own = (!kind) && (i == c);
        bool sel = true; if (!kind && !own) sel = (selmask >> i) & 1u;
        if (__ballot(sel) == 0ull) continue;
        const float laneoff = sel ? (slope2 * (float)(256 * i - qpos) - M2) : -INFINITY;
        const int ktmax = own ? wave : 7;
        const LAS unsigned char* kb = L + (st & 3) * 32768; const LAS unsigned char* vb = kb + 16384 + r * 256;
        const int nkt = (ktmax - 4 * hf + 1) < 4 ? (ktmax - 4 * hf + 1) : 4;
        if (nkt <= 0) continue;
        bf16x8 kf[4];
#pragma unroll
        for (int s = 0; s < 4; ++s) kf[s] = *(const LAS bf16x8*)(kb + chs[s]);
#pragma unroll 1
        for (int ktl = 0; ktl < nkt; ++ktl) {
            const int kt = 4 * hf + ktl;
            f32x16 C; const float lo = laneoff + slope2 * (float)(32 * kt) + lo4;
#pragma unroll
            for (int x = 0; x < 16; ++x) C[x] = slope2 * (float)((x & 3) + 8 * (x >> 2)) + lo;
#pragma unroll
            for (int s = 0; s < 4; ++s) C = __builtin_amdgcn_mfma_f32_32x32x16_bf16(kf[s], Qf[s], C, 0, 0, 0);
            const unsigned c0 = (unsigned)(((4 * ktl + hh) ^ (r & 15)) * 16), c1 = (unsigned)(((4 * ktl + 2 + hh) ^ (r & 15)) * 16);
            const bf16x8 vf0 = *(const LAS bf16x8*)(vb + c0), vf1 = *(const LAS bf16x8*)(vb + 32 * 256 + c0);
            const bf16x8 vf2 = *(const LAS bf16x8*)(vb + c1), vf3 = *(const LAS bf16x8*)(vb + 32 * 256 + c1);
            const int kn = (ktl + 1 < nkt) ? ktl + 1 : ktl;
#pragma unroll
            for (int s = 0; s < 4; ++s) kf[s] = *(const LAS bf16x8*)(kb + kn * 4096 + chs[s]);
            __builtin_amdgcn_sched_barrier(0);
            if (own && kt == wave) {
#pragma unroll
                for (int x = 0; x < 16; ++x) if ((x & 3) + 8 * (x >> 2) + 4 * hh > r) C[x] = -INFINITY;
            }
#pragma unroll
            for (int x = 0; x < 16; ++x) C[x] = __builtin_amdgcn_exp2f(C[x]);
            const float ps = (((C[0] + C[1]) + (C[2] + C[3])) + ((C[4] + C[5]) + (C[6] + C[7]))) + (((C[8] + C[9]) + (C[10] + C[11])) + ((C[12] + C[13]) + (C[14] + C[15])));
            lsum += ps;
            const bf16x8 p0 = cvt8(C, 0), p1 = cvt8(C, 1);
            O0 = __builtin_amdgcn_mfma_f32_32x32x16_bf16(vf0, p0, O0, 0, 0, 0);
            O1 = __builtin_amdgcn_mfma_f32_32x32x16_bf16(vf1, p0, O1, 0, 0, 0);
            O0 = __builtin_amdgcn_mfma_f32_32x32x16_bf16(vf2, p1, O0, 0, 0, 0);
            O1 = __builtin_amdgcn_mfma_f32_32x32x16_bf16(vf3, p1, O1, 0, 0, 0);
        }
    }
    lsum += __shfl_xor(lsum, 32);
    const float inv = 1.0f / lsum;
    bf16_t* yp = P + t * PP + (kind ? 768 : 512) + h * 64 + 4 * hh;
#pragma unroll
    for (int g = 0; g < 4; ++g) {
        u32x2 w0, w1; w0.x = cvtpk(O0[4 * g] * inv, O0[4 * g + 1] * inv); w0.y = cvtpk(O0[4 * g + 2] * inv, O0[4 * g + 3] * inv);
        w1.x = cvtpk(O1[4 * g] * inv, O1[4 * g + 1] * inv); w1.y = cvtpk(O1[4 * g + 2] * inv, O1[4 * g + 3] * inv);
        *(u32x2*)(yp + 8 * g) = w0; *(u32x2*)(yp + 32 + 8 * g) = w1;
    }
}

__device__ __forceinline__ void p4b_attn(Frame& F, const Args& A, int pass) {
    LAS unsigned* qw = (LAS unsigned*)(F.lds + 140000);
    unsigned* heads = (unsigned*)(F.ws + WS_CTL) + CW_QUEUE + 1024 * pass;
    const int myq = (int)(xb_xcc_id() & 7u);
    for (int qi = 0; qi < 8; ++qi) {
        const int q = (myq + qi) & 7;
        for (;;) {
            __syncthreads();
            if (F.tid == 0) *qw = atomicAdd(heads + 64 * q, 1u);
            __syncthreads();
            const int idx = (int)*qw;
            if (idx >= 128) break;
            const int bh = 2 * q + (idx & 1);
            if (idx < 64) attn_item(F, A, 0, bh, 31 - (idx >> 1));
            else attn_item(F, A, 1, bh, (idx - 64) >> 1);
        }
    }
}

__device__ __forceinline__ void naive_gdn(Frame& F, const Args& A, int b, int h) {
    unsigned char* ws = F.ws;
    LAS float* vec = (LAS float*)F.lds;
    LAS float* ba = vec + 32 * 384;
    LAS float* part = ba + 64;
    LAS float* part2 = part + 512;
    LAS float* obuf = part2 + 512;
    const int tid = F.tid, e = tid & 127, dq = tid >> 7;
    const bf16_t* GQ = (const bf16_t*)(ws + WS_GQ); const bf16_t* GK = (const bf16_t*)(ws + WS_GK); const bf16_t* GV = (const bf16_t*)(ws + WS_GV);
    const float* GB = (const float*)(ws + WS_GB); const float* GG = (const float*)(ws + WS_GG);
    bf16_t* P = (bf16_t*)(ws + WS_C);
    const float* og = A.in[11];
    float S[32];
#pragma unroll
    for (int i = 0; i < 32; ++i) S[i] = 0.f;
    for (int c0 = 0; c0 < SEQ; c0 += 32) {
        __syncthreads();
        for (int i = tid; i < 32 * 384; i += NTHREADS) { const int tk = i / 384, r = i % 384; const size_t t = (size_t)b * SEQ + c0 + tk;
            const bf16_t* src = (r < 128) ? GQ : (r < 256) ? GK : GV;
            vec[i] = bf2f(src[t * 512 + h * 128 + (r & 127)]); }
        if (tid < 32) { const size_t t = (size_t)b * SEQ + c0 + tid; ba[tid * 2] = GB[t * 4 + h]; ba[tid * 2 + 1] = __expf(GG[t * 4 + h]); }
        __syncthreads();
        for (int tk = 0; tk < 32; ++tk) {
            const LAS float* qq = vec + tk * 384 + 32 * dq; const LAS float* kk = qq + 128; const float vv = vec[tk * 384 + 256 + e];
            const float beta = ba[tk * 2], alpha = ba[tk * 2 + 1];
            float p = 0.f;
#pragma unroll
            for (int i = 0; i < 32; ++i) p += S[i] * kk[i];
            part[dq * 128 + e] = p;
            __syncthreads();
            const float Sk = (part[e] + part[128 + e]) + (part[256 + e] + part[384 + e]);
            const float vn = beta * (vv - alpha * Sk);
            float po = 0.f;
#pragma unroll
            for (int i = 0; i < 32; ++i) { S[i] = alpha * S[i] + kk[i] * vn; po += S[i] * qq[i]; }
            part2[dq * 128 + e] = po;
            __syncthreads();
            if (dq == 0) obuf[tk * 128 + e] = (part2[e] + part2[128 + e]) + (part2[256 + e] + part2[384 + e]);
        }
        __syncthreads();
        { const int r = tid >> 4, cb = (tid & 15) * 8; const size_t t = (size_t)b * SEQ + c0 + r;
            float v[8]; float s = 0.f;
#pragma unroll
            for (int i = 0; i < 8; ++i) { v[i] = obuf[r * 128 + cb + i]; s += v[i] * v[i]; }
#pragma unroll
            for (int o = 1; o < 16; o <<= 1) s += __shfl_xor(s, o);
            const float rs = __builtin_amdgcn_rsqf(s * (1.0f / 128) + EPS);
            const u32x4 zw = *(const u32x4*)(P + t * PP + C_GZ + h * 128 + cb);
            float z[8] = {bflo(zw.x), bfhi(zw.x), bflo(zw.y), bfhi(zw.y), bflo(zw.z), bfhi(zw.z), bflo(zw.w), bfhi(zw.w)};
            float o[8];
#pragma unroll
            for (int i = 0; i < 8; ++i) o[i] = v[i] * rs * og[cb + i] * z[i];
            u32x4 w; w.x = pk2(o[0], o[1]); w.y = pk2(o[2], o[3]); w.z = pk2(o[4], o[5]); w.w = pk2(o[6], o[7]);
            *(u32x4*)(P + t * PP + h * 128 + cb) = w; }
    }
}

__device__ __forceinline__ void naive_moba_query(Frame& F, const Args& A, int t, int h, LAS float* sc, LAS float* qs) {
    unsigned char* ws = F.ws; const int lane = F.lane;
    bf16_t* P = (bf16_t*)(ws + WS_C);
    const bf16_t* KNM = (const bf16_t*)(ws + WS_KNM); const float* KM = (const float*)(ws + WS_KMEAN);
    const int b = t >> 13, tl = t & (SEQ - 1), own = tl >> 8, bh = b * 4 + h;
    const float qraw = bf2f(P[(size_t)t * PP + C_MQ + h * 64 + lane]);
    const float qh = qraw * __builtin_amdgcn_rsqf(wave_sum(qraw * qraw) * (1.0f / 64) + EPS) * A.in[12][lane];
    qs[lane] = qh;
    float mygate = -INFINITY;
    for (int j = 0; j < own; ++j) { const float g = wave_sum(qh * KM[((size_t)bh * 32 + j) * 64 + lane]); if (lane == j) mygate = g; }
    const int nsel = own < 3 ? own : 3;
    int sel0 = 0, sel1 = 0, sel2 = 0;
#pragma unroll
    for (int r = 0; r < 3; ++r) {
        if (r < nsel) {
            const float mx = wave_max(mygate);
            const unsigned long long bal = __ballot(mygate == mx);
            const int idx = __builtin_ctzll(bal);
            if (r == 0) sel0 = idx; else if (r == 1) sel1 = idx; else sel2 = idx;
            if (lane == idx) mygate = -INFINITY;
        }
    }
#define SELBLK(bi) (((bi) >= nsel) ? own : ((bi) == 0 ? sel0 : ((bi) == 1 ? sel1 : sel2)))
    const float slope = exp2f(-2.0f * (float)(h + 1));
    asm volatile("s_waitcnt lgkmcnt(0)" ::: "memory");
    float m = -INFINITY;
    const int nblk = nsel + 1;
    for (int bi = 0; bi < nblk; ++bi) {
        const int blk = SELBLK(bi);
        for (int kc = 0; kc < 4; ++kc) {
            const int key = blk * 256 + kc * 64 + lane;
            const u32x4* kp = (const u32x4*)(KNM + ((size_t)bh * SEQ + key) * 64);
            float dot = 0.f;
#pragma unroll
            for (int c = 0; c < 8; ++c) { const u32x4 w = kp[c];
                dot += qs[c * 8 + 0] * bflo(w.x) + qs[c * 8 + 1] * bfhi(w.x) + qs[c * 8 + 2] * bflo(w.y) + qs[c * 8 + 3] * bfhi(w.y)
                     + qs[c * 8 + 4] * bflo(w.z) + qs[c * 8 + 5] * bfhi(w.z) + qs[c * 8 + 6] * bflo(w.w) + qs[c * 8 + 7] * bfhi(w.w); }
            float s = dot * 0.125f - slope * (float)(tl - key);
            if (key > tl) s = -INFINITY;
            sc[bi * 256 + kc * 64 + lane] = s; m = fmaxf(m, s);
        }
    }
    m = wave_max(m);
    float l = 0.f;
    for (int i = lane; i < nblk * 256; i += 64) { const float p = __expf(sc[i] - m); sc[i] = p; l += p; }
    l = wave_sum(l);
    asm volatile("s_waitcnt lgkmcnt(0)" ::: "memory");
    float o = 0.f;
    for (int bi = 0; bi < nblk; ++bi) {
        const int blk = SELBLK(bi);
        const bf16_t* vp = P + ((size_t)b * SEQ + blk * 256) * PP + C_MV + h * 64 + lane;
#pragma unroll 8
        for (int k = 0; k < 256; ++k) o += sc[bi * 256 + k] * bf2f(vp[(size_t)k * PP]);
    }
    P[(size_t)t * PP + 512 + h * 64 + lane] = (bf16_t)f2bf(o / l);
}
__device__ __forceinline__ void naive_mem_query(Frame& F, const Args& A, int t, int h, LAS float* sc, LAS float* qs) {
    unsigned char* ws = F.ws; const int lane = F.lane;
    bf16_t* P = (bf16_t*)(ws + WS_C);
    const float* KV = (const float*)(ws + WS_KVMEM);
    const int b = t >> 13;
    const float qraw = bf2f(P[(size_t)t * PP + C_CQ + h * 64 + lane]);
    const float qh = qraw * __builtin_amdgcn_rsqf(wave_sum(qraw * qraw) * (1.0f / 64) + EPS) * A.in[16][lane];
    qs[lane] = qh;
    const float* kg = A.in[17];
    asm volatile("s_waitcnt lgkmcnt(0)" ::: "memory");
    float m = -INFINITY;
    for (int kc = 0; kc < 4; ++kc) {
        const int key = kc * 64 + lane;
        const f32x4* kp = (const f32x4*)(KV + ((size_t)b * MEMT + key) * 512 + h * 64);
        float dot = 0.f, s2 = 0.f;
#pragma unroll
        for (int c = 0; c < 16; ++c) { const f32x4 w = kp[c];
            dot += qs[c * 4 + 0] * w[0] * kg[c * 4 + 0] + qs[c * 4 + 1] * w[1] * kg[c * 4 + 1] + qs[c * 4 + 2] * w[2] * kg[c * 4 + 2] + qs[c * 4 + 3] * w[3] * kg[c * 4 + 3];
            s2 += (w[0] * w[0] + w[1] * w[1]) + (w[2] * w[2] + w[3] * w[3]); }
        const float s = dot * __builtin_amdgcn_rsqf(s2 * (1.0f / 64) + EPS) * 0.125f;
        sc[key] = s; m = fmaxf(m, s);
    }
    m = wave_max(m);
    float l = 0.f;
    for (int i = lane; i < 256; i += 64) { const float p = __expf(sc[i] - m); sc[i] = p; l += p; }
    l = wave_sum(l);
    asm volatile("s_waitcnt lgkmcnt(0)" ::: "memory");
    float o = 0.f;
    const float* vp = KV + (size_t)b * MEMT * 512 + 256 + h * 64 + lane;
#pragma unroll 8
    for (int k = 0; k < 256; ++k) o += sc[k] * vp[(size_t)k * 512];
    P[(size_t)t * PP + 768 + h * 64 + lane] = (bf16_t)f2bf(o / l);
}

__device__ __forceinline__ void p4b_naive(Frame& F, const Args& A, int pass) {
    const int bx = blockIdx.x;
#if GDN_NAIVE
    if (bx < 16) { naive_gdn(F, A, bx >> 2, bx & 3); return; }
#else
    if (bx < 16 && !(PROBE_DUP == 51 && pass == 1)) { gdn_scan(F, A, bx >> 2, bx & 3); }
#if HELP2
    else if (bx < 24 && !(PROBE_DUP == 51 && pass == 1)) { scan_helper(F, bx - 16, 0); }
#else
    else if (bx < 16 + 16 * NHELP && !(PROBE_DUP == 51 && pass == 1)) { scan_helper(F, (bx - 16) & 15, (bx - 16) >> 4); }
#endif
#endif
#if !GDN_NAIVE
    if (!(PROBE_DUP == 51 && pass == 1)) {
        LAS unsigned* qw = (LAS unsigned*)(F.lds + 140000);
        unsigned* head = (unsigned*)(F.ws + WS_CTL) + CW_PQ;
        u32x4 praw[11]; float pa = 0.f, pb = 0.f; int cw_head = -1, pend = -1;
#define PREP_ITEM(q_) ((((q_) & 15) >> 2) * 128 + ((q_) >> 4)) * 4 + ((q_) & 3)
        __syncthreads(); if (F.tid == 0) *qw = atomicAdd(head, 1u); __syncthreads();
        int cur = __builtin_amdgcn_readfirstlane((int)*qw);
        if (cur < N_PREP) gdn_prep_fetch(F, PREP_ITEM(cur), praw, pa, pb);
        while (cur < N_PREP) {
            __syncthreads(); if (F.tid == 0) *qw = atomicAdd(head, 1u); __syncthreads();
            const int nxt = __builtin_amdgcn_readfirstlane((int)*qw);
            gdn_prep_item(F, A, PREP_ITEM(cur), nxt < N_PREP ? PREP_ITEM(nxt) : (1 << 30), praw, pa, pb, cw_head, pend);
            cur = nxt;
        }
        if (pend >= 0) {
            asm volatile("s_waitcnt vmcnt(0)" ::: "memory");
            __syncthreads();
            if (F.tid == 0) __hip_atomic_store((unsigned*)(F.ws + WS_CTL) + CW_FLG + pend, 1u, __ATOMIC_RELAXED, __HIP_MEMORY_SCOPE_AGENT);
        }
#undef PREP_ITEM
    }
#endif
#if !ATTN_NAIVE
    p4b_attn(F, A, (PROBE_DUP == 51) ? pass : 0); return;
#endif
    LAS float* sc = (LAS float*)F.lds + F.wave * 1152;
    LAS float* qs = sc + 1024;
    const int w = bx - 16, NW = F.G - 16;
    const int NQ = T * 4 / 8;
    for (int it = w; it < 2 * NQ; it += NW) {
        const int kind = it >= NQ; const int q = (kind ? it - NQ : it) * 8 + F.wave;
        if (kind) naive_mem_query(F, A, q >> 2, q & 3, sc, qs); else naive_moba_query(F, A, q >> 2, q & 3, sc, qs);
    }
}

__global__ void __launch_bounds__(NTHREADS, 2) mk_fwd(Args args) {
    extern __shared__ __attribute__((aligned(16))) unsigned char lds_raw[];
    Frame F;
    F.lds = (LAS unsigned char*)lds_raw;
    F.tid = threadIdx.x; F.lane = F.tid & 63; F.wave = __builtin_amdgcn_readfirstlane(F.tid >> 6);
    F.G = gridDim.x; { const int bx = blockIdx.x; F.vcu = (F.G % 8 == 0) ? (bx % 8) * (F.G / 8) + bx / 8 : bx; }
    F.out = args.out; F.ws = args.ws;
    unsigned char* ws = args.ws;
    const int lo = args.ph_lo, hi = args.ph_hi;
#define IN(k) (lo <= (k) && (k) < hi)
#if USE_CG_SYNC
#define SEAM(k) do { if (IN(k) && IN((k) + 1)) { cg::this_grid().sync(); } } while (0)
#else
    { volatile LAS unsigned* st = (volatile LAS unsigned*)(F.lds + LDS_ST_OFF); if (F.tid < 4) st[F.tid] = 0u; }
    __syncthreads();
    XcdBarrier bar = xcd_barrier_post((unsigned*)(ws + WS_CTL) + CW_BAR, (volatile LAS unsigned*)(F.lds + LDS_ST_OFF));
#define SEAM(k) do { if (IN(k) && IN((k) + 1)) { xcd_barrier(bar); } } while (0)
#endif
#define PH_BEGIN(k) for (int _r = 0; _r < ((PROBE_DUP == (k) || (PROBE_DUP == 51 && (k) == 5)) ? 2 : 1); ++_r) { if (_r) xcd_barrier(bar);
#define PH_END }
    float* ss = (float*)(ws + WS_SS);
    bf16_t* XB = (bf16_t*)(ws + WS_XB);
    bf16_t* PC = (bf16_t*)(ws + WS_C);

    PH_BEGIN(0) if (IN(0)) { p0_prologue(F, args); }
    PH_END
    SEAM(0);
#if PROBE_DUP == 61
    { pg8::Gemm g{XB, (const bf16_t*)(ws + WS_WGU1), T, NGU, DM, DM}; pg8::StaticOrder S; S.init(T, NGU, F.G, (int)blockIdx.x);
      pg8::EpiNullP E{(float*)(ws + WS_CTL) + 60000}; pg8::gemm_phase<pg8::EpiNullP, true>(F.lds, g, S, E); xcd_barrier(bar); }
#endif
    PH_BEGIN(1) if (IN(1)) {
        pg8::Gemm g{XB, (const bf16_t*)(ws + WS_WGU1), T, NGU, DM, DM}; pg8::StaticOrder S; S.init(T, NGU, F.G, (int)blockIdx.x);
        pg8::EpiSwiGLU E{PC, ss};
        pg8::gemm_phase<pg8::EpiSwiGLU, true>(F.lds, g, S, E, ss);
    }
    PH_END
    SEAM(1);
#if PROBE_DUP == 62
    { pg8::Gemm g{PC, (const bf16_t*)(ws + WS_WD1), T, DM, FF, FF}; pg8::StaticOrder S; S.init(T, DM, F.G, (int)blockIdx.x);
      pg8::EpiNullN E{(float*)(ws + WS_CTL) + 60000}; pg8::gemm_phase<pg8::EpiNullN, true>(F.lds, g, S, E); xcd_barrier(bar); }
#endif
    PH_BEGIN(2) if (IN(2)) {
        pg8::Gemm g{PC, (const bf16_t*)(ws + WS_WD1), T, DM, FF, FF}; pg8::StaticOrder S; S.init(T, DM, F.G, (int)blockIdx.x);
        pg8::EpiResid<1> E{nullptr, F.out, XB, ss, 0.5f};
        pg8::gemm_phase<pg8::EpiResid<1>, true>(F.lds, g, S, E);
    }
    PH_END
    SEAM(2);
    PH_BEGIN(3) if (IN(3)) {
        pg8::Gemm g{XB, (const bf16_t*)(ws + WS_WIN), T, NIN, DM, DM}; pg8::StaticOrder S; S.init(T, NIN, F.G, (int)blockIdx.x);
        pg8::EpiWin E{PC, (float*)(ws + WS_AB), ss};
        pg8::gemm_phase<pg8::EpiWin, true>(F.lds, g, S, E, ss);
        {
            pg8::Gemm g2{(const bf16_t*)(ws + WS_MEMB), (const bf16_t*)(ws + WS_WKV), BATCH * MEMT, 512, DM, DM}; pg8::StaticOrder S2; S2.init(BATCH * MEMT, 512, 8, (int)blockIdx.x - (F.G - 8));
            pg8::EpiKV E2{(float*)(ws + WS_KVMEM), (const float*)(ws + WS_RSTDM)};
            pg8::gemm_phase<pg8::EpiKV, false>(F.lds, g2, S2, E2);
        }
        {
            const int rem = ((T / 256) * (NIN / 256)) % F.G; int lo = rem, hi = F.G - 8; if (hi - lo < 32) { lo = 0; hi = F.G; }
            const int c = (int)blockIdx.x;
            if (c >= lo && c < hi) tr_weights<1>(F, args, (c - lo) * NWAVES + F.wave, (hi - lo) * NWAVES);
        }
    }
    PH_END
    SEAM(3);
    PH_BEGIN(4) if (IN(4)) {
#if ATTN_NAIVE
        p4a_naive(F, args);
#else
        for (int it = F.vcu; it < 528; it += F.G) img_item(F, args, it);
#endif
    }
    PH_END
    SEAM(4);
    PH_BEGIN(5) if (IN(5)) { p4b_naive(F, args, _r); }
    PH_END
    SEAM(5);
    PH_BEGIN(6) if (IN(6)) {
        pg8::Gemm g{PC, (const bf16_t*)(ws + WS_WOUT), T, DM, DM, PP}; pg8::StaticOrder S; S.init(T, DM, F.G, (int)blockIdx.x);
        pg8::EpiResid<1> E{nullptr, F.out, XB, ss, 1.0f};
        pg8::gemm_phase<pg8::EpiResid<1>, true>(F.lds, g, S, E);
    }
    PH_END
    SEAM(6);
    PH_BEGIN(7) if (IN(7)) {
        pg8::Gemm g{XB, (const bf16_t*)(ws + WS_WGU2), T, NGU, DM, DM}; pg8::StaticOrder S; S.init(T, NGU, F.G, (int)blockIdx.x);
        pg8::EpiSwiGLU E{PC, ss};
        pg8::gemm_phase<pg8::EpiSwiGLU, true>(F.lds, g, S, E, ss);
    }
    PH_END
    SEAM(7);
    PH_BEGIN(8) if (IN(8)) {
        pg8::Gemm g{PC, (const bf16_t*)(ws + WS_WD2), T, DM, FF, FF}; pg8::StaticOrder S; S.init(T, DM, F.G, (int)blockIdx.x);
        pg8::EpiResid<2> E{nullptr, F.out, XB, ss, 0.5f};
        pg8::gemm_phase<pg8::EpiResid<2>, true>(F.lds, g, S, E);
    }
    PH_END
#undef IN
#undef SEAM
}

constexpr int N_PHASES = 9;
extern "C" void kernel_launch(void* const* d_in, const int* in_sizes, int n_in, void* d_out, int out_size, void* d_ws, size_t ws_size, hipStream_t stream) {
    static int grid = 0;
    if (grid == 0) {
        if (n_in != 23 || out_size != T * DM || ws_size < WS_END) { fprintf(stderr, "kernel_launch: unexpected shapes (n_in %d out %d ws %zu)\n", n_in, out_size, ws_size); grid = -1; return; }
        int dev = 0, cus = 0, per_cu = 0;
        (void)hipGetDevice(&dev); (void)hipDeviceGetAttribute(&cus, hipDeviceAttributeMultiprocessorCount, dev);
        (void)hipFuncSetAttribute((const void*)mk_fwd, hipFuncAttributeMaxDynamicSharedMemorySize, LDS_BYTES);
        (void)hipOccupancyMaxActiveBlocksPerMultiprocessor(&per_cu, (const void*)mk_fwd, NTHREADS, LDS_BYTES);
        (void)hipGetLastError();
        if (per_cu < 1) { fprintf(stderr, "kernel_launch: occupancy query says %d blocks/CU\n", per_cu); }
        grid = cus;
        if (grid != 256) fprintf(stderr, "kernel_launch: %d CUs (expected 256)\n", grid);
    }
    if (grid < 0) return;
    (void)hipMemsetAsync((char*)d_ws + WS_CTL, 0, 81920, stream);
    Args a{};
    for (int i = 0; i < 23; ++i) a.in[i] = (const float*)d_in[i];
    a.out = (float*)d_out; a.ws = (unsigned char*)d_ws;
    if (MK_N_LAUNCHES == 1) {
        a.ph_lo = 0; a.ph_hi = N_PHASES;
#if USE_CG_SYNC
        void* kargs[] = {&a};
        hipError_t e = hipLaunchCooperativeKernel((const void*)mk_fwd, dim3(grid), dim3(NTHREADS), kargs, LDS_BYTES, stream);
        if (e != hipSuccess) fprintf(stderr, "cooperative launch failed: %s\n", hipGetErrorString(e));
#else
        hipLaunchKernelGGL(mk_fwd, dim3(grid), dim3(NTHREADS), LDS_BYTES, stream, a);
#endif
    } else {
        for (int p = 0; p < N_PHASES; ++p) {
            a.ph_lo = p; a.ph_hi = p + 1;
            hipLaunchKernelGGL(mk_fwd, dim3(grid), dim3(NTHREADS), LDS_BYTES, stream, a);
        }
    }
}
```

```cpp
#include <hip/hip_runtime.h>
#include <hip/hip_cooperative_groups.h>
#include <cstdio>
#include <cstdint>
namespace cg = cooperative_groups;

#ifndef PROBE_DUP
#define PROBE_DUP -1
#endif
#ifndef NHELP
#define NHELP 1
#define HELP2 1
#endif
#ifndef USE_CG_SYNC
#define USE_CG_SYNC 0
#endif
#ifndef GDN_NAIVE
#define GDN_NAIVE 0
#endif
#ifndef ATTN_NAIVE
#define ATTN_NAIVE 0
#endif
#ifndef MK_N_LAUNCHES
#define MK_N_LAUNCHES 1
#endif

constexpr int BATCH = 4, SEQ = 8192, DM = 1024, T = BATCH * SEQ, FF = 2816, MEMT = 256;
constexpr int NGU = 2 * FF;
constexpr int NINR = 3072;
constexpr int NIN = 3328;
constexpr int PP = NINR;
constexpr float EPS = 1e-6f;
constexpr int C_GQ = 0, C_GK = 512, C_GV = 1024, C_GZ = 1536, C_MQ = 2048, C_MK = 2304, C_MV = 2560, C_CQ = 2816;

constexpr size_t MiB = 1u << 20;
constexpr size_t WS_CTL = 0, CTL_BYTES = 1 * MiB;
constexpr size_t WS_WGU1 = 1 * MiB, WS_WD1 = 12 * MiB, WS_WIN = 18 * MiB, WS_WOUT = 25 * MiB, WS_WGU2 = 27 * MiB, WS_WD2 = 38 * MiB, WS_WKV = 44 * MiB;
constexpr size_t WS_SS = 45 * MiB;
constexpr size_t WS_RSTDM = 47 * MiB;
constexpr size_t WS_AB = 48 * MiB;
constexpr size_t WS_KMEAN = 49 * MiB;
constexpr size_t WS_KVMEM = 50 * MiB;
constexpr size_t WS_MEMB = 52 * MiB;
constexpr size_t WS_GB = 54 * MiB;
constexpr size_t WS_GG = 54 * MiB + 512 * 1024;
constexpr size_t WS_XB = 56 * MiB;
constexpr size_t WS_KNM = 56 * MiB;
constexpr size_t WS_C = 120 * MiB;
constexpr size_t WS_G = 312 * MiB;
constexpr size_t WS_GQ = 312 * MiB, WS_GK = 344 * MiB, WS_GV = 376 * MiB;
constexpr size_t WS_END = 494 * MiB;

constexpr int NWAVES = 8, NTHREADS = 512;
constexpr int LDS_BYTES = 163840;

typedef unsigned short bf16_t;
typedef short bf16x8 __attribute__((ext_vector_type(8)));
typedef float f32x4 __attribute__((ext_vector_type(4)));
typedef float f32x2 __attribute__((ext_vector_type(2)));
typedef unsigned u32x4 __attribute__((ext_vector_type(4)));
typedef unsigned u32x2 __attribute__((ext_vector_type(2)));
#define LAS __attribute__((address_space(3)))
typedef float f32x16 __attribute__((ext_vector_type(16)));
typedef __bf16 bf16x2_t __attribute__((ext_vector_type(2)));
__device__ __forceinline__ unsigned cvtpk(float lo, float hi) { f32x2 v = {lo, hi}; bf16x2_t b = __builtin_convertvector(v, bf16x2_t); return __builtin_bit_cast(unsigned, b); }

__device__ __forceinline__ unsigned f2bf(float f) { unsigned u = __builtin_bit_cast(unsigned, f); return (u + 0x7fffu + ((u >> 16) & 1u)) >> 16; }
__device__ __forceinline__ unsigned pk2(float lo, float hi) { return f2bf(lo) | (f2bf(hi) << 16); }
__device__ __forceinline__ float bf2f(unsigned short h) { return __builtin_bit_cast(float, (unsigned)h << 16); }
__device__ __forceinline__ float bflo(unsigned w) { return __builtin_bit_cast(float, w << 16); }
__device__ __forceinline__ float bfhi(unsigned w) { return __builtin_bit_cast(float, w & 0xffff0000u); }
__device__ __forceinline__ float wave_sum(float v) {
#pragma unroll
    for (int o = 1; o < 64; o <<= 1) v += __shfl_xor(v, o);
    return v;
}
__device__ __forceinline__ float wave_max(float v) {
#pragma unroll
    for (int o = 1; o < 64; o <<= 1) v = fmaxf(v, __shfl_xor(v, o));
    return v;
}

namespace pg8 {
constexpr int BM = 256, BK = 64, HALF = 128, HTB = HALF * BK * 2, STAGE_BYTES = 8 * HTB, NXCD = 8, WGM = 4;
__host__ __device__ __forceinline__ int lds_byte(int r, int c) { const int st = (r >> 4) * 2 + (c >> 5), rr = r & 15, cc = c & 31, ob = rr * 64 + cc * 2; return st * 1024 + (ob ^ (((ob >> 9) & 1) << 5)); }
__host__ __device__ __forceinline__ void stage_rc(int b, int& R, int& C) { const int st = b / 1024, sb = b % 1024, swz = sb ^ (((sb >> 9) & 1) << 5); R = (st >> 1) * 16 + swz / 64; C = (st & 1) * 32 + (swz % 64) / 2; }
__host__ __device__ __forceinline__ int perm32(int rho) { const int n = rho >> 4, i = rho & 15; return 8 * (i >> 2) + 4 * n + (i & 3); }

struct Unit { int pm, pn; };
struct Gemm { const bf16_t* A; const bf16_t* Bt; int M, N, K, lda; };

struct StaticOrder {
    int nM, nN, nwg, G, c;
    __device__ void init(int M, int N, int G_, int c_) { nM = M / BM; nN = N / BM; nwg = nM * nN; G = G_; c = c_; }
    __device__ bool next(int i, Unit& u) const {
        const long L = (long)i * G + c; if (c < 0 || L >= nwg) return false;
        int wgid = (int)L; { const int q = nwg / NXCD, r = nwg % NXCD, xcd = wgid % NXCD, off = wgid / NXCD; wgid = (xcd < r ? xcd * (q + 1) : r * (q + 1) + (xcd - r) * q) + off; }
        const int nig = WGM * nN, gid = wgid / nig, fm = gid * WGM, gsz = (nM - fm) < WGM ? (nM - fm) : WGM;
        u.pm = fm + ((wgid % nig) % gsz); u.pn = (wgid % nig) / gsz; return true;
    }
};

__device__ __forceinline__ void rstd_table(LAS unsigned char* lds, const float* ss, const StaticOrder& S);
template <class Epi, bool ALIGN_EPI>
__device__ __forceinline__ void gemm_phase(LAS unsigned char* lds, const Gemm g, const StaticOrder& S, const Epi& E, const float* tab_ss = nullptr) {
    int tid = threadIdx.x; asm volatile("" : "+v"(tid));
    const int wid = __builtin_amdgcn_readfirstlane(tid >> 6), lane = tid & 63, wr = wid >> 2, wc = wid & 3, fr = lane & 15, fq = lane >> 4;
    const int K = g.K, nt = K / BK, lda = g.lda;
    unsigned voffA[2], voffB[2];
#pragma unroll
    for (int i = 0; i < 2; ++i) { int R, C; stage_rc(tid * 16 + i * 8192, R, C); const int Rb = (int)Epi::PERM == 2 ? (((R >> 5) << 6) + perm32(R & 31)) : (Epi::PERM ? ((R & ~31) + perm32(R & 31)) : R);
        voffA[i] = (unsigned)(R * lda + C) * 2u; voffB[i] = (unsigned)(Rb * K + C) * 2u; }
    const size_t kstep = (size_t)(BK * 2);
    const size_t hstepA = (size_t)HALF * lda * 2, hstepB = (size_t)((int)Epi::PERM == 2 ? 32 : HALF) * K * 2;
    const size_t tstepA = 2 * hstepA, tstepB = (size_t)BM * K * 2;
    const unsigned ldsw = (unsigned)wid * 1024u;
    const int aoff = lds_byte(wr * 64 + fr, fq * 8), boff = lds_byte(wc * 32 + fr, fq * 8);
#define PG8_SA(b, h) (((b) * 2 + (h)) * HTB)
#define PG8_SB(b, h) ((4 + (b) * 2 + (h)) * HTB)
#define PG8_STAGE(bufoff, gbase, voff) do { _Pragma("unroll") for (int _i = 0; _i < 2; ++_i) \
        __builtin_amdgcn_global_load_lds((const unsigned*)((const char*)(gbase) + (voff)[_i]), (LAS unsigned*)(lds + (bufoff) + ldsw + _i * 8192), 16, 0, 0); } while (0)
#define PG8_LDA(dst, b, h) do { _Pragma("unroll") for (int m = 0; m < 4; ++m) _Pragma("unroll") for (int k = 0; k < 2; ++k) dst[m][k] = *(const LAS bf16x8*)(lds + PG8_SA(b, h) + aoff + m * 2048 + k * 1024); } while (0)
#define PG8_LDB(dst, b, h) do { _Pragma("unroll") for (int n = 0; n < 2; ++n) _Pragma("unroll") for (int k = 0; k < 2; ++k) dst[n][k] = *(const LAS bf16x8*)(lds + PG8_SB(b, h) + boff + n * 2048 + k * 1024); } while (0)
#define PG8_MMA(ai, bj, At, Bt) do { __builtin_amdgcn_s_setprio(1); _Pragma("unroll") for (int m = 0; m < 4; ++m) _Pragma("unroll") for (int n = 0; n < 2; ++n) _Pragma("unroll") for (int k = 0; k < 2; ++k) \
        acc[ai][bj][m][n] = __builtin_amdgcn_mfma_f32_16x16x32_bf16(Bt[n][k], At[m][k], acc[ai][bj][m][n], 0, 0, 0); __builtin_amdgcn_s_setprio(0); } while (0)
#define PG8_WAIT_V(n) asm volatile("s_waitcnt vmcnt(" #n ")" ::: "memory")
#define PG8_WAIT_L(n) asm volatile("s_waitcnt lgkmcnt(" #n ")" ::: "memory")
#define PG8_BAR __builtin_amdgcn_s_barrier()
#define PG8_SCHED __builtin_amdgcn_sched_barrier(0)
    Unit cur, nxt; int ui = 0;
    if (!S.next(0, cur)) return;
    f32x4 acc[2][2][4][2];
#pragma unroll
    for (int a = 0; a < 2; ++a)
#pragma unroll
        for (int b = 0; b < 2; ++b)
#pragma unroll
            for (int m = 0; m < 4; ++m)
#pragma unroll
                for (int n = 0; n < 2; ++n) acc[a][b][m][n] = (f32x4){0.f, 0.f, 0.f, 0.f};
    bf16x8 At[4][2], B0[2][2], B1[2][2];
    const char* cA = (const char*)g.A + (size_t)cur.pm * tstepA; const char* cB = (const char*)g.Bt + (size_t)cur.pn * tstepB;
    PG8_STAGE(PG8_SB(0, 0), cB, voffB); PG8_STAGE(PG8_SB(0, 1), cB + hstepB, voffB); PG8_STAGE(PG8_SA(0, 0), cA, voffA); PG8_STAGE(PG8_SA(0, 1), cA + hstepA, voffA);
    if (tab_ss) rstd_table(lds, tab_ss, S);
    if (wr == 1) PG8_BAR;
    PG8_WAIT_V(2); PG8_BAR;
    PG8_STAGE(PG8_SB(1, 0), cB + kstep, voffB); PG8_STAGE(PG8_SA(1, 0), cA + kstep, voffA); PG8_STAGE(PG8_SB(1, 1), cB + hstepB + kstep, voffB);
    PG8_WAIT_V(6); PG8_BAR;
    for (;;) {
        const bool has_next = S.next(ui + 1, nxt);
        const char* nA = has_next ? (const char*)g.A + (size_t)nxt.pm * tstepA : cA; const char* nB = has_next ? (const char*)g.Bt + (size_t)nxt.pn * tstepB : cB;
        for (int t = 0; t < nt; t += 2) {
            const bool last = (t == nt - 2);
            const char* a1 = cA + (size_t)(t + 1) * kstep;
            const char* a2 = last ? nA : cA + (size_t)(t + 2) * kstep; const char* b2 = last ? nB : cB + (size_t)(t + 2) * kstep;
            const char* a3 = a2 + kstep; const char* b3 = b2 + kstep;
            PG8_LDB(B0, 0, 0); PG8_LDB(B1, 0, 1); PG8_SCHED; PG8_LDA(At, 0, 0); PG8_STAGE(PG8_SA(1, 1), a1 + hstepA, voffA);
            PG8_WAIT_V(8); PG8_WAIT_L(0); PG8_BAR; PG8_MMA(0, 0, At, B0); PG8_MMA(0, 1, At, B1); PG8_BAR; PG8_SCHED;
            PG8_LDA(At, 0, 1); PG8_STAGE(PG8_SB(0, 0), b2, voffB); PG8_STAGE(PG8_SB(0, 1), b2 + hstepB, voffB); PG8_STAGE(PG8_SA(0, 0), a2, voffA);
            PG8_WAIT_V(8); PG8_WAIT_L(0); PG8_BAR; PG8_MMA(1, 0, At, B0); PG8_MMA(1, 1, At, B1); PG8_BAR; PG8_SCHED;
            PG8_LDB(B0, 1, 0); PG8_LDB(B1, 1, 1); PG8_SCHED; PG8_LDA(At, 1, 0); PG8_STAGE(PG8_SA(0, 1), a2 + hstepA, voffA);
            PG8_WAIT_V(8); PG8_WAIT_L(0); PG8_BAR; PG8_MMA(0, 0, At, B0); PG8_MMA(0, 1, At, B1); PG8_BAR; PG8_SCHED;
            PG8_LDA(At, 1, 1); PG8_STAGE(PG8_SB(1, 0), b3, voffB); PG8_STAGE(PG8_SB(1, 1), b3 + hstepB, voffB); PG8_STAGE(PG8_SA(1, 0), a3, voffA);
            PG8_WAIT_V(8); PG8_WAIT_L(0); PG8_BAR; PG8_MMA(1, 0, At, B0); PG8_MMA(1, 1, At, B1); PG8_BAR; PG8_SCHED;
        }
        if constexpr (ALIGN_EPI) { if (wr == 0) PG8_BAR; }
        E(acc, cur, wr, wc, fr, fq, ui, lds);
        if (!has_next) break;
#pragma unroll
        for (int a = 0; a < 2; ++a)
#pragma unroll
            for (int b = 0; b < 2; ++b)
#pragma unroll
                for (int m = 0; m < 4; ++m)
#pragma unroll
                    for (int n = 0; n < 2; ++n) acc[a][b][m][n] = (f32x4){0.f, 0.f, 0.f, 0.f};
        cur = nxt; cA = nA; cB = nB; ++ui;
        if constexpr (ALIGN_EPI) { if (wr == 1) PG8_BAR; }
    }
    PG8_WAIT_V(0);
    if constexpr (!ALIGN_EPI) { if (wr == 0) PG8_BAR; }
    PG8_BAR;
#undef PG8_SA
#undef PG8_SB
#undef PG8_STAGE
#undef PG8_LDA
#undef PG8_LDB
#undef PG8_MMA
#undef PG8_WAIT_V
#undef PG8_WAIT_L
#undef PG8_BAR
#undef PG8_SCHED
}

__device__ __forceinline__ float row_rstd(const float* ss, int row) {
    const f32x4* p = (const f32x4*)(ss + (size_t)row * 16);
    const f32x4 a = p[0], b = p[1], c = p[2], d = p[3];
    const float s = ((a[0] + a[1]) + (a[2] + a[3])) + ((b[0] + b[1]) + (b[2] + b[3])) + ((c[0] + c[1]) + (c[2] + c[3])) + ((d[0] + d[1]) + (d[2] + d[3]));
    return __builtin_amdgcn_rsqf(s * (1.0f / DM) + EPS);
}
constexpr int RSTD_TAB_OFF = 131072;
__device__ __forceinline__ void rows_rstd8(LAS unsigned char* lds, int ui, int rl0  , float (&rs)[2][4]) {
    const LAS float* tab = (const LAS float*)(lds + RSTD_TAB_OFF) + ui * 256 + rl0;
#pragma unroll
    for (int ai = 0; ai < 2; ++ai)
#pragma unroll
        for (int m = 0; m < 4; ++m) rs[ai][m] = tab[ai * HALF + m * 16];
}
__device__ __forceinline__ float silu_mul(float g, float u) { return g * __builtin_amdgcn_rcpf(1.0f + __expf(-g)) * u; }

struct EpiSwiGLU {
    static constexpr bool PERM = true;
    bf16_t* H; const float* ss;
    __device__ __forceinline__ void operator()(const f32x4 (&acc)[2][2][4][2], const Unit& u, int wr, int wc, int fr, int fq, int ui, LAS unsigned char* lds) const {
        float rs8[2][4]; rows_rstd8(lds, ui, wr * 64 + fr, rs8);
#pragma unroll
        for (int ai = 0; ai < 2; ++ai)
#pragma unroll
            for (int m = 0; m < 4; ++m) {
                const int row = u.pm * BM + ai * HALF + wr * 64 + m * 16 + fr;
                const float rs = rs8[ai][m];
                u32x4 w;
                { const f32x4 g = acc[ai][0][m][0] * rs, up = acc[ai][1][m][0] * rs; w.x = cvtpk(silu_mul(g[0], up[0]), silu_mul(g[1], up[1])); w.y = cvtpk(silu_mul(g[2], up[2]), silu_mul(g[3], up[3])); }
                { const f32x4 g = acc[ai][0][m][1] * rs, up = acc[ai][1][m][1] * rs; w.z = cvtpk(silu_mul(g[0], up[0]), silu_mul(g[1], up[1])); w.w = cvtpk(silu_mul(g[2], up[2]), silu_mul(g[3], up[3])); }
                *(u32x4*)(H + (size_t)row * FF + u.pn * 128 + wc * 32 + 8 * fq) = w;
            }
    }
};
template <int MODE> struct EpiResid {
    static constexpr int PERM = 2;
    const float* xin; float* out; bf16_t* xb; float* ss; float scale;
    __device__ __forceinline__ void operator()(const f32x4 (&acc)[2][2][4][2], const Unit& u, int wr, int wc, int fr, int fq, int ui, LAS unsigned char* lds) const {
        const size_t base = (size_t)(u.pm * BM + wr * 64 + fr) * DM + u.pn * BM + wc * 64 + 8 * fq;
        u32x4 rb[2][4][2];
#pragma unroll
        for (int ai = 0; ai < 2; ++ai)
#pragma unroll
            for (int m = 0; m < 4; ++m)
#pragma unroll
                for (int bj = 0; bj < 2; ++bj) rb[ai][m][bj] = *(const u32x4*)(xb + base + (size_t)(ai * HALF + m * 16) * DM + bj * 32);
#pragma unroll
        for (int ai = 0; ai < 2; ++ai)
#pragma unroll
            for (int m = 0; m < 4; ++m) {
                const size_t off = base + (size_t)(ai * HALF + m * 16) * DM;
                float s = 0.f;
#pragma unroll
                for (int bj = 0; bj < 2; ++bj) {
                    const u32x4 w = rb[ai][m][bj];
                    const f32x4 v0 = (f32x4){bflo(w.x), bfhi(w.x), bflo(w.y), bfhi(w.y)} + acc[ai][bj][m][0] * scale;
                    const f32x4 v1 = (f32x4){bflo(w.z), bfhi(w.z), bflo(w.w), bfhi(w.w)} + acc[ai][bj][m][1] * scale;
                    if (MODE == 2) { *(f32x4*)(out + off + bj * 32) = v0; *(f32x4*)(out + off + bj * 32 + 4) = v1; }
                    else { u32x4 o; o.x = cvtpk(v0[0], v0[1]); o.y = cvtpk(v0[2], v0[3]); o.z = cvtpk(v1[0], v1[1]); o.w = cvtpk(v1[2], v1[3]);
                        *(u32x4*)(xb + off + bj * 32) = o;
                        const float r0 = bflo(o.x), r1 = bfhi(o.x), r2 = bflo(o.y), r3 = bfhi(o.y), r4 = bflo(o.z), r5 = bfhi(o.z), r6 = bflo(o.w), r7 = bfhi(o.w);
                        s += ((r0 * r0 + r1 * r1) + (r2 * r2 + r3 * r3)) + ((r4 * r4 + r5 * r5) + (r6 * r6 + r7 * r7)); }
                }
                if (MODE != 2) { s += __shfl_xor(s, 16); s += __shfl_xor(s, 32); if (fq == 0) ss[(size_t)(u.pm * BM + ai * HALF + wr * 64 + m * 16 + fr) * 16 + u.pn * 4 + wc] = s; }
            }
    }
};
struct EpiWin {
    static constexpr int PERM = 2;
    bf16_t* P; float* AB; const float* ss;
    __device__ __forceinline__ void operator()(const f32x4 (&acc)[2][2][4][2], const Unit& u, int wr, int wc, int fr, int fq, int ui, LAS unsigned char* lds) const {
        float rs8[2][4]; rows_rstd8(lds, ui, wr * 64 + fr, rs8);
#pragma unroll
        for (int ai = 0; ai < 2; ++ai)
#pragma unroll
            for (int m = 0; m < 4; ++m) {
                const int row = u.pm * BM + ai * HALF + wr * 64 + m * 16 + fr;
                const float rs = rs8[ai][m];
                if (u.pn < 12) {
                    const bool gatecol = (u.pn == C_GZ / BM) || (u.pn == C_GZ / BM + 1);
#pragma unroll
                    for (int bj = 0; bj < 2; ++bj) {
                        f32x4 v0 = acc[ai][bj][m][0] * rs, v1 = acc[ai][bj][m][1] * rs;
                        if (gatecol) {
#pragma unroll
                            for (int i = 0; i < 4; ++i) { v0[i] = v0[i] * __builtin_amdgcn_rcpf(1.0f + __expf(-v0[i])); v1[i] = v1[i] * __builtin_amdgcn_rcpf(1.0f + __expf(-v1[i])); }
                        }
                        u32x4 w; w.x = cvtpk(v0[0], v0[1]); w.y = cvtpk(v0[2], v0[3]); w.z = cvtpk(v1[0], v1[1]); w.w = cvtpk(v1[2], v1[3]);
                        *(u32x4*)(P + (size_t)row * PP + u.pn * BM + wc * 64 + bj * 32 + 8 * fq) = w;
                    }
                } else if (wc == 0 && fq == 0) {
                    *(f32x4*)(AB + (size_t)row * 8) = acc[ai][0][m][0] * rs;
                    *(f32x4*)(AB + (size_t)row * 8 + 4) = acc[ai][0][m][1] * rs;
                }
            }
    }
};
struct EpiNullP { static constexpr bool PERM = true; float* sink;
    __device__ __forceinline__ void operator()(const f32x4 (&acc)[2][2][4][2], const Unit& u, int wr, int wc, int fr, int fq, int ui, LAS unsigned char* lds) const {
        float s = 0.f;
#pragma unroll
        for (int ai = 0; ai < 2; ++ai)
#pragma unroll
            for (int bj = 0; bj < 2; ++bj)
#pragma unroll
                for (int m = 0; m < 4; ++m)
#pragma unroll
                    for (int n = 0; n < 2; ++n) s += acc[ai][bj][m][n][0];
        if (s == 123456.789f) sink[0] = s;
    } };
struct EpiNullN { static constexpr bool PERM = false; float* sink;
    __device__ __forceinline__ void operator()(const f32x4 (&acc)[2][2][4][2], const Unit& u, int wr, int wc, int fr, int fq, int ui, LAS unsigned char* lds) const {
        float s = 0.f;
#pragma unroll
        for (int ai = 0; ai < 2; ++ai)
#pragma unroll
            for (int bj = 0; bj < 2; ++bj)
#pragma unroll
                for (int m = 0; m < 4; ++m)
#pragma unroll
                    for (int n = 0; n < 2; ++n) s += acc[ai][bj][m][n][0];
        if (s == 123456.789f) sink[0] = s;
    } };
struct EpiKV {
    static constexpr bool PERM = false;
    float* O; const float* rstdm;
    __device__ __forceinline__ void operator()(const f32x4 (&acc)[2][2][4][2], const Unit& u, int wr, int wc, int fr, int fq, int ui, LAS unsigned char* lds) const {
#pragma unroll
        for (int ai = 0; ai < 2; ++ai)
#pragma unroll
            for (int m = 0; m < 4; ++m) {
                const int row = u.pm * BM + ai * HALF + wr * 64 + m * 16 + fr;
                const float rs = rstdm[row];
                const size_t off = (size_t)row * 512 + u.pn * BM + wc * 32 + 4 * fq;
#pragma unroll
                for (int bj = 0; bj < 2; ++bj)
#pragma unroll
                    for (int n = 0; n < 2; ++n) *(f32x4*)(O + off + bj * HALF + n * 16) = acc[ai][bj][m][n] * rs;
            }
    }
};
__device__ __forceinline__ void rstd_table(LAS unsigned char* lds, const float* ss, const StaticOrder& S) {
    LAS float* tab = (LAS float*)(lds + RSTD_TAB_OFF);
    const int tid = threadIdx.x, half = tid >> 8, rl = tid & 255;
    for (int i = half; i < 12; i += 2) { Unit u; if (!S.next(i, u)) break; tab[i * 256 + rl] = row_rstd(ss, u.pm * BM + rl); }
    __syncthreads();
}
}


#define XB_TMO      128
#define XB_XCNT(j)  (256  + 64 * (j))
#define XB_XSUB(j)  (1280 + 64 * (j))
#define XB_XGEN(j)  (2304 + 64 * (j))
#define XB_TOP      3328
#define XB_TOPGEN   3392
#define XCD_BAR_WORDS 3456
#define XB_SPIN_CAP (1u << 18)
constexpr int CW_BAR = 1024;
constexpr int LDS_ST_OFF = 147440;
__device__ __forceinline__ unsigned xb_ld(unsigned* p)              { return __hip_atomic_load(p, __ATOMIC_RELAXED, __HIP_MEMORY_SCOPE_AGENT); }
__device__ __forceinline__ unsigned xb_add(unsigned* p, unsigned v) { return __hip_atomic_fetch_add(p, v, __ATOMIC_RELAXED, __HIP_MEMORY_SCOPE_AGENT); }
__device__ __forceinline__ unsigned xb_xcc_id() { return (unsigned)__builtin_amdgcn_s_getreg((3 << 11) | 20) & 0xFu; }
#define XB_SPIN(cond, bar) do { unsigned _sp = 0; while (cond) { __builtin_amdgcn_s_sleep(1); \
    if ((++_sp & 255u) == 0u) { if (xb_ld(&(bar)[XB_TMO])) break; if (_sp > XB_SPIN_CAP) { atomicAdd(&(bar)[XB_TMO], 1u); break; } } } } while (0)
struct XcdBarrier { unsigned* bar; unsigned x; volatile LAS unsigned* st; };
__device__ __forceinline__ XcdBarrier xcd_barrier_post(unsigned* bar, volatile LAS unsigned* st) {
    XcdBarrier b; b.bar = bar; b.x = xb_xcc_id(); b.st = st;
    if (threadIdx.x == 0) (void)xb_add(&bar[XB_XCNT(b.x)], 1u);
    return b;
}
__device__ __forceinline__ void xcd_barrier_complete(unsigned* bar, unsigned x, unsigned& nloc, unsigned& nx) {
    const unsigned G = gridDim.x * gridDim.y * gridDim.z;
    unsigned sum, cnt, mine, sp = 0u;
    for (;;) {
        sum = 0u; cnt = 0u; mine = 0u;
#pragma unroll
        for (unsigned j = 0; j < 16; ++j) { const unsigned c = xb_ld(&bar[XB_XCNT(j)]); sum += c; cnt += (c > 0u) ? 1u : 0u; mine = (j == x) ? c : mine; }
        if (sum == G) break;
        __builtin_amdgcn_s_sleep(1);
        if ((++sp & 255u) == 0u) { if (xb_ld(&bar[XB_TMO])) break; if (sp > XB_SPIN_CAP) { atomicAdd(&bar[XB_TMO], 1u); break; } }
    }
    nloc = mine > 0u ? mine : 1u; nx = cnt > 0u ? cnt : 1u;
}
__device__ __forceinline__ void xcd_barrier(const XcdBarrier& b) {
    asm volatile("s_waitcnt vmcnt(0)" ::: "memory");
    __syncthreads();
    if (threadIdx.x == 0) {
        unsigned* bar = b.bar;
        __builtin_amdgcn_s_waitcnt(0);
        unsigned nloc = b.st[0], nx = b.st[1];
        if (nloc == 0u) { xcd_barrier_complete(bar, b.x, nloc, nx); b.st[0] = nloc; b.st[1] = nx; }
        const unsigned old = xb_add(&bar[XB_XSUB(b.x)], 1u);
        const unsigned gen = old / nloc;
        if (old + 1u == (gen + 1u) * nloc) {
            __builtin_amdgcn_fence(__ATOMIC_RELEASE, "agent");
            asm volatile("s_waitcnt vmcnt(0)" ::: "memory");
            const unsigned og = xb_add(&bar[XB_TOP], 1u);
            const unsigned tg = og / nx;
            if (og + 1u == (tg + 1u) * nx) xb_add(&bar[XB_TOPGEN], 1u);
            else XB_SPIN(xb_ld(&bar[XB_TOPGEN]) == tg, bar);
            __builtin_amdgcn_fence(__ATOMIC_ACQUIRE, "agent");
            xb_add(&bar[XB_XGEN(b.x)], 1u);
            asm volatile("s_waitcnt vmcnt(0)" ::: "memory");
        } else {
            asm volatile("buffer_inv sc1" ::: "memory");
            XB_SPIN(xb_ld(&bar[XB_XGEN(b.x)]) == gen, bar);
            asm volatile("s_waitcnt vmcnt(0)" ::: "memory");
        }
    }
    __syncthreads();
}

struct Args;
struct Frame {
    LAS unsigned char* lds;
    int tid, lane, wave, vcu, G;
    float* out; unsigned char* ws;
};
struct Args { const float* in[23]; float* out; unsigned char* ws; int ph_lo, ph_hi; };

template <class SrcCol>
__device__ __forceinline__ void tr_item(const float* W, int ldw, int k0, int d0, SrcCol src, const float* gain, bf16_t* WT, int Kdim, LAS float* scr, int lane) {
    const int dl = lane & 31, sc = src(d0 + dl);
#pragma unroll 8
    for (int i = 0; i < 32; ++i) { const int kk = 2 * i + (lane >> 5);
        float v = 0.f; if (sc >= 0) { v = W[(size_t)(k0 + kk) * ldw + sc]; if (gain) v *= gain[k0 + kk]; }
        scr[kk * 33 + dl] = v; }
    asm volatile("s_waitcnt lgkmcnt(0)" ::: "memory");
    const int c = lane & 7;
#pragma unroll
    for (int j = 0; j < 4; ++j) { const int n = (lane >> 3) + 8 * j; const LAS float* s = scr + (8 * c) * 33 + n;
        u32x4 o; o.x = pk2(s[0 * 33], s[1 * 33]); o.y = pk2(s[2 * 33], s[3 * 33]); o.z = pk2(s[4 * 33], s[5 * 33]); o.w = pk2(s[6 * 33], s[7 * 33]);
        *(u32x4*)(WT + (size_t)(d0 + n) * Kdim + k0 + 8 * c) = o; }
    asm volatile("s_waitcnt lgkmcnt(0)" ::: "memory");
}
__device__ __forceinline__ void tr_item64(const float* W, int ldw, int k0, int d0, int sc0, const float* gain, bf16_t* WT, int Kdim, LAS float* scr, int lane) {
    const int n4 = (lane & 15) * 4;
#pragma unroll 8
    for (int i = 0; i < 16; ++i) { const int kk = 4 * i + (lane >> 4);
        f32x4 v = *(const f32x4*)(W + (size_t)(k0 + kk) * ldw + sc0 + n4); if (gain) v = v * gain[k0 + kk];
        scr[kk * 65 + n4] = v[0]; scr[kk * 65 + n4 + 1] = v[1]; scr[kk * 65 + n4 + 2] = v[2]; scr[kk * 65 + n4 + 3] = v[3]; }
    asm volatile("s_waitcnt lgkmcnt(0)" ::: "memory");
    const int c = lane & 7;
#pragma unroll
    for (int j = 0; j < 8; ++j) { const int n = (lane >> 3) + 8 * j; const LAS float* sp = scr + (8 * c) * 65 + n;
        u32x4 o; o.x = cvtpk(sp[0 * 65], sp[1 * 65]); o.y = cvtpk(sp[2 * 65], sp[3 * 65]); o.z = cvtpk(sp[4 * 65], sp[5 * 65]); o.w = cvtpk(sp[6 * 65], sp[7 * 65]);
        *(u32x4*)(WT + (size_t)(d0 + n) * Kdim + k0 + 8 * c) = o; }
    asm volatile("s_waitcnt lgkmcnt(0)" ::: "memory");
}
struct SrcGU { int up; __device__ int operator()(int d) const { const int pn = d >> 8, r = d & 255; return ((r >> 7) == up) ? pn * 128 + (r & 127) : -2; } };
struct SrcId { __device__ int operator()(int d) const { return d; } };
struct SrcWin { __device__ int operator()(int d) const { if (d < 2048) return d; if (d < 3072) return d + 8; if (d < 3080) return d - 3072 + 2048; return -1; } };

__device__ __forceinline__ float row_to_bf16(const float* xrow, bf16_t* orow, int lane) {
    const f32x4* xr = (const f32x4*)xrow + lane; f32x4 v[4]; float s = 0.f;
#pragma unroll
    for (int j = 0; j < 4; ++j) { v[j] = xr[64 * j]; s += (v[j][0] * v[j][0] + v[j][1] * v[j][1]) + (v[j][2] * v[j][2] + v[j][3] * v[j][3]); }
    u32x2* o8 = (u32x2*)orow + lane;
#pragma unroll
    for (int j = 0; j < 4; ++j) { u32x2 w; w.x = pk2(v[j][0], v[j][1]); w.y = pk2(v[j][2], v[j][3]); o8[64 * j] = w; }
    return wave_sum(s);
}

template <int PART>
__device__ __forceinline__ void tr_weights(Frame& F, const Args& A, int gw, int NGW) {
    LAS float* scr = (LAS float*)(F.lds + F.wave * 16640);
    const int lane = F.lane;
    unsigned char* ws = F.ws;
    constexpr int I_GU = (DM / 64) * (NGU / 64);
    constexpr int I_D = (FF / 64) * (DM / 64);
    constexpr int I_IN = (DM / 64) * (NINR / 64);
    constexpr int I_AB = (DM / 64) * 8;
    constexpr int I_O = (DM / 64) * (DM / 64);
    constexpr int I_KV = (DM / 64) * (512 / 64);
    constexpr int NITEMS = PART ? (I_GU + I_D + I_O) : (I_GU + I_D + I_IN + I_AB + I_KV);
    constexpr int l = PART;
    for (int it = gw; it < NITEMS; it += NGW) {
        int r = it;
        if (r < I_GU) { const int kb = r / (NGU / 64), db = r % (NGU / 64); const int d0 = db * 64; const int up = (d0 >> 7) & 1;
            const float* W = A.in[(l ? 20 : 3) + up]; const float* gain = A.in[l ? 19 : 2];
            tr_item64(W, FF, kb * 64, d0, (d0 >> 8) * 128 + (d0 & 127), gain, (bf16_t*)(ws + (l ? WS_WGU2 : WS_WGU1)), DM, scr, lane); continue; }
        r -= I_GU;
        if (r < I_D) { const int kb = r / (DM / 64), db = r % (DM / 64);
            tr_item64(A.in[l ? 22 : 5], DM, kb * 64, db * 64, db * 64, nullptr, (bf16_t*)(ws + (l ? WS_WD2 : WS_WD1)), FF, scr, lane); continue; }
        r -= I_D;
        if (PART) { const int kb = r / (DM / 64), db = r % (DM / 64);
            tr_item64(A.in[18], DM, kb * 64, db * 64, db * 64, nullptr, (bf16_t*)(ws + WS_WOUT), DM, scr, lane); continue; }
        if (r < I_IN) { const int kb = r / (NINR / 64), db = r % (NINR / 64); const int d0 = db * 64;
            tr_item64(A.in[7], 3080, kb * 64, d0, d0 < 2048 ? d0 : d0 + 8, A.in[6], (bf16_t*)(ws + WS_WIN), DM, scr, lane); continue; }
        r -= I_IN;
        if (r < I_AB) { const int kb = r / 8, db = r % 8;
            tr_item(A.in[7], 3080, kb * 64, NINR + db * 32, SrcWin{}, A.in[6], (bf16_t*)(ws + WS_WIN), DM, scr, lane); continue; }
        r -= I_AB;
        { const int kb = r / 8, db = r % 8;
            tr_item64(A.in[15], 512, kb * 64, db * 64, db * 64, A.in[14], (bf16_t*)(ws + WS_WKV), DM, scr, lane); }
    }
}

__device__ __forceinline__ void p0_prologue(Frame& F, const Args& A) {
    const int gw = F.vcu * NWAVES + F.wave, NGW = F.G * NWAVES, lane = F.lane;
    unsigned char* ws = F.ws;
    tr_weights<0>(F, A, gw, NGW);
    float* ss = (float*)(ws + WS_SS);
    for (int m = gw; m < T; m += NGW) {
        const float s = row_to_bf16(A.in[0] + (size_t)m * DM, (bf16_t*)(ws + WS_XB) + (size_t)m * DM, lane);
        if (lane < 16) ss[(size_t)m * 16 + lane] = (lane == 0) ? s : 0.f;
    }
    for (int m = gw; m < BATCH * MEMT; m += NGW) {
        const float s = row_to_bf16(A.in[1] + (size_t)m * DM, (bf16_t*)(ws + WS_MEMB) + (size_t)m * DM, lane);
        if (lane == 0) ((float*)(ws + WS_RSTDM))[m] = __builtin_amdgcn_rsqf(s * (1.0f / DM) + EPS);
    }
}

__device__ __forceinline__ void p4a_naive(Frame& F, const Args& A) {
    const int gw = F.vcu * NWAVES + F.wave, NGW = F.G * NWAVES, lane = F.lane;
    unsigned char* ws = F.ws;
    const bf16_t* P = (const bf16_t*)(ws + WS_C);
    const float* convw = A.in[8];
    const int h = lane >> 4;
#if GDN_NAIVE
    float cw[3][4][8];
#pragma unroll
    for (int s = 0; s < 3; ++s)
#pragma unroll
        for (int j = 0; j < 4; ++j)
#pragma unroll
            for (int i = 0; i < 8; ++i) cw[s][j][i] = convw[j * 1536 + s * 512 + lane * 8 + i];
    const float alog = A.in[9][h], dtb = A.in[10][h];
    const float* AB = (const float*)(ws + WS_AB);
    for (int t = gw; t < T; t += NGW) {
        const int tl = t & (SEQ - 1);
        float y[3][8];
#pragma unroll
        for (int s = 0; s < 3; ++s) {
#pragma unroll
            for (int i = 0; i < 8; ++i) y[s][i] = 0.f;
#pragma unroll
            for (int j = 0; j < 4; ++j) { const int tt = tl - 3 + j;
                if (tt >= 0) { const u32x4 w = *(const u32x4*)(P + (size_t)(t - 3 + j) * PP + s * 512 + lane * 8);
                    y[s][0] += cw[s][j][0] * bflo(w.x); y[s][1] += cw[s][j][1] * bfhi(w.x); y[s][2] += cw[s][j][2] * bflo(w.y); y[s][3] += cw[s][j][3] * bfhi(w.y);
                    y[s][4] += cw[s][j][4] * bflo(w.z); y[s][5] += cw[s][j][5] * bfhi(w.z); y[s][6] += cw[s][j][6] * bflo(w.w); y[s][7] += cw[s][j][7] * bfhi(w.w); } }
#pragma unroll
            for (int i = 0; i < 8; ++i) { const float v = y[s][i]; y[s][i] = v * __builtin_amdgcn_rcpf(1.0f + __expf(-v)); }
        }
        float sq = 0.f, sk = 0.f;
#pragma unroll
        for (int i = 0; i < 8; ++i) { sq += y[0][i] * y[0][i]; sk += y[1][i] * y[1][i]; }
#pragma unroll
        for (int o = 1; o < 16; o <<= 1) { sq += __shfl_xor(sq, o); sk += __shfl_xor(sk, o); }
        const float rq = __builtin_amdgcn_rsqf(sq + EPS) * 0.08838834764831845f, rk = __builtin_amdgcn_rsqf(sk + EPS);
        u32x4 wq, wk, wv;
        wq.x = pk2(y[0][0] * rq, y[0][1] * rq); wq.y = pk2(y[0][2] * rq, y[0][3] * rq); wq.z = pk2(y[0][4] * rq, y[0][5] * rq); wq.w = pk2(y[0][6] * rq, y[0][7] * rq);
        wk.x = pk2(y[1][0] * rk, y[1][1] * rk); wk.y = pk2(y[1][2] * rk, y[1][3] * rk); wk.z = pk2(y[1][4] * rk, y[1][5] * rk); wk.w = pk2(y[1][6] * rk, y[1][7] * rk);
        wv.x = pk2(y[2][0], y[2][1]); wv.y = pk2(y[2][2], y[2][3]); wv.z = pk2(y[2][4], y[2][5]); wv.w = pk2(y[2][6], y[2][7]);
        *(u32x4*)((bf16_t*)(ws + WS_GQ) + (size_t)t * 512 + lane * 8) = wq;
        *(u32x4*)((bf16_t*)(ws + WS_GK) + (size_t)t * 512 + lane * 8) = wk;
        *(u32x4*)((bf16_t*)(ws + WS_GV) + (size_t)t * 512 + lane * 8) = wv;
        if ((lane & 15) == 0) {
            const float a = AB[(size_t)t * 8 + h], b = AB[(size_t)t * 8 + 4 + h];
            const float xx = a + dtb; const float sp = (xx > 20.f) ? xx : log1pf(__expf(xx));
            ((float*)(ws + WS_GG))[(size_t)t * 4 + h] = -__expf(alog) * sp;
            ((float*)(ws + WS_GB))[(size_t)t * 4 + h] = 1.0f / (1.0f + __expf(-b));
        }
    }
#endif
    {
        const float* kg = A.in[13]; const int d0 = (lane & 15) * 4;
        const float g0 = kg[d0], g1 = kg[d0 + 1], g2 = kg[d0 + 2], g3 = kg[d0 + 3];
        bf16_t* KNM = (bf16_t*)(ws + WS_KNM);
        for (int t = gw; t < T; t += NGW) {
            const int b = t >> 13, tl = t & (SEQ - 1);
            const u32x2 w = *(const u32x2*)(P + (size_t)t * PP + C_MK + lane * 4);
            float v0 = bflo(w.x), v1 = bfhi(w.x), v2 = bflo(w.y), v3 = bfhi(w.y);
            float s = v0 * v0 + v1 * v1 + v2 * v2 + v3 * v3;
#pragma unroll
            for (int o = 1; o < 16; o <<= 1) s += __shfl_xor(s, o);
            const float r = __builtin_amdgcn_rsqf(s * (1.0f / 64) + EPS);
            u32x2 o; o.x = pk2(v0 * r * g0, v1 * r * g1); o.y = pk2(v2 * r * g2, v3 * r * g3);
            *(u32x2*)(KNM + ((size_t)(b * 4 + h) * SEQ + tl) * 64 + d0) = o;
        }
        float* KM = (float*)(ws + WS_KMEAN);
        for (int it = gw; it < BATCH * 32; it += NGW) {
            const int b = it >> 5, j = it & 31;
            float a0 = 0.f, a1 = 0.f, a2 = 0.f, a3 = 0.f;
            for (int k = 0; k < 256; ++k) {
                const int t = b * SEQ + j * 256 + k;
                const u32x2 w = *(const u32x2*)(P + (size_t)t * PP + C_MK + lane * 4);
                float v0 = bflo(w.x), v1 = bfhi(w.x), v2 = bflo(w.y), v3 = bfhi(w.y);
                float s = v0 * v0 + v1 * v1 + v2 * v2 + v3 * v3;
#pragma unroll
                for (int o = 1; o < 16; o <<= 1) s += __shfl_xor(s, o);
                const float r = __builtin_amdgcn_rsqf(s * (1.0f / 64) + EPS);
                a0 += bf2f((unsigned short)f2bf(v0 * r * g0)); a1 += bf2f((unsigned short)f2bf(v1 * r * g1)); a2 += bf2f((unsigned short)f2bf(v2 * r * g2)); a3 += bf2f((unsigned short)f2bf(v3 * r * g3));
            }
            f32x4 o = {a0 * (1.0f / 256), a1 * (1.0f / 256), a2 * (1.0f / 256), a3 * (1.0f / 256)};
            *(f32x4*)(KM + ((size_t)(b * 4 + h) * 32 + j) * 64 + d0) = o;
        }
    }
}


constexpr int GREC = 73728;
constexpr int CW_PROG = 12288;
constexpr int CW_PQ = 14336;
constexpr int CW_FLG = 16384;
constexpr int N_PREP = T / 64 * 4;
constexpr int R_W = 0, R_QG = 16384, R_KD = 32768, R_QK = 49152, R_U = 55296, R_GL = 71680;
constexpr int R_OPS = 55296;
constexpr int L_QN = 0, L_KN = 17408, L_KNT = 34816, L_VT = 53248, L_AT = 71680, L_TP = 89088, L_KGT = 98304, L_SC = 116736, L_AB = 117760, L_TT = 126976, L_CW = 147456;
constexpr int PQ = 272, PT = 144;
__device__ __forceinline__ u32x4 pack8(const float (&v)[8]) { u32x4 w; w.x = cvtpk(v[0], v[1]); w.y = cvtpk(v[2], v[3]); w.z = cvtpk(v[4], v[5]); w.w = cvtpk(v[6], v[7]); return w; }

__device__ __forceinline__ bf16x8 cvt8(const f32x16& x, int s) {
    u32x4 w;
    if (s == 0) { w.x = cvtpk(x[0], x[1]); w.y = cvtpk(x[2], x[3]); w.z = cvtpk(x[4], x[5]); w.w = cvtpk(x[6], x[7]); }
    else { w.x = cvtpk(x[8], x[9]); w.y = cvtpk(x[10], x[11]); w.z = cvtpk(x[12], x[13]); w.w = cvtpk(x[14], x[15]); }
    return __builtin_bit_cast(bf16x8, w);
}

__device__ __forceinline__ void gdn_prep_fetch(Frame& F, int item, u32x4 (&praw)[11], float& pa, float& pb) {
    const int cidx = item >> 2, h = item & 3; const int t0 = cidx * 64, tl0 = t0 & (SEQ - 1);
    const bf16_t* P = (const bf16_t*)(F.ws + WS_C); const int tid2 = F.tid & 127, cg = tid2 & 15, c0 = (tid2 >> 4) * 8; const int s = F.wave >> 1;
    if (F.wave < 6) {
#pragma unroll
        for (int k = 0; k < 11; ++k)
            praw[k] = (tl0 + c0 - 3 + k >= 0) ? *(const u32x4*)(P + (size_t)(t0 + c0 - 3 + k) * PP + s * 512 + h * 128 + cg * 8) : (u32x4){0u, 0u, 0u, 0u};
    }
    if (F.wave == 0) { const float* AB = (const float*)(F.ws + WS_AB); pa = AB[(size_t)(t0 + F.lane) * 8 + h]; pb = AB[(size_t)(t0 + F.lane) * 8 + 4 + h]; }
}
typedef int i32x4 __attribute__((ext_vector_type(4)));
__device__ __forceinline__ void st16_wt(__amdgpu_buffer_rsrc_t rsrc, int off, u32x4 v) { __builtin_amdgcn_raw_buffer_store_b128(__builtin_bit_cast(i32x4, v), rsrc, off, 0, 16); }
__device__ __forceinline__ void gdn_prep_item(Frame& F, const Args& A, int item, int next_item, u32x4 (&praw)[11], float& pa, float& pb, int& cw_head, int& pend) {
    const int cidx = item >> 2, h = item & 3;
    const int t0 = cidx * 64, tl0 = t0 & (SEQ - 1);
    LAS unsigned char* L = F.lds;
    int tid = F.tid; asm volatile("" : "+v"(tid));
    const int lane = tid & 63, wave = F.wave;
    unsigned char* rec = F.ws + WS_G + (size_t)item * GREC;
    const __amdgpu_buffer_rsrc_t rsrc = __builtin_amdgcn_make_buffer_rsrc(rec, 0, GREC, 0x00020000);
    const bf16_t* P = (const bf16_t*)(F.ws + WS_C);
    LAS float* sc_beta = (LAS float*)(L + L_SC); LAS float* sc_gc = sc_beta + 64; LAS float* sc_eg = sc_beta + 128; LAS float* sc_ekd = sc_beta + 192;
    if (wave == 0) {
        const float a = pa, bb = pb;
        const float xx = a + A.in[10][h]; const float sp = (xx > 20.f) ? xx : log1pf(__expf(xx));
        float g = -__expf(A.in[9][h]) * sp;
        const float beta = 1.0f / (1.0f + __expf(-bb));
#pragma unroll
        for (int o = 1; o < 64; o <<= 1) { const float u = __shfl_up(g, o); if (lane >= o) g += u; }
        const float gl = __shfl(g, 63);
        sc_beta[lane] = beta; sc_gc[lane] = g; sc_eg[lane] = __expf(g); sc_ekd[lane] = __expf(gl - g);
        if (lane == 0) __hip_atomic_store((float*)(rec + R_GL), __expf(gl), __ATOMIC_RELAXED, __HIP_MEMORY_SCOPE_AGENT);
    }
    for (int i = tid; i < 576; i += NTHREADS) { *(LAS u32x4*)(L + L_TP + i * 16) = (u32x4){0u, 0u, 0u, 0u}; *(LAS u32x4*)(L + L_TT + i * 16) = (u32x4){0u, 0u, 0u, 0u}; }
    if (h != cw_head) {
        LAS float* cwl = (LAS float*)(L + L_CW);
        for (int i = tid; i < 1536; i += NTHREADS) { const int e = i & 7, j = (i >> 3) & 3, s3 = (i >> 5) % 3, cg2 = i / 96;
            cwl[i] = A.in[8][j * 1536 + s3 * 512 + h * 128 + cg2 * 8 + e]; }
        cw_head = h;
    }
    __syncthreads();
    if (wave < 6) {
        const int s = wave >> 1, tid2 = tid & 127, cg = tid2 & 15, c0 = (tid2 >> 4) * 8;
        const LAS float* cwl = (const LAS float*)(L + L_CW) + cg * 96 + s * 32;
        f32x4 cw0[4], cw1[4];
#pragma unroll
        for (int j = 0; j < 4; ++j) { cw0[j] = *(const LAS f32x4*)(cwl + j * 8); cw1[j] = *(const LAS f32x4*)(cwl + j * 8 + 4); }
        const int cst = ((c0 + 8 * (cg & 7)) & 63) * 2;
#pragma unroll
        for (int g4 = 0; g4 < 2; ++g4) {
            float y[4][8];
#pragma unroll
            for (int k = 0; k < 4; ++k)
#pragma unroll
                for (int i = 0; i < 8; ++i) y[k][i] = 0.f;
#pragma unroll
            for (int r7 = 0; r7 < 7; ++r7) {
                const u32x4 w = praw[4 * g4 + r7];
                const float x0 = bflo(w.x), x1 = bfhi(w.x), x2 = bflo(w.y), x3 = bfhi(w.y), x4 = bflo(w.z), x5 = bfhi(w.z), x6 = bflo(w.w), x7 = bfhi(w.w);
#pragma unroll
                for (int j = 0; j < 4; ++j) { const int k = r7 - j;
                    if (k >= 0 && k < 4) {
                        y[k][0] += cw0[j][0] * x0; y[k][1] += cw0[j][1] * x1; y[k][2] += cw0[j][2] * x2; y[k][3] += cw0[j][3] * x3;
                        y[k][4] += cw1[j][0] * x4; y[k][5] += cw1[j][1] * x5; y[k][6] += cw1[j][2] * x6; y[k][7] += cw1[j][3] * x7; } }
            }
#pragma unroll
            for (int k = 0; k < 4; ++k)
#pragma unroll
                for (int i = 0; i < 8; ++i) { const float v = y[k][i]; y[k][i] = v * __builtin_amdgcn_rcpf(1.0f + __expf(-v)); }
            if (s < 2) {
#pragma unroll
                for (int k = 0; k < 4; ++k) {
                    float sq = 0.f;
#pragma unroll
                    for (int i = 0; i < 8; ++i) sq += y[k][i] * y[k][i];
#pragma unroll
                    for (int o = 1; o < 16; o <<= 1) sq += __shfl_xor(sq, o);
                    const float rn = __builtin_amdgcn_rsqf(sq + EPS) * (s == 0 ? 0.08838834764831845f : 1.0f);
#pragma unroll
                    for (int i = 0; i < 8; ++i) y[k][i] *= rn;
                }
            }
            const int cb = c0 + 4 * g4;
            if (s == 0) {
#pragma unroll
                for (int k = 0; k < 4; ++k) *(LAS u32x4*)(L + L_QN + (cb + k) * PQ + cg * 16) = pack8(y[k]);
            } else if (s == 1) {
#pragma unroll
                for (int k = 0; k < 4; ++k) *(LAS u32x4*)(L + L_KN + (cb + k) * PQ + cg * 16) = pack8(y[k]);
                float be[4];
#pragma unroll
                for (int k = 0; k < 4; ++k) be[k] = sc_beta[cb + k] * sc_eg[cb + k];
#pragma unroll
                for (int i = 0; i < 8; ++i) {
                    u32x2 kw, gw;
                    kw.x = cvtpk(y[0][i], y[1][i]); kw.y = cvtpk(y[2][i], y[3][i]);
                    gw.x = cvtpk(y[0][i] * be[0], y[1][i] * be[1]); gw.y = cvtpk(y[2][i] * be[2], y[3][i] * be[3]);
                    *(LAS u32x2*)(L + L_KNT + (cg * 8 + i) * PT + cst + 8 * g4) = kw;
                    *(LAS u32x2*)(L + L_KGT + (cg * 8 + i) * PT + cst + 8 * g4) = gw;
                }
            } else {
                float bt[4];
#pragma unroll
                for (int k = 0; k < 4; ++k) bt[k] = sc_beta[cb + k];
#pragma unroll
                for (int i = 0; i < 8; ++i) {
                    u32x2 vw; vw.x = cvtpk(y[0][i] * bt[0], y[1][i] * bt[1]); vw.y = cvtpk(y[2][i] * bt[2], y[3][i] * bt[3]);
                    *(LAS u32x2*)(L + L_VT + (cg * 8 + i) * PT + cst + 8 * g4) = vw;
                }
            }
        }
    }
    if (pend >= 0) asm volatile("s_waitcnt vmcnt(0)" ::: "memory");
    __syncthreads();
    if (pend >= 0 && tid == 0) __hip_atomic_store((unsigned*)(F.ws + WS_CTL) + CW_FLG + pend, 1u, __ATOMIC_RELAXED, __HIP_MEMORY_SCOPE_AGENT);
    if (next_item < T / 64 * 4) gdn_prep_fetch(F, next_item, praw, pa, pb);
    const int r = lane & 31, hh = lane >> 5;
    if (wave < 6) {
        int tm, tn; const LAS unsigned char* Ab; const LAS unsigned char* Bb;
        if (wave < 3) { tm = (wave >= 1); tn = (wave == 2); Ab = L + L_KN + (32 * tm + r) * PQ; Bb = L + L_KN + (32 * tn + r) * PQ; }
        else { tm = (wave == 5); tn = (wave >= 4); Ab = L + L_KN + (32 * tm + r) * PQ; Bb = L + L_QN + (32 * tn + r) * PQ; }
        f32x16 acc;
#pragma unroll
        for (int i = 0; i < 16; ++i) acc[i] = 0.f;
#pragma unroll
        for (int s = 0; s < 8; ++s) { const bf16x8 a = *(const LAS bf16x8*)(Ab + s * 32 + hh * 16), b = *(const LAS bf16x8*)(Bb + s * 32 + hh * 16);
            acc = __builtin_amdgcn_mfma_f32_32x32x16_bf16(a, b, acc, 0, 0, 0); }
        const int col = tn * 32 + r; const float gcc = sc_gc[col];
        if (wave < 3) {
#pragma unroll
            for (int i = 0; i < 16; ++i) { const int row = tm * 32 + (i & 3) + 8 * (i >> 2) + 4 * hh;
                const float v = (row > col) ? acc[i] * sc_beta[row] * __expf(sc_gc[row] - gcc) : 0.f;
                *(LAS float*)(L + L_AT + col * PQ + row * 4) = v;
                *(LAS unsigned short*)(L + L_AB + row * PT + col * 2) = (unsigned short)(cvtpk(v, 0.f) & 0xffffu); }
        } else {
            float v[16];
#pragma unroll
            for (int i = 0; i < 16; ++i) { const int row = tm * 32 + (i & 3) + 8 * (i >> 2) + 4 * hh;
                v[i] = (row <= col) ? acc[i] * __expf(gcc - sc_gc[row]) : 0.f; }
            const int f0 = (tn == 0) ? 0 : 2 + 2 * tm;
            u32x4 w0, w1; w0.x = cvtpk(v[0], v[1]); w0.y = cvtpk(v[2], v[3]); w0.z = cvtpk(v[4], v[5]); w0.w = cvtpk(v[6], v[7]);
            w1.x = cvtpk(v[8], v[9]); w1.y = cvtpk(v[10], v[11]); w1.z = cvtpk(v[12], v[13]); w1.w = cvtpk(v[14], v[15]);
            st16_wt(rsrc, R_QK + f0 * 1024 + lane * 16, w0);
            st16_wt(rsrc, R_QK + (f0 + 1) * 1024 + lane * 16, w1);
        }
    }
    __syncthreads();
    if (wave == 0) {
        {
            const int g = lane >> 4, rr = lane & 15;
            const LAS unsigned char* ab = L + L_AT + (16 * g) * PQ + (16 * g) * 4;
            float Dr[16];
#pragma unroll
            for (int i = 0; i < 16; ++i) Dr[i] = 0.f;
            Dr[15] = (rr == 15) ? 1.0f : 0.f;
#define GDN_L0_BATCH(JHI, JLO) { asm volatile("" : "+v"(ab)); f32x4 av[(JHI) - (JLO) + 1][4]; \
            _Pragma("unroll") for (int jj = (JHI); jj >= (JLO); --jj) _Pragma("unroll") for (int k = 0; k < 4; ++k) if (k >= ((jj + 1) >> 2)) av[jj - (JLO)][k] = *(const LAS f32x4*)(ab + jj * PQ + k * 16); \
            _Pragma("unroll") for (int jj = (JHI); jj >= (JLO); --jj) { f32x2 a0 = {0.f, 0.f}, a1 = {0.f, 0.f}; \
                _Pragma("unroll") for (int k = 0; k < 4; ++k) if (k >= ((jj + 1) >> 2)) { \
                    a0 += (f32x2){Dr[4 * k], Dr[4 * k + 1]} * (f32x2){av[jj - (JLO)][k][0], av[jj - (JLO)][k][1]}; \
                    a1 += (f32x2){Dr[4 * k + 2], Dr[4 * k + 3]} * (f32x2){av[jj - (JLO)][k][2], av[jj - (JLO)][k][3]}; } \
                Dr[jj] = (rr == jj) ? 1.0f : -((a0[0] + a0[1]) + (a1[0] + a1[1])); } }
            GDN_L0_BATCH(14, 7)
            GDN_L0_BATCH(6, 3)
            GDN_L0_BATCH(2, 0)
#undef GDN_L0_BATCH
            u32x4 w0, w1; w0.x = cvtpk(Dr[0], Dr[1]); w0.y = cvtpk(Dr[2], Dr[3]); w0.z = cvtpk(Dr[4], Dr[5]); w0.w = cvtpk(Dr[6], Dr[7]);
            w1.x = cvtpk(Dr[8], Dr[9]); w1.y = cvtpk(Dr[10], Dr[11]); w1.z = cvtpk(Dr[12], Dr[13]); w1.w = cvtpk(Dr[14], Dr[15]);
            *(LAS u32x4*)(L + L_TP + (16 * g + rr) * PT + 32 * g) = w0; *(LAS u32x4*)(L + L_TP + (16 * g + rr) * PT + 32 * g + 16) = w1;
            const unsigned dw[8] = {w0.x, w0.y, w0.z, w0.w, w1.x, w1.y, w1.z, w1.w};
#pragma unroll
            for (int c = 0; c < 16; ++c) *(LAS unsigned short*)(L + L_TT + (16 * g + c) * PT + (16 * g + rr) * 2) = (unsigned short)((c & 1) ? (dw[c >> 1] >> 16) : (dw[c >> 1] & 0xffffu));
        }
        asm volatile("s_waitcnt lgkmcnt(0)" ::: "memory");
#pragma unroll
        for (int q = 0; q < 2; ++q) {
            f32x16 G, M;
#pragma unroll
            for (int i = 0; i < 16; ++i) { G[i] = 0.f; M[i] = 0.f; }
            G = __builtin_amdgcn_mfma_f32_32x32x16_bf16(*(const LAS bf16x8*)(L + L_AB + (32 * q + r) * PT + (32 * q + 8 * hh) * 2),
                                                         *(const LAS bf16x8*)(L + L_TT + (32 * q + r) * PT + (32 * q + 8 * hh) * 2), G, 0, 0, 0);
            const bf16x8 gb = cvt8(G, 1);
            const u32x2 d0 = *(const LAS u32x2*)(L + L_TP + (32 * q + r) * PT + (32 * q + 16 + 4 * hh) * 2), d1 = *(const LAS u32x2*)(L + L_TP + (32 * q + r) * PT + (32 * q + 16 + 8 + 4 * hh) * 2);
            u32x4 da; da.x = d0.x; da.y = d0.y; da.z = d1.x; da.w = d1.y;
            M = __builtin_amdgcn_mfma_f32_32x32x16_bf16(__builtin_bit_cast(bf16x8, da), gb, M, 0, 0, 0);
            if (r < 16) {
#pragma unroll
                for (int i = 8; i < 16; ++i) { const int m = (i & 3) + 8 * (i >> 2) + 4 * hh;
                    *(LAS unsigned short*)(L + L_TP + (32 * q + m) * PT + (32 * q + r) * 2) = (unsigned short)(cvtpk(-M[i], 0.f) & 0xffffu); }
                u32x2 t0, t1; t0.x = cvtpk(-M[8], -M[9]); t0.y = cvtpk(-M[10], -M[11]); t1.x = cvtpk(-M[12], -M[13]); t1.y = cvtpk(-M[14], -M[15]);
                *(LAS u32x2*)(L + L_TT + (32 * q + r) * PT + (32 * q + 16 + 4 * hh) * 2) = t0;
                *(LAS u32x2*)(L + L_TT + (32 * q + r) * PT + (32 * q + 24 + 4 * hh) * 2) = t1;
            }
        }
        asm volatile("s_waitcnt lgkmcnt(0)" ::: "memory");
        {
            f32x16 G, M;
#pragma unroll
            for (int i = 0; i < 16; ++i) { G[i] = 0.f; M[i] = 0.f; }
#pragma unroll
            for (int sx = 0; sx < 2; ++sx)
                G = __builtin_amdgcn_mfma_f32_32x32x16_bf16(*(const LAS bf16x8*)(L + L_AB + (32 + r) * PT + (16 * sx + 8 * hh) * 2),
                                                             *(const LAS bf16x8*)(L + L_TT + r * PT + (16 * sx + 8 * hh) * 2), G, 0, 0, 0);
#pragma unroll
            for (int sx = 0; sx < 2; ++sx) {
                const bf16x8 gb = cvt8(G, sx);
                const u32x2 d0 = *(const LAS u32x2*)(L + L_TP + (32 + r) * PT + (32 + 16 * sx + 4 * hh) * 2), d1 = *(const LAS u32x2*)(L + L_TP + (32 + r) * PT + (32 + 16 * sx + 8 + 4 * hh) * 2);
                u32x4 da; da.x = d0.x; da.y = d0.y; da.z = d1.x; da.w = d1.y;
                M = __builtin_amdgcn_mfma_f32_32x32x16_bf16(__builtin_bit_cast(bf16x8, da), gb, M, 0, 0, 0);
            }
#pragma unroll
            for (int i = 0; i < 16; ++i) { const int m = (i & 3) + 8 * (i >> 2) + 4 * hh;
                *(LAS unsigned short*)(L + L_TP + (32 + m) * PT + r * 2) = (unsigned short)(cvtpk(-M[i], 0.f) & 0xffffu); }
        }
    } else {
        for (int f = wave - 1; f < 32; f += 7) {
            if (f < 16) {
                const int mt = f >> 3, dblk = (f >> 1) & 3, s = f & 1; const int c = 32 * mt + r, d0 = 32 * dblk + 16 * s + 4 * hh;
                const u32x2 lo = *(const LAS u32x2*)(L + L_QN + c * PQ + d0 * 2), hi = *(const LAS u32x2*)(L + L_QN + c * PQ + (d0 + 8) * 2);
                const float e = sc_eg[c];
                float v[8] = {bflo(lo.x) * e, bfhi(lo.x) * e, bflo(lo.y) * e, bfhi(lo.y) * e, bflo(hi.x) * e, bfhi(hi.x) * e, bflo(hi.y) * e, bfhi(hi.y) * e};
                st16_wt(rsrc, R_QG + f * 1024 + lane * 16, pack8(v));
            } else {
                const int g = f - 16; const int dblk = g >> 2, blk = (g >> 1) & 1, s = g & 1; const int d = 32 * dblk + r, c0 = 32 * blk + 16 * s + 4 * hh;
                const int rot = 8 * ((d >> 3) & 7);
                const u32x2 lo = *(const LAS u32x2*)(L + L_KNT + d * PT + ((c0 + rot) & 63) * 2), hi = *(const LAS u32x2*)(L + L_KNT + d * PT + ((c0 + 8 + rot) & 63) * 2);
                const f32x4 e0 = *(const LAS f32x4*)(sc_ekd + c0), e1 = *(const LAS f32x4*)(sc_ekd + c0 + 8);
                float v[8] = {bflo(lo.x) * e0[0], bfhi(lo.x) * e0[1], bflo(lo.y) * e0[2], bfhi(lo.y) * e0[3], bflo(hi.x) * e1[0], bfhi(hi.x) * e1[1], bflo(hi.y) * e1[2], bfhi(hi.y) * e1[3]};
                st16_wt(rsrc, R_KD + g * 1024 + lane * 16, pack8(v));
            }
        }
    }
    __syncthreads();
    {
        const int ct = wave >> 2, et = wave & 3, dt = wave & 3;
        f32x16 acc;
#pragma unroll
        for (int i = 0; i < 16; ++i) acc[i] = 0.f;
        const LAS unsigned char* Ab = L + L_TP + (32 * ct + r) * PT + hh * 16; const LAS unsigned char* Bb = L + L_VT + (32 * et + r) * PT; const int rotv = (4 * et + (r >> 3)) & 7;
#define ROTC(s_, hh_, rot_) ((((2 * (s_) + (hh_)) + (rot_)) & 7) * 16)
#pragma unroll
        for (int s = 0; s < 2; ++s) acc = __builtin_amdgcn_mfma_f32_32x32x16_bf16(*(const LAS bf16x8*)(Ab + s * 32), *(const LAS bf16x8*)(Bb + ROTC(s, hh, rotv)), acc, 0, 0, 0);
        if (ct) {
#pragma unroll
            for (int s = 2; s < 4; ++s) acc = __builtin_amdgcn_mfma_f32_32x32x16_bf16(*(const LAS bf16x8*)(Ab + s * 32), *(const LAS bf16x8*)(Bb + ROTC(s, hh, rotv)), acc, 0, 0, 0);
        }
        { u32x4 w0, w1; w0.x = cvtpk(acc[0], acc[1]); w0.y = cvtpk(acc[2], acc[3]); w0.z = cvtpk(acc[4], acc[5]); w0.w = cvtpk(acc[6], acc[7]);
          w1.x = cvtpk(acc[8], acc[9]); w1.y = cvtpk(acc[10], acc[11]); w1.z = cvtpk(acc[12], acc[13]); w1.w = cvtpk(acc[14], acc[15]);
          st16_wt(rsrc, R_U + (et * 2 + ct) * 2048 + lane * 32, w0); st16_wt(rsrc, R_U + (et * 2 + ct) * 2048 + lane * 32 + 16, w1); }
#pragma unroll
        for (int i = 0; i < 16; ++i) acc[i] = 0.f;
        Ab = L + L_KGT + (32 * dt + r) * PT; Bb = L + L_TP + (32 * ct + r) * PT + hh * 16;
#pragma unroll
        for (int s = 0; s < 2; ++s) acc = __builtin_amdgcn_mfma_f32_32x32x16_bf16(*(const LAS bf16x8*)(Ab + ROTC(s, hh, rotv)), *(const LAS bf16x8*)(Bb + s * 32), acc, 0, 0, 0);
        if (ct) {
#pragma unroll
            for (int s = 2; s < 4; ++s) acc = __builtin_amdgcn_mfma_f32_32x32x16_bf16(*(const LAS bf16x8*)(Ab + ROTC(s, hh, rotv)), *(const LAS bf16x8*)(Bb + s * 32), acc, 0, 0, 0);
        }
#undef ROTC
        { u32x4 w0, w1; w0.x = cvtpk(acc[0], acc[1]); w0.y = cvtpk(acc[2], acc[3]); w0.z = cvtpk(acc[4], acc[5]); w0.w = cvtpk(acc[6], acc[7]);
          w1.x = cvtpk(acc[8], acc[9]); w1.y = cvtpk(acc[10], acc[11]); w1.z = cvtpk(acc[12], acc[13]); w1.w = cvtpk(acc[14], acc[15]);
          const int f0 = (ct * 4 + dt) * 2;
          st16_wt(rsrc, R_W + f0 * 1024 + lane * 16, w0); st16_wt(rsrc, R_W + (f0 + 1) * 1024 + lane * 16, w1); }
    }
    pend = item;
}

constexpr int S_OP0 = 0, S_OP1 = 55296, S_OB0 = 110592, S_OB1 = 128000;
__device__ __forceinline__ void gdn_scan(Frame& F, const Args& A, int b, int h) {
    LAS unsigned char* L = F.lds;
    int tid = F.tid; asm volatile("" : "+v"(tid));
    const int lane = tid & 63, wave = F.wave;
    const unsigned char* rec0 = F.ws + WS_G + ((size_t)(b * 128) * 4 + h) * GREC;
    const size_t rstep = (size_t)4 * GREC;
    bf16_t* P = (bf16_t*)(F.ws + WS_C);
    const int r = lane & 31, hh = lane >> 5;
    auto stage = [&](int n) {
        const unsigned char* src = rec0 + (size_t)n * rstep; const int lw = wave - 4; const int ob = (n & 1) ? S_OP1 : S_OP0;
        for (int k = lw; k < 54; k += 4)
            __builtin_amdgcn_global_load_lds((const unsigned*)(src + k * 1024 + lane * 16), (LAS unsigned*)(L + ob + k * 1024), 16, 0, 0);
    };
    auto warm = [&](int n) {
        const unsigned char* src = rec0 + (size_t)(n < 127 ? n : 127) * rstep; const int lw = wave - 4;
#pragma unroll
        for (int k = 0; k < 3; ++k) { const int p = lw + 4 * k; const int off = (p < 9 ? p : p - 3) * 8192;
            __builtin_amdgcn_global_load_lds((const unsigned*)(src + off + lane * 128), (LAS unsigned*)(L + 145920 + lw * 256), 4, 0, 0); }
    };
    auto zstage = [&](int m) {
        const int lw = wave - 4;
#pragma unroll
        for (int k = 0; k < 4; ++k) { const int p = lw * 4 + k;
            const bf16_t* zp = P + ((size_t)b * SEQ + m * 64 + 4 * p + (lane >> 4)) * PP + C_GZ + h * 128 + (lane & 15) * 8;
            __builtin_amdgcn_global_load_lds((const unsigned*)zp, (LAS unsigned*)(L + 147456 + p * 1024), 16, 0, 0); }
    };
    unsigned* flags = (unsigned*)(F.ws + WS_CTL) + CW_FLG + (size_t)(b * 128) * 4 + h;
    auto ensure = [&](int first, int count) {
        unsigned spins = 0;
        for (;;) {
            const unsigned v = (lane < count) ? __hip_atomic_load(flags + 4 * (first + lane), __ATOMIC_RELAXED, __HIP_MEMORY_SCOPE_AGENT) : 1u;
            if (__ballot(v == 0u) == 0ull) break;
            __builtin_amdgcn_s_sleep(4);
            if (++spins > (1u << 20)) break;
        }
        __builtin_amdgcn_fence(__ATOMIC_ACQUIRE, "agent");
        asm volatile("s_waitcnt vmcnt(0)" ::: "memory");
    };
    if (wave == 4) ensure(0, 8);
    __syncthreads();
    if (wave >= 4) { stage(0);
        const unsigned char* src1 = rec0 + rstep; const int lw = wave - 4;
#pragma unroll
        for (int j = 0; j < 8; ++j) { const int k = lw + 4 * j; __builtin_amdgcn_global_load_lds((const unsigned*)(src1 + k * 1024 + lane * 16), (LAS unsigned*)(L + S_OP1 + k * 1024), 16, 0, 0); } }
    f32x16 S[4];
#pragma unroll
    for (int d = 0; d < 4; ++d)
#pragma unroll
        for (int i = 0; i < 16; ++i) S[d][i] = 0.f;
    u32x4 Uc[4]; float glc = 0.f;
    if (wave < 4) {
        const unsigned char* up = rec0 + R_U + wave * 4096 + lane * 32;
        Uc[0] = *(const u32x4*)(up); Uc[1] = *(const u32x4*)(up + 16); Uc[2] = *(const u32x4*)(up + 2048); Uc[3] = *(const u32x4*)(up + 2048 + 16);
        glc = *(const float*)(rec0 + R_GL);
    }
    LAS float* ogl = (LAS float*)(L + 145408);
    if (tid < 128) ogl[tid] = A.in[11][tid];
    asm volatile("s_waitcnt vmcnt(0)" ::: "memory");
    __syncthreads();
    unsigned* prog = (unsigned*)(F.ws + WS_CTL) + CW_PROG + 64 * (b * 4 + h);
    for (int n = 0; n < 128; ++n) {
        if (tid == 0) __hip_atomic_store(prog, (unsigned)(n + 1), __ATOMIC_RELAXED, __HIP_MEMORY_SCOPE_AGENT);
        if (wave < 4) {
            const LAS unsigned char* ob = L + ((n & 1) ? S_OP1 : S_OP0) + lane * 16;
            f32x16 w0, w1, o0, o1;
#pragma unroll
            for (int i = 0; i < 16; ++i) { w0[i] = 0.f; w1[i] = 0.f; o0[i] = 0.f; o1[i] = 0.f; }
            bf16x8 sb[4][2];
#pragma unroll
            for (int d = 0; d < 4; ++d)
#pragma unroll
                for (int s = 0; s < 2; ++s) sb[d][s] = cvt8(S[d], s);
#pragma unroll
            for (int d = 0; d < 4; ++d)
#pragma unroll
                for (int s = 0; s < 2; ++s) {
                    w0 = __builtin_amdgcn_mfma_f32_32x32x16_bf16(*(const LAS bf16x8*)(ob + R_W + ((0 * 4 + d) * 2 + s) * 1024), sb[d][s], w0, 0, 0, 0);
                    w1 = __builtin_amdgcn_mfma_f32_32x32x16_bf16(*(const LAS bf16x8*)(ob + R_W + ((1 * 4 + d) * 2 + s) * 1024), sb[d][s], w1, 0, 0, 0);
                }
#define QGF(a_, d_, s_) (*(const LAS bf16x8*)(ob + R_QG + (((a_) * 4 + (d_)) * 2 + (s_)) * 1024))
            bf16x8 qa[4], qb[4];
            qa[0] = QGF(0, 0, 0); qa[1] = QGF(0, 0, 1); qa[2] = QGF(1, 0, 0); qa[3] = QGF(1, 0, 1);
            __builtin_amdgcn_sched_group_barrier(0x2, 32, 0);
            __builtin_amdgcn_sched_group_barrier(0x100, 8, 0);
#pragma unroll
            for (int g = 0; g < 12; ++g) { __builtin_amdgcn_sched_group_barrier(0x8, 1, 0); __builtin_amdgcn_sched_group_barrier(0x100, 1, 0); }
            __builtin_amdgcn_sched_group_barrier(0x8, 4, 0);
            __builtin_amdgcn_sched_barrier(0);
            const unsigned u0[8] = {Uc[0].x, Uc[0].y, Uc[0].z, Uc[0].w, Uc[1].x, Uc[1].y, Uc[1].z, Uc[1].w};
            const unsigned u1[8] = {Uc[2].x, Uc[2].y, Uc[2].z, Uc[2].w, Uc[3].x, Uc[3].y, Uc[3].z, Uc[3].w};
            bf16x8 vb[2][2];
            const float gl = glc;
#define QG_RUN(d_, qc_) do { o0 = __builtin_amdgcn_mfma_f32_32x32x16_bf16(qc_[0], sb[d_][0], o0, 0, 0, 0); o1 = __builtin_amdgcn_mfma_f32_32x32x16_bf16(qc_[2], sb[d_][0], o1, 0, 0, 0); \
                             o0 = __builtin_amdgcn_mfma_f32_32x32x16_bf16(qc_[1], sb[d_][1], o0, 0, 0, 0); o1 = __builtin_amdgcn_mfma_f32_32x32x16_bf16(qc_[3], sb[d_][1], o1, 0, 0, 0); } while (0)
#define QG_SGB(nds_) do { _Pragma("unroll") for (int g_ = 0; g_ < 4; ++g_) { __builtin_amdgcn_sched_group_barrier(0x8, 1, 0); if (nds_) __builtin_amdgcn_sched_group_barrier(0x100, 1, 0); __builtin_amdgcn_sched_group_barrier(0x2, 6, 0); } } while (0)
            qb[0] = QGF(0, 1, 0); qb[1] = QGF(0, 1, 1); qb[2] = QGF(1, 1, 0); qb[3] = QGF(1, 1, 1);
            QG_RUN(0, qa);
#pragma unroll
            for (int i = 0; i < 8; ++i) { w0[2 * i] = bflo(u0[i]) - w0[2 * i]; w0[2 * i + 1] = bfhi(u0[i]) - w0[2 * i + 1]; }
            QG_SGB(1); __builtin_amdgcn_sched_barrier(0);
            qa[0] = QGF(0, 2, 0); qa[1] = QGF(0, 2, 1); qa[2] = QGF(1, 2, 0); qa[3] = QGF(1, 2, 1);
            QG_RUN(1, qb);
            vb[0][0] = cvt8(w0, 0); vb[0][1] = cvt8(w0, 1);
#pragma unroll
            for (int i = 0; i < 4; ++i) { w1[2 * i] = bflo(u1[i]) - w1[2 * i]; w1[2 * i + 1] = bfhi(u1[i]) - w1[2 * i + 1]; }
            QG_SGB(1); __builtin_amdgcn_sched_barrier(0);
            qb[0] = QGF(0, 3, 0); qb[1] = QGF(0, 3, 1); qb[2] = QGF(1, 3, 0); qb[3] = QGF(1, 3, 1);
            QG_RUN(2, qa);
#pragma unroll
            for (int i = 4; i < 8; ++i) { w1[2 * i] = bflo(u1[i]) - w1[2 * i]; w1[2 * i + 1] = bfhi(u1[i]) - w1[2 * i + 1]; }
            vb[1][0] = cvt8(w1, 0); vb[1][1] = cvt8(w1, 1);
            QG_SGB(1); __builtin_amdgcn_sched_barrier(0);
            QG_RUN(3, qb);
#pragma unroll
            for (int d = 0; d < 2; ++d)
#pragma unroll
                for (int i = 0; i < 16; ++i) S[d][i] *= gl;
            QG_SGB(0);
#undef QGF
#undef QG_RUN
#undef QG_SGB
            __builtin_amdgcn_sched_barrier(0); asm volatile("" ::: "memory"); __builtin_amdgcn_s_barrier(); asm volatile("" ::: "memory"); __builtin_amdgcn_sched_barrier(0);
            bf16x8 qkf[6], kdA[8];
#pragma unroll
            for (int f = 0; f < 6; ++f) qkf[f] = *(const LAS bf16x8*)(ob + R_QK + f * 1024);
#pragma unroll
            for (int f = 0; f < 8; ++f) kdA[f] = *(const LAS bf16x8*)(ob + R_KD + f * 1024);
#pragma unroll
            for (int d = 2; d < 4; ++d)
#pragma unroll
                for (int i = 0; i < 16; ++i) S[d][i] *= gl;
            __builtin_amdgcn_sched_barrier(0);
            bf16x8 kdB[8];
#pragma unroll
            for (int f = 0; f < 8; ++f) kdB[f] = *(const LAS bf16x8*)(ob + R_KD + (8 + f) * 1024);
#pragma unroll
            for (int s = 0; s < 2; ++s) {
                o0 = __builtin_amdgcn_mfma_f32_32x32x16_bf16(qkf[0 + s], vb[0][s], o0, 0, 0, 0);
                o1 = __builtin_amdgcn_mfma_f32_32x32x16_bf16(qkf[2 + s], vb[0][s], o1, 0, 0, 0);
                o1 = __builtin_amdgcn_mfma_f32_32x32x16_bf16(qkf[4 + s], vb[1][s], o1, 0, 0, 0);
            }
            __builtin_amdgcn_sched_group_barrier(0x8, 2, 1);
            __builtin_amdgcn_sched_group_barrier(0x100, 8, 1);
            __builtin_amdgcn_sched_group_barrier(0x8, 4, 1);
            __builtin_amdgcn_sched_barrier(0);
            LAS unsigned char* obuf = L + ((n & 1) ? S_OB1 : S_OB0) + (wave * 32 + r) * 2;
#define OW2(ov_, base_, i_) do { const int r0_ = ((i_) & 3) + 8 * ((i_) >> 2) + 4 * hh, r1_ = (((i_) + 1) & 3) + 8 * (((i_) + 1) >> 2) + 4 * hh; \
                *(LAS unsigned short*)(obuf + ((base_) + r0_) * PQ) = (unsigned short)(cvtpk(ov_[(i_)], 0.f) & 0xffffu); \
                *(LAS unsigned short*)(obuf + ((base_) + r1_) * PQ) = (unsigned short)(cvtpk(ov_[(i_) + 1], 0.f) & 0xffffu); } while (0)
#pragma unroll
            for (int d = 0; d < 2; ++d)
#pragma unroll
                for (int bk = 0; bk < 2; ++bk)
#pragma unroll
                    for (int s = 0; s < 2; ++s) { const int g = (d * 2 + bk) * 2 + s;
                        S[d] = __builtin_amdgcn_mfma_f32_32x32x16_bf16(kdA[g], vb[bk][s], S[d], 0, 0, 0);
                        OW2(o0, 0, 2 * g);
                        __builtin_amdgcn_sched_barrier(0); }
            {   const int nn = (n + 1 < 128) ? n + 1 : 127;
                const unsigned char* up = rec0 + (size_t)nn * rstep + R_U + wave * 4096 + lane * 32;
                Uc[0] = *(const u32x4*)(up); Uc[1] = *(const u32x4*)(up + 16); Uc[2] = *(const u32x4*)(up + 2048); Uc[3] = *(const u32x4*)(up + 2048 + 16);
                glc = *(const float*)(rec0 + (size_t)nn * rstep + R_GL); }
            __builtin_amdgcn_sched_barrier(0);
#pragma unroll
            for (int d = 2; d < 4; ++d)
#pragma unroll
                for (int bk = 0; bk < 2; ++bk)
#pragma unroll
                    for (int s = 0; s < 2; ++s) { const int g = ((d - 2) * 2 + bk) * 2 + s;
                        S[d] = __builtin_amdgcn_mfma_f32_32x32x16_bf16(kdB[g], vb[bk][s], S[d], 0, 0, 0);
                        OW2(o1, 32, 2 * g);
                        __builtin_amdgcn_sched_barrier(0); }
#undef OW2
        } else {
            const int m = n - 1; const int tt = tid - 256, row = tt >> 2, qd = tt & 3;
            const size_t t = (size_t)b * SEQ + (m < 0 ? 0 : m) * 64 + row;
            u32x4 zv0, zv1, zv2, zv3;
            { const bf16_t* zp = P + t * PP + C_GZ + h * 128 + qd * 32;
              asm volatile("global_load_dwordx4 %0, %4, off\n\tglobal_load_dwordx4 %1, %4, off offset:16\n\tglobal_load_dwordx4 %2, %4, off offset:32\n\tglobal_load_dwordx4 %3, %4, off offset:48"
                           : "=&v"(zv0), "=&v"(zv1), "=&v"(zv2), "=&v"(zv3) : "v"(zp) : "memory"); }
            { const int nn = (n + 1 < 128) ? n + 1 : 127; const unsigned char* src = rec0 + (size_t)nn * rstep; const int lw = wave - 4; const int obn = (nn & 1) ? S_OP1 : S_OP0;
#pragma unroll
              for (int j = 8; j < 14; ++j) { const int k = lw + 4 * j;
                  if (k < 54) __builtin_amdgcn_global_load_lds((const unsigned*)(src + k * 1024 + lane * 16), (LAS unsigned*)(L + obn + k * 1024), 16, 0, 0);
                  else __builtin_amdgcn_global_load_lds((const unsigned*)(src + lane * 16), (LAS unsigned*)(L + 147456 + (lw & 1) * 1024), 16, 0, 0); } }
            if (n >= 2) asm volatile("s_waitcnt vmcnt(22)" ::: "memory"); else asm volatile("s_waitcnt vmcnt(18)" ::: "memory");
            __builtin_amdgcn_s_barrier();
            { const int nn = (n + 2 < 128) ? n + 2 : 127; const unsigned char* src = rec0 + (size_t)nn * rstep; const int lw = wave - 4; const int obn = (n & 1) ? S_OP1 : S_OP0;
#pragma unroll
              for (int j = 0; j < 8; ++j) { const int k = lw + 4 * j;
                  __builtin_amdgcn_global_load_lds((const unsigned*)(src + k * 1024 + lane * 16), (LAS unsigned*)(L + obn + k * 1024), 16, 0, 0); } }
            asm volatile("s_waitcnt vmcnt(14)" : "+v"(zv0), "+v"(zv1), "+v"(zv2), "+v"(zv3) :: "memory");
            const u32x4 zv[4] = {zv0, zv1, zv2, zv3};
            if (n >= 1) {
                const LAS unsigned char* ob = L + ((m & 1) ? S_OB1 : S_OB0) + row * PQ + qd * 64;
                float v[32], z[32]; float ssq = 0.f;
#pragma unroll
                for (int k = 0; k < 4; ++k) {
                    const u32x4 o4 = *(const LAS u32x4*)(ob + k * 16);
                    const unsigned ow[4] = {o4.x, o4.y, o4.z, o4.w}, zw[4] = {zv[k].x, zv[k].y, zv[k].z, zv[k].w};
#pragma unroll
                    for (int i = 0; i < 4; ++i) { v[k * 8 + 2 * i] = bflo(ow[i]); v[k * 8 + 2 * i + 1] = bfhi(ow[i]); z[k * 8 + 2 * i] = bflo(zw[i]); z[k * 8 + 2 * i + 1] = bfhi(zw[i]); }
                }
#pragma unroll
                for (int i = 0; i < 32; ++i) ssq += v[i] * v[i];
                ssq += __shfl_xor(ssq, 1); ssq += __shfl_xor(ssq, 2);
                const float rs = __builtin_amdgcn_rsqf(ssq * (1.0f / 128) + EPS);
#pragma unroll
                for (int k = 0; k < 4; ++k) {
                    float o[8];
#pragma unroll
                    for (int i = 0; i < 8; ++i) o[i] = v[k * 8 + i] * rs * ogl[qd * 32 + k * 8 + i] * z[k * 8 + i];
                    *(u32x4*)(P + t * PP + h * 128 + qd * 32 + k * 8) = pack8(o);
                }
            }
            if (n >= 2) asm volatile("s_waitcnt vmcnt(26)" ::: "memory"); else asm volatile("s_waitcnt vmcnt(22)" ::: "memory");
            if (wave == 4 && n + 3 < 128 && ((n + 3) & 31) == 8) ensure(n + 3, (n + 3 + 32 <= 128) ? 32 : 128 - (n + 3));
        }
        asm volatile("s_waitcnt lgkmcnt(0)" ::: "memory"); __builtin_amdgcn_s_barrier(); asm volatile("" ::: "memory");
    }
    asm volatile("s_waitcnt vmcnt(0)" ::: "memory");
    if (tid == 0) __hip_atomic_store(prog, 1000u, __ATOMIC_RELAXED, __HIP_MEMORY_SCOPE_AGENT);
    if (wave >= 4) {
        const int m = 127; const int tt = tid - 256, row = tt >> 2, qd = tt & 3;
        const LAS unsigned char* ob = L + ((m & 1) ? S_OB1 : S_OB0) + row * PQ + qd * 64;
        const size_t t = (size_t)b * SEQ + m * 64 + row;
        float ssq = 0.f; float v[32], z[32];
#pragma unroll
        for (int k = 0; k < 4; ++k) {
            const u32x4 o4 = *(const LAS u32x4*)(ob + k * 16), z4 = *(const u32x4*)(P + t * PP + C_GZ + h * 128 + qd * 32 + k * 8);
            const unsigned ow[4] = {o4.x, o4.y, o4.z, o4.w}, zw[4] = {z4.x, z4.y, z4.z, z4.w};
#pragma unroll
            for (int i = 0; i < 4; ++i) { v[k * 8 + 2 * i] = bflo(ow[i]); v[k * 8 + 2 * i + 1] = bfhi(ow[i]); z[k * 8 + 2 * i] = bflo(zw[i]); z[k * 8 + 2 * i + 1] = bfhi(zw[i]); }
        }
#pragma unroll
        for (int i = 0; i < 32; ++i) ssq += v[i] * v[i];
        ssq += __shfl_xor(ssq, 1); ssq += __shfl_xor(ssq, 2);
        const float rs = __builtin_amdgcn_rsqf(ssq * (1.0f / 128) + EPS);
#pragma unroll
        for (int k = 0; k < 4; ++k) {
            float o[8];
#pragma unroll
            for (int i = 0; i < 8; ++i) o[i] = v[k * 8 + i] * rs * ogl[qd * 32 + k * 8 + i] * z[k * 8 + i];
            *(u32x4*)(P + t * PP + h * 128 + qd * 32 + k * 8) = pack8(o);
        }
    }
}


__device__ __forceinline__ void scan_helper(Frame& F, int i, int part) {
    LAS unsigned char* L = F.lds; const int lane = F.lane, wave = F.wave;
#if HELP2
    const int tid = F.tid & 255; constexpr int HSTRIDE = 256; i += 8 * (wave >> 2);
#else
    const int tid = F.tid; constexpr int HSTRIDE = NTHREADS;
#endif
    const int b = i >> 2, h = i & 3;
    const unsigned char* rec0 = F.ws + WS_G + ((size_t)(b * 128) * 4 + h) * GREC; const size_t rstep = (size_t)4 * GREC;
    const bf16_t* P = (const bf16_t*)(F.ws + WS_C);
    unsigned* prog = (unsigned*)(F.ws + WS_CTL) + CW_PROG + 64 * i;
    constexpr int LA = 8;
    for (int n = 1; n < 128; ++n) {
        unsigned spins = 0;
        for (;;) {
            const unsigned p = __builtin_amdgcn_readfirstlane(__hip_atomic_load(prog, __ATOMIC_RELAXED, __HIP_MEMORY_SCOPE_AGENT));
            const unsigned f = __builtin_amdgcn_readfirstlane(__hip_atomic_load((unsigned*)(F.ws + WS_CTL) + CW_FLG + ((size_t)(b * 128 + n) * 4 + h), __ATOMIC_RELAXED, __HIP_MEMORY_SCOPE_AGENT));
            if ((int)p + LA >= n && f != 0u) break;
            __builtin_amdgcn_s_sleep(8);
            if (++spins > 20000u) break;
        }
        constexpr int NL = 576 / NHELP;
        for (int line = tid; line < NL + (part == 0 ? 128 : 0); line += HSTRIDE) {
        if (line < NL) __builtin_amdgcn_global_load_lds((const unsigned*)(rec0 + (size_t)n * rstep + part * (NL * 128) + line * 128), (LAS unsigned*)(L + wave * 256), 4, 0, 0);
        else { const int zl = line - NL; const int row = zl >> 1, hf = zl & 1;
            __builtin_amdgcn_global_load_lds((const unsigned*)(P + ((size_t)b * SEQ + n * 64 + row) * PP + C_GZ + h * 128 + hf * 64), (LAS unsigned*)(L + wave * 256), 4, 0, 0); }
        }
        asm volatile("s_waitcnt vmcnt(4)" ::: "memory");
    }
    asm volatile("s_waitcnt vmcnt(0)" ::: "memory");
}

constexpr size_t WS_IMG = 460 * MiB;
constexpr size_t WS_IMGM = 492 * MiB;
constexpr int CW_QUEUE = 8192;
constexpr float LOG2E = 1.4426950408889634f;

__device__ __forceinline__ void img_item(Frame& F, const Args& A, int item) {
    LAS unsigned char* L = F.lds; int tid = F.tid; asm volatile("" : "+v"(tid));
    const bool mem = item >= 512; const int bh = mem ? item - 512 : item >> 5, j = item & 31, b = bh >> 2, h = bh & 3;
    unsigned char* img = F.ws + (mem ? WS_IMGM + (size_t)bh * 65536 : WS_IMG + ((size_t)bh * 32 + j) * 65536);
    const int key = tid >> 1, half = tid & 1;
    LAS unsigned* TK = (LAS unsigned*)L;
    LAS unsigned* TV = TK + 256 * 33;
    LAS float* part = (LAS float*)(TV + 256 * 33);
    float kv[32], vv[32];
    if (!mem) {
        const bf16_t* P = (const bf16_t*)(F.ws + WS_C); const size_t t = (size_t)b * SEQ + j * 256 + key;
#pragma unroll
        for (int c4 = 0; c4 < 4; ++c4) {
            const u32x4 kw = *(const u32x4*)(P + t * PP + C_MK + h * 64 + half * 32 + c4 * 8), vw = *(const u32x4*)(P + t * PP + C_MV + h * 64 + half * 32 + c4 * 8);
            const unsigned ka[4] = {kw.x, kw.y, kw.z, kw.w}, va[4] = {vw.x, vw.y, vw.z, vw.w};
#pragma unroll
            for (int i = 0; i < 4; ++i) { kv[c4 * 8 + 2 * i] = bflo(ka[i]); kv[c4 * 8 + 2 * i + 1] = bfhi(ka[i]); vv[c4 * 8 + 2 * i] = bflo(va[i]); vv[c4 * 8 + 2 * i + 1] = bfhi(va[i]); }
        }
    } else {
        const float* KV = (const float*)(F.ws + WS_KVMEM) + ((size_t)b * MEMT + key) * 512 + h * 64 + half * 32;
#pragma unroll
        for (int c4 = 0; c4 < 8; ++c4) { const f32x4 kw = *(const f32x4*)(KV + c4 * 4), vw = *(const f32x4*)(KV + 256 + c4 * 4);
#pragma unroll
            for (int i = 0; i < 4; ++i) { kv[c4 * 4 + i] = kw[i]; vv[c4 * 4 + i] = vw[i]; } }
    }
    float ss = 0.f;
#pragma unroll
    for (int i = 0; i < 32; ++i) ss += kv[i] * kv[i];
    ss += __shfl_xor(ss, 1);
    const float rs = __builtin_amdgcn_rsqf(ss * (1.0f / 64) + EPS);
    const float* kg = (mem ? A.in[17] : A.in[13]) + half * 32;
    unsigned kp[16], vp[16];
#pragma unroll
    for (int i = 0; i < 16; ++i) { kp[i] = cvtpk(kv[2 * i] * rs * kg[2 * i], kv[2 * i + 1] * rs * kg[2 * i + 1]); vp[i] = cvtpk(vv[2 * i], vv[2 * i + 1]); }
#pragma unroll
    for (int i = 0; i < 16; ++i) { TK[key * 33 + half * 16 + i] = kp[i]; TV[key * 33 + half * 16 + i] = vp[i]; }
#pragma unroll
    for (int cc = 0; cc < 4; ++cc) { const int ch = half * 4 + cc; u32x4 w; w.x = kp[cc * 4]; w.y = kp[cc * 4 + 1]; w.z = kp[cc * 4 + 2]; w.w = kp[cc * 4 + 3];
        *(u32x4*)(img + key * 128 + ((ch ^ ((key >> 1) & 7)) * 16)) = w; }
    __syncthreads();
    const LAS unsigned short* TKh = (const LAS unsigned short*)TK; const LAS unsigned short* TVh = (const LAS unsigned short*)TV;
    if (!mem) { const int d = tid & 63, kq = tid >> 6; float a = 0.f;
#pragma unroll 8
        for (int k = 0; k < 32; ++k) a += bf2f(TKh[(kq * 32 + k) * 66 + d]);
        part[kq * 64 + d] = a; }
    {
        const int d = tid >> 3, pt = tid & 7;
#pragma unroll
        for (int cc = 0; cc < 4; ++cc) { const int ch = pt * 4 + cc; unsigned short e[8];
#pragma unroll
            for (int x = 0; x < 8; ++x) { const int pos = ch * 8 + x, kt = pos >> 5, p5 = pos & 31; const int kap = (p5 & 16) | ((p5 & 4) << 1) | ((p5 & 8) >> 1) | (p5 & 3);
                e[x] = TVh[(kt * 32 + kap) * 66 + d]; }
            u32x4 w; w.x = e[0] | ((unsigned)e[1] << 16); w.y = e[2] | ((unsigned)e[3] << 16); w.z = e[4] | ((unsigned)e[5] << 16); w.w = e[6] | ((unsigned)e[7] << 16);
            *(u32x4*)(img + 32768 + d * 512 + ((ch ^ (d & 15)) * 16)) = w; }
    }
    __syncthreads();
    if (!mem && tid < 64) { float a = 0.f;
#pragma unroll
        for (int k = 0; k < 8; ++k) a += part[k * 64 + tid];
        ((float*)(F.ws + WS_KMEAN))[((size_t)bh * 32 + j) * 64 + tid] = a * (1.0f / 256); }
    __syncthreads();
}

__device__ __forceinline__ void attn_item(Frame& F, const Args& A, const int kind, const int bh, const int c) {
    LAS unsigned char* L = F.lds; int tid = F.tid; asm volatile("" : "+v"(tid)); const int lane = tid & 63, wave = F.wave;
    const int b = bh >> 2, h = bh & 3, r = lane & 31, hh = lane >> 5;
    bf16_t* P = (bf16_t*)(F.ws + WS_C);
    const unsigned char* img0 = F.ws + (kind ? WS_IMGM + (size_t)bh * 65536 : WS_IMG + (size_t)bh * 32 * 65536);
    const int nb = kind ? 1 : c + 1, nst = 2 * nb;
    auto stage = [&](int st) {
        const unsigned char* src = img0 + (size_t)(st >> 1) * 65536; const int hf = st & 1; LAS unsigned char* dst = L + (st & 3) * 32768;
#pragma unroll
        for (int k = 0; k < 4; ++k) { const int p = wave * 4 + k;
            if (p < 16) __builtin_amdgcn_global_load_lds((const unsigned*)(src + hf * 16384 + p * 1024 + lane * 16), (LAS unsigned*)(dst + p * 1024), 16, 0, 0);
            else { const int pp = p - 16;
                __builtin_amdgcn_global_load_lds((const unsigned*)(src + 32768 + (4 * pp + (lane >> 4)) * 512 + hf * 256 + (lane & 15) * 16), (LAS unsigned*)(dst + 16384 + pp * 1024), 16, 0, 0); } }
    };
    LAS float* KM = (LAS float*)(L + 131072);
    if (!kind) { const float* kmg = (const float*)(F.ws + WS_KMEAN) + (size_t)bh * 32 * 64; for (int i = tid; i < c * 64; i += NTHREADS) KM[i] = kmg[i]; }
    const int qloc = 32 * wave + r, qpos = c * 256 + qloc; const size_t t = (size_t)b * SEQ + qpos;
    const bf16_t* qp = P + t * PP + (kind ? C_CQ : C_MQ) + h * 64;
    const float* qgain = kind ? A.in[16] : A.in[12]; const float* kgain = kind ? A.in[17] : A.in[13];
    const float mq = wave_max(fabsf(qgain[lane])), mk = wave_max(fabsf(kgain[lane]));
    const float M2 = (8.0f * mq * mk * 1.02f + 0.05f) * LOG2E;
    const float slope2 = kind ? 0.f : exp2f(-2.0f * (float)(h + 1)) * LOG2E;
    float qg[32];
    {
#pragma unroll
        for (int c4 = 0; c4 < 4; ++c4) { const u32x4 w = *(const u32x4*)(qp + hh * 32 + c4 * 8); const unsigned wa[4] = {w.x, w.y, w.z, w.w};
#pragma unroll
            for (int i = 0; i < 4; ++i) { qg[c4 * 8 + 2 * i] = bflo(wa[i]); qg[c4 * 8 + 2 * i + 1] = bfhi(wa[i]); } }
    }
    float ss = 0.f;
#pragma unroll
    for (int i = 0; i < 32; ++i) ss += qg[i] * qg[i];
    ss += __shfl_xor(ss, 32);
    const float rs = __builtin_amdgcn_rsqf(ss * (1.0f / 64) + EPS);
    bf16x8 Qf[4];
#pragma unroll
    for (int s = 0; s < 4; ++s) { const int d0 = 16 * s + 8 * hh; const u32x4 w = *(const u32x4*)(qp + d0); const unsigned wa[4] = {w.x, w.y, w.z, w.w}; const float sc = rs * (0.125f * LOG2E);
        float v[8];
#pragma unroll
        for (int i = 0; i < 4; ++i) { v[2 * i] = bflo(wa[i]) * sc * qgain[d0 + 2 * i]; v[2 * i + 1] = bfhi(wa[i]) * sc * qgain[d0 + 2 * i + 1]; }
        Qf[s] = __builtin_bit_cast(bf16x8, pack8(v)); }
    unsigned selmask = 0u;
    if (!kind) {
#pragma unroll
        for (int i = 0; i < 32; ++i) qg[i] *= rs * qgain[hh * 32 + i];
    }
    asm volatile("s_waitcnt vmcnt(0)" : "+v"(qg[0]), "+v"(qg[31]) :: "memory");
    __syncthreads();
    stage(0); stage(1); if (nst > 2) stage(2);
    if (!kind && c > 0) {
        float v0 = -INFINITY, v1 = -INFINITY, v2 = -INFINITY; int i0 = -1, i1 = -1, i2 = -1;
        for (int j = 0; j < c; ++j) {
            const LAS f32x4* km = (const LAS f32x4*)(KM + j * 64 + hh * 32);
            float g = 0.f;
#pragma unroll
            for (int k = 0; k < 8; ++k) { const f32x4 m4 = km[k]; g += qg[4 * k] * m4[0] + qg[4 * k + 1] * m4[1] + qg[4 * k + 2] * m4[2] + qg[4 * k + 3] * m4[3]; }
            g += __shfl_xor(g, 32);
            if (g > v0) { v2 = v1; i2 = i1; v1 = v0; i1 = i0; v0 = g; i0 = j; }
            else if (g > v1) { v2 = v1; i2 = i1; v1 = g; i1 = j; }
            else if (g > v2) { v2 = g; i2 = j; }
        }
        if (i0 >= 0) selmask |= 1u << i0; if (i1 >= 0) selmask |= 1u << i1; if (i2 >= 0) selmask |= 1u << i2;
    }
    unsigned chs[4];
#pragma unroll
    for (int s = 0; s < 4; ++s) chs[s] = (unsigned)(r * 128 + (((2 * s + hh) ^ ((r >> 1) & 7)) * 16));
    const float lo4 = slope2 * (float)(4 * hh);
    f32x16 O0, O1;
#pragma unroll
    for (int i = 0; i < 16; ++i) { O0[i] = 0.f; O1[i] = 0.f; }
    float lsum = 0.f;
    for (int st = 0; st < nst; ++st) {
        const int younger = (nst - 1 - st) < 2 ? (nst - 1 - st) : 2;
        if (younger == 2) asm volatile("s_waitcnt vmcnt(8)" ::: "memory"); else if (younger == 1) asm volatile("s_waitcnt vmcnt(4)" ::: "memory"); else asm volatile("s_waitcnt vmcnt(0)" ::: "memory");
        asm volatile("s_waitcnt lgkmcnt(0)" ::: "memory"); __builtin_amdgcn_s_barrier(); asm volatile("" ::: "memory");
        if (st + 3 < nst) stage(st + 3);
        const int i = st >> 1, hf = st & 1;
        const bool own = (!kind) && (i == c);
        bool sel = true; if (!kind && !own) sel = (selmask >> i) & 1u;
        if (__ballot(sel) == 0ull) continue;
        const float laneoff = sel ? (slope2 * (float)(256 * i - qpos) - M2) : -INFINITY;
        const int ktmax = own ? wave : 7;
        const LAS unsigned char* kb = L + (st & 3) * 32768; const LAS unsigned char* vb = kb + 16384 + r * 256;
        const int nkt = (ktmax - 4 * hf + 1) < 4 ? (ktmax - 4 * hf + 1) : 4;
        if (nkt <= 0) continue;
        bf16x8 kf[4];
#pragma unroll
        for (int s = 0; s < 4; ++s) kf[s] = *(const LAS bf16x8*)(kb + chs[s]);
#pragma unroll 1
        for (int ktl = 0; ktl < nkt; ++ktl) {
            const int kt = 4 * hf + ktl;
            f32x16 C; const float lo = laneoff + slope2 * (float)(32 * kt) + lo4;
#pragma unroll
            for (int x = 0; x < 16; ++x) C[x] = slope2 * (float)((x & 3) + 8 * (x >> 2)) + lo;
#pragma unroll
            for (int s = 0; s < 4; ++s) C = __builtin_amdgcn_mfma_f32_32x32x16_bf16(kf[s], Qf[s], C, 0, 0, 0);
            const unsigned c0 = (unsigned)(((4 * ktl + hh) ^ (r & 15)) * 16), c1 = (unsigned)(((4 * ktl + 2 + hh) ^ (r & 15)) * 16);
            const bf16x8 vf0 = *(const LAS bf16x8*)(vb + c0), vf1 = *(const LAS bf16x8*)(vb + 32 * 256 + c0);
            const bf16x8 vf2 = *(const LAS bf16x8*)(vb + c1), vf3 = *(const LAS bf16x8*)(vb + 32 * 256 + c1);
            const int kn = (ktl + 1 < nkt) ? ktl + 1 : ktl;
#pragma unroll
            for (int s = 0; s < 4; ++s) kf[s] = *(const LAS bf16x8*)(kb + kn * 4096 + chs[s]);
            __builtin_amdgcn_sched_barrier(0);
            if (own && kt == wave) {
#pragma unroll
                for (int x = 0; x < 16; ++x) if ((x & 3) + 8 * (x >> 2) + 4 * hh > r) C[x] = -INFINITY;
            }
#pragma unroll
            for (int x = 0; x < 16; ++x) C[x] = __builtin_amdgcn_exp2f(C[x]);
            const float ps = (((C[0] + C[1]) + (C[2] + C[3])) + ((C[4] + C[5]) + (C[6] + C[7]))) + (((C[8] + C[9]) + (C[10] + C[11])) + ((C[12] + C[13]) + (C[14] + C[15])));
            lsum += ps;
            const bf16x8 p0 = cvt8(C, 0), p1 = cvt8(C, 1);
            O0 = __builtin_amdgcn_mfma_f32_32x32x16_bf16(vf0, p0, O0, 0, 0, 0);
            O1 = __builtin_amdgcn_mfma_f32_32x32x16_bf16(vf1, p0, O1, 0, 0, 0);
            O0 = __builtin_amdgcn_mfma_f32_32x32x16_bf16(vf2, p1, O0, 0, 0, 0);
            O1 = __builtin_amdgcn_mfma_f32_32x32x16_bf16(vf3, p1, O1, 0, 0, 0);
        }
    }
    lsum += __shfl_xor(lsum, 32);
    const float inv = 1.0f / lsum;
    bf16_t* yp = P + t * PP + (kind ? 768 : 512) + h * 64 + 4 * hh;
#pragma unroll
    for (int g = 0; g < 4; ++g) {
        u32x2 w0, w1; w0.x = cvtpk(O0[4 * g] * inv, O0[4 * g + 1] * inv); w0.y = cvtpk(O0[4 * g + 2] * inv, O0[4 * g + 3] * inv);
        w1.x = cvtpk(O1[4 * g] * inv, O1[4 * g + 1] * inv); w1.y = cvtpk(O1[4 * g + 2] * inv, O1[4 * g + 3] * inv);
        *(u32x2*)(yp + 8 * g) = w0; *(u32x2*)(yp + 32 + 8 * g) = w1;
    }
}

__device__ __forceinline__ void p4b_attn(Frame& F, const Args& A, int pass) {
    LAS unsigned* qw = (LAS unsigned*)(F.lds + 140000);
    unsigned* heads = (unsigned*)(F.ws + WS_CTL) + CW_QUEUE + 1024 * pass;
    const int myq = (int)(xb_xcc_id() & 7u);
    for (int qi = 0; qi < 8; ++qi) {
        const int q = (myq + qi) & 7;
        for (;;) {
            __syncthreads();
            if (F.tid == 0) *qw = atomicAdd(heads + 64 * q, 1u);
            __syncthreads();
            const int idx = (int)*qw;
            if (idx >= 128) break;
            const int bh = 2 * q + (idx & 1);
            if (idx < 64) attn_item(F, A, 0, bh, 31 - (idx >> 1));
            else attn_item(F, A, 1, bh, (idx - 64) >> 1);
        }
    }
}

__device__ __forceinline__ void naive_gdn(Frame& F, const Args& A, int b, int h) {
    unsigned char* ws = F.ws;
    LAS float* vec = (LAS float*)F.lds;
    LAS float* ba = vec + 32 * 384;
    LAS float* part = ba + 64;
    LAS float* part2 = part + 512;
    LAS float* obuf = part2 + 512;
    const int tid = F.tid, e = tid & 127, dq = tid >> 7;
    const bf16_t* GQ = (const bf16_t*)(ws + WS_GQ); const bf16_t* GK = (const bf16_t*)(ws + WS_GK); const bf16_t* GV = (const bf16_t*)(ws + WS_GV);
    const float* GB = (const float*)(ws + WS_GB); const float* GG = (const float*)(ws + WS_GG);
    bf16_t* P = (bf16_t*)(ws + WS_C);
    const float* og = A.in[11];
    float S[32];
#pragma unroll
    for (int i = 0; i < 32; ++i) S[i] = 0.f;
    for (int c0 = 0; c0 < SEQ; c0 += 32) {
        __syncthreads();
        for (int i = tid; i < 32 * 384; i += NTHREADS) { const int tk = i / 384, r = i % 384; const size_t t = (size_t)b * SEQ + c0 + tk;
            const bf16_t* src = (r < 128) ? GQ : (r < 256) ? GK : GV;
            vec[i] = bf2f(src[t * 512 + h * 128 + (r & 127)]); }
        if (tid < 32) { const size_t t = (size_t)b * SEQ + c0 + tid; ba[tid * 2] = GB[t * 4 + h]; ba[tid * 2 + 1] = __expf(GG[t * 4 + h]); }
        __syncthreads();
        for (int tk = 0; tk < 32; ++tk) {
            const LAS float* qq = vec + tk * 384 + 32 * dq; const LAS float* kk = qq + 128; const float vv = vec[tk * 384 + 256 + e];
            const float beta = ba[tk * 2], alpha = ba[tk * 2 + 1];
            float p = 0.f;
#pragma unroll
            for (int i = 0; i < 32; ++i) p += S[i] * kk[i];
            part[dq * 128 + e] = p;
            __syncthreads();
            const float Sk = (part[e] + part[128 + e]) + (part[256 + e] + part[384 + e]);
            const float vn = beta * (vv - alpha * Sk);
            float po = 0.f;
#pragma unroll
            for (int i = 0; i < 32; ++i) { S[i] = alpha * S[i] + kk[i] * vn; po += S[i] * qq[i]; }
            part2[dq * 128 + e] = po;
            __syncthreads();
            if (dq == 0) obuf[tk * 128 + e] = (part2[e] + part2[128 + e]) + (part2[256 + e] + part2[384 + e]);
        }
        __syncthreads();
        { const int r = tid >> 4, cb = (tid & 15) * 8; const size_t t = (size_t)b * SEQ + c0 + r;
            float v[8]; float s = 0.f;
#pragma unroll
            for (int i = 0; i < 8; ++i) { v[i] = obuf[r * 128 + cb + i]; s += v[i] * v[i]; }
#pragma unroll
            for (int o = 1; o < 16; o <<= 1) s += __shfl_xor(s, o);
            const float rs = __builtin_amdgcn_rsqf(s * (1.0f / 128) + EPS);
            const u32x4 zw = *(const u32x4*)(P + t * PP + C_GZ + h * 128 + cb);
            float z[8] = {bflo(zw.x), bfhi(zw.x), bflo(zw.y), bfhi(zw.y), bflo(zw.z), bfhi(zw.z), bflo(zw.w), bfhi(zw.w)};
            float o[8];
#pragma unroll
            for (int i = 0; i < 8; ++i) o[i] = v[i] * rs * og[cb + i] * z[i];
            u32x4 w; w.x = pk2(o[0], o[1]); w.y = pk2(o[2], o[3]); w.z = pk2(o[4], o[5]); w.w = pk2(o[6], o[7]);
            *(u32x4*)(P + t * PP + h * 128 + cb) = w; }
    }
}

__device__ __forceinline__ void naive_moba_query(Frame& F, const Args& A, int t, int h, LAS float* sc, LAS float* qs) {
    unsigned char* ws = F.ws; const int lane = F.lane;
    bf16_t* P = (bf16_t*)(ws + WS_C);
    const bf16_t* KNM = (const bf16_t*)(ws + WS_KNM); const float* KM = (const float*)(ws + WS_KMEAN);
    const int b = t >> 13, tl = t & (SEQ - 1), own = tl >> 8, bh = b * 4 + h;
    const float qraw = bf2f(P[(size_t)t * PP + C_MQ + h * 64 + lane]);
    const float qh = qraw * __builtin_amdgcn_rsqf(wave_sum(qraw * qraw) * (1.0f / 64) + EPS) * A.in[12][lane];
    qs[lane] = qh;
    float mygate = -INFINITY;
    for (int j = 0; j < own; ++j) { const float g = wave_sum(qh * KM[((size_t)bh * 32 + j) * 64 + lane]); if (lane == j) mygate = g; }
    const int nsel = own < 3 ? own : 3;
    int sel0 = 0, sel1 = 0, sel2 = 0;
#pragma unroll
    for (int r = 0; r < 3; ++r) {
        if (r < nsel) {
            const float mx = wave_max(mygate);
            const unsigned long long bal = __ballot(mygate == mx);
            const int idx = __builtin_ctzll(bal);
            if (r == 0) sel0 = idx; else if (r == 1) sel1 = idx; else sel2 = idx;
            if (lane == idx) mygate = -INFINITY;
        }
    }
#define SELBLK(bi) (((bi) >= nsel) ? own : ((bi) == 0 ? sel0 : ((bi) == 1 ? sel1 : sel2)))
    const float slope = exp2f(-2.0f * (float)(h + 1));
    asm volatile("s_waitcnt lgkmcnt(0)" ::: "memory");
    float m = -INFINITY;
    const int nblk = nsel + 1;
    for (int bi = 0; bi < nblk; ++bi) {
        const int blk = SELBLK(bi);
        for (int kc = 0; kc < 4; ++kc) {
            const int key = blk * 256 + kc * 64 + lane;
            const u32x4* kp = (const u32x4*)(KNM + ((size_t)bh * SEQ + key) * 64);
            float dot = 0.f;
#pragma unroll
            for (int c = 0; c < 8; ++c) { const u32x4 w = kp[c];
                dot += qs[c * 8 + 0] * bflo(w.x) + qs[c * 8 + 1] * bfhi(w.x) + qs[c * 8 + 2] * bflo(w.y) + qs[c * 8 + 3] * bfhi(w.y)
                     + qs[c * 8 + 4] * bflo(w.z) + qs[c * 8 + 5] * bfhi(w.z) + qs[c * 8 + 6] * bflo(w.w) + qs[c * 8 + 7] * bfhi(w.w); }
            float s = dot * 0.125f - slope * (float)(tl - key);
            if (key > tl) s = -INFINITY;
            sc[bi * 256 + kc * 64 + lane] = s; m = fmaxf(m, s);
        }
    }
    m = wave_max(m);
    float l = 0.f;
    for (int i = lane; i < nblk * 256; i += 64) { const float p = __expf(sc[i] - m); sc[i] = p; l += p; }
    l = wave_sum(l);
    asm volatile("s_waitcnt lgkmcnt(0)" ::: "memory");
    float o = 0.f;
    for (int bi = 0; bi < nblk; ++bi) {
        const int blk = SELBLK(bi);
        const bf16_t* vp = P + ((size_t)b * SEQ + blk * 256) * PP + C_MV + h * 64 + lane;
#pragma unroll 8
        for (int k = 0; k < 256; ++k) o += sc[bi * 256 + k] * bf2f(vp[(size_t)k * PP]);
    }
    P[(size_t)t * PP + 512 + h * 64 + lane] = (bf16_t)f2bf(o / l);
}
__device__ __forceinline__ void naive_mem_query(Frame& F, const Args& A, int t, int h, LAS float* sc, LAS float* qs) {
    unsigned char* ws = F.ws; const int lane = F.lane;
    bf16_t* P = (bf16_t*)(ws + WS_C);
    const float* KV = (const float*)(ws + WS_KVMEM);
    const int b = t >> 13;
    const float qraw = bf2f(P[(size_t)t * PP + C_CQ + h * 64 + lane]);
    const float qh = qraw * __builtin_amdgcn_rsqf(wave_sum(qraw * qraw) * (1.0f / 64) + EPS) * A.in[16][lane];
    qs[lane] = qh;
    const float* kg = A.in[17];
    asm volatile("s_waitcnt lgkmcnt(0)" ::: "memory");
    float m = -INFINITY;
    for (int kc = 0; kc < 4; ++kc) {
        const int key = kc * 64 + lane;
        const f32x4* kp = (const f32x4*)(KV + ((size_t)b * MEMT + key) * 512 + h * 64);
        float dot = 0.f, s2 = 0.f;
#pragma unroll
        for (int c = 0; c < 16; ++c) { const f32x4 w = kp[c];
            dot += qs[c * 4 + 0] * w[0] * kg[c * 4 + 0] + qs[c * 4 + 1] * w[1] * kg[c * 4 + 1] + qs[c * 4 + 2] * w[2] * kg[c * 4 + 2] + qs[c * 4 + 3] * w[3] * kg[c * 4 + 3];
            s2 += (w[0] * w[0] + w[1] * w[1]) + (w[2] * w[2] + w[3] * w[3]); }
        const float s = dot * __builtin_amdgcn_rsqf(s2 * (1.0f / 64) + EPS) * 0.125f;
        sc[key] = s; m = fmaxf(m, s);
    }
    m = wave_max(m);
    float l = 0.f;
    for (int i = lane; i < 256; i += 64) { const float p = __expf(sc[i] - m); sc[i] = p; l += p; }
    l = wave_sum(l);
    asm volatile("s_waitcnt lgkmcnt(0)" ::: "memory");
    float o = 0.f;
    const float* vp = KV + (size_t)b * MEMT * 512 + 256 + h * 64 + lane;
#pragma unroll 8
    for (int k = 0; k < 256; ++k) o += sc[k] * vp[(size_t)k * 512];
    P[(size_t)t * PP + 768 + h * 64 + lane] = (bf16_t)f2bf(o / l);
}

__device__ __forceinline__ void p4b_naive(Frame& F, const Args& A, int pass) {
    const int bx = blockIdx.x;
#if GDN_NAIVE
    if (bx < 16) { naive_gdn(F, A, bx >> 2, bx & 3); return; }
#else
    if (bx < 16 && !(PROBE_DUP == 51 && pass == 1)) { gdn_scan(F, A, bx >> 2, bx & 3); }
#if HELP2
    else if (bx < 24 && !(PROBE_DUP == 51 && pass == 1)) { scan_helper(F, bx - 16, 0); }
#else
    else if (bx < 16 + 16 * NHELP && !(PROBE_DUP == 51 && pass == 1)) { scan_helper(F, (bx - 16) & 15, (bx - 16) >> 4); }
#endif
#endif
#if !GDN_NAIVE
    if (!(PROBE_DUP == 51 && pass == 1)) {
        LAS unsigned* qw = (LAS unsigned*)(F.lds + 140000);
        unsigned* head = (unsigned*)(F.ws + WS_CTL) + CW_PQ;
        u32x4 praw[11]; float pa = 0.f, pb = 0.f; int cw_head = -1, pend = -1;
#define PREP_ITEM(q_) ((((q_) & 15) >> 2) * 128 + ((q_) >> 4)) * 4 + ((q_) & 3)
        const int npre = (F.G > 16) ? ((F.G - 16 < N_PREP) ? F.G - 16 : N_PREP) : 0;
        __syncthreads(); if (F.tid == 0) *qw = atomicAdd(head, 1u); __syncthreads();
        int cur = npre + __builtin_amdgcn_readfirstlane((int)*qw);
        if (cur < N_PREP) gdn_prep_fetch(F, PREP_ITEM(cur), praw, pa, pb);
        while (cur < N_PREP) {
            __syncthreads(); if (F.tid == 0) *qw = atomicAdd(head, 1u); __syncthreads();
            const int nxt = npre + __builtin_amdgcn_readfirstlane((int)*qw);
            gdn_prep_item(F, A, PREP_ITEM(cur), nxt < N_PREP ? PREP_ITEM(nxt) : (1 << 30), praw, pa, pb, cw_head, pend);
            cur = nxt;
        }
        if (pend >= 0) {
            asm volatile("s_waitcnt vmcnt(0)" ::: "memory");
            __syncthreads();
            if (F.tid == 0) __hip_atomic_store((unsigned*)(F.ws + WS_CTL) + CW_FLG + pend, 1u, __ATOMIC_RELAXED, __HIP_MEMORY_SCOPE_AGENT);
        }
#undef PREP_ITEM
    }
#endif
#if !ATTN_NAIVE
    p4b_attn(F, A, (PROBE_DUP == 51) ? pass : 0); return;
#endif
    LAS float* sc = (LAS float*)F.lds + F.wave * 1152;
    LAS float* qs = sc + 1024;
    const int w = bx - 16, NW = F.G - 16;
    const int NQ = T * 4 / 8;
    for (int it = w; it < 2 * NQ; it += NW) {
        const int kind = it >= NQ; const int q = (kind ? it - NQ : it) * 8 + F.wave;
        if (kind) naive_mem_query(F, A, q >> 2, q & 3, sc, qs); else naive_moba_query(F, A, q >> 2, q & 3, sc, qs);
    }
}

__global__ void __launch_bounds__(NTHREADS, 2) mk_fwd(Args args) {
    extern __shared__ __attribute__((aligned(16))) unsigned char lds_raw[];
    Frame F;
    F.lds = (LAS unsigned char*)lds_raw;
    F.tid = threadIdx.x; F.lane = F.tid & 63; F.wave = __builtin_amdgcn_readfirstlane(F.tid >> 6);
    F.G = gridDim.x; { const int bx = blockIdx.x; F.vcu = (F.G % 8 == 0) ? (bx % 8) * (F.G / 8) + bx / 8 : bx; }
    F.out = args.out; F.ws = args.ws;
    unsigned char* ws = args.ws;
    const int lo = args.ph_lo, hi = args.ph_hi;
#define IN(k) (lo <= (k) && (k) < hi)
#if USE_CG_SYNC
#define SEAM(k) do { if (IN(k) && IN((k) + 1)) { cg::this_grid().sync(); } } while (0)
#else
    { volatile LAS unsigned* st = (volatile LAS unsigned*)(F.lds + LDS_ST_OFF); if (F.tid < 4) st[F.tid] = 0u; }
    __syncthreads();
    XcdBarrier bar = xcd_barrier_post((unsigned*)(ws + WS_CTL) + CW_BAR, (volatile LAS unsigned*)(F.lds + LDS_ST_OFF));
#define SEAM(k) do { if (IN(k) && IN((k) + 1)) { xcd_barrier(bar); } } while (0)
#endif
#define PH_BEGIN(k) for (int _r = 0; _r < ((PROBE_DUP == (k) || (PROBE_DUP == 51 && (k) == 5)) ? 2 : 1); ++_r) { if (_r) xcd_barrier(bar);
#define PH_END }
    float* ss = (float*)(ws + WS_SS);
    bf16_t* XB = (bf16_t*)(ws + WS_XB);
    bf16_t* PC = (bf16_t*)(ws + WS_C);

    PH_BEGIN(0) if (IN(0)) { p0_prologue(F, args); }
    PH_END
    SEAM(0);
#if PROBE_DUP == 61
    { pg8::Gemm g{XB, (const bf16_t*)(ws + WS_WGU1), T, NGU, DM, DM}; pg8::StaticOrder S; S.init(T, NGU, F.G, (int)blockIdx.x);
      pg8::EpiNullP E{(float*)(ws + WS_CTL) + 60000}; pg8::gemm_phase<pg8::EpiNullP, true>(F.lds, g, S, E); xcd_barrier(bar); }
#endif
    PH_BEGIN(1) if (IN(1)) {
        pg8::Gemm g{XB, (const bf16_t*)(ws + WS_WGU1), T, NGU, DM, DM}; pg8::StaticOrder S; S.init(T, NGU, F.G, (int)blockIdx.x);
        pg8::EpiSwiGLU E{PC, ss};
        pg8::gemm_phase<pg8::EpiSwiGLU, true>(F.lds, g, S, E, ss);
    }
    PH_END
    SEAM(1);
#if PROBE_DUP == 62
    { pg8::Gemm g{PC, (const bf16_t*)(ws + WS_WD1), T, DM, FF, FF}; pg8::StaticOrder S; S.init(T, DM, F.G, (int)blockIdx.x);
      pg8::EpiNullN E{(float*)(ws + WS_CTL) + 60000}; pg8::gemm_phase<pg8::EpiNullN, true>(F.lds, g, S, E); xcd_barrier(bar); }
#endif
    PH_BEGIN(2) if (IN(2)) {
        pg8::Gemm g{PC, (const bf16_t*)(ws + WS_WD1), T, DM, FF, FF}; pg8::StaticOrder S; S.init(T, DM, F.G, (int)blockIdx.x);
        pg8::EpiResid<1> E{nullptr, F.out, XB, ss, 0.5f};
        pg8::gemm_phase<pg8::EpiResid<1>, true>(F.lds, g, S, E);
    }
    PH_END
    SEAM(2);
    PH_BEGIN(3) if (IN(3)) {
        pg8::Gemm g{XB, (const bf16_t*)(ws + WS_WIN), T, NIN, DM, DM}; pg8::StaticOrder S; S.init(T, NIN, F.G, (int)blockIdx.x);
        pg8::EpiWin E{PC, (float*)(ws + WS_AB), ss};
        pg8::gemm_phase<pg8::EpiWin, true>(F.lds, g, S, E, ss);
        {
            pg8::Gemm g2{(const bf16_t*)(ws + WS_MEMB), (const bf16_t*)(ws + WS_WKV), BATCH * MEMT, 512, DM, DM}; pg8::StaticOrder S2; S2.init(BATCH * MEMT, 512, 8, (int)blockIdx.x - (F.G - 8));
            pg8::EpiKV E2{(float*)(ws + WS_KVMEM), (const float*)(ws + WS_RSTDM)};
            pg8::gemm_phase<pg8::EpiKV, false>(F.lds, g2, S2, E2);
        }
        {
            const int rem = ((T / 256) * (NIN / 256)) % F.G; int lo = rem, hi = F.G - 8; if (hi - lo < 32) { lo = 0; hi = F.G; }
            const int c = (int)blockIdx.x;
            if (c >= lo && c < hi) tr_weights<1>(F, args, (c - lo) * NWAVES + F.wave, (hi - lo) * NWAVES);
        }
    }
    PH_END
    SEAM(3);
    PH_BEGIN(4) if (IN(4)) {
#if ATTN_NAIVE
        p4a_naive(F, args);
#else
        for (int it = F.vcu; it < 528; it += F.G) img_item(F, args, it);
        {   const int npre = (F.G > 16) ? ((F.G - 16 < N_PREP) ? F.G - 16 : N_PREP) : 0, q = F.vcu - 16;
            if (q >= 0 && q < npre) {
                u32x4 praw[11]; float pa = 0.f, pb = 0.f; int cw_head = -1, pend = -1;
                const int item = (((q & 15) >> 2) * 128 + (q >> 4)) * 4 + (q & 3);
                gdn_prep_fetch(F, item, praw, pa, pb);
                gdn_prep_item(F, args, item, 1 << 30, praw, pa, pb, cw_head, pend);
                asm volatile("s_waitcnt vmcnt(0)" ::: "memory");
                __syncthreads();
                if (F.tid == 0) __hip_atomic_store((unsigned*)(F.ws + WS_CTL) + CW_FLG + item, 1u, __ATOMIC_RELAXED, __HIP_MEMORY_SCOPE_AGENT);
            }
        }
#endif
    }
    PH_END
    SEAM(4);
    PH_BEGIN(5) if (IN(5)) { p4b_naive(F, args, _r); }
    PH_END
    SEAM(5);
    PH_BEGIN(6) if (IN(6)) {
        pg8::Gemm g{PC, (const bf16_t*)(ws + WS_WOUT), T, DM, DM, PP}; pg8::StaticOrder S; S.init(T, DM, F.G, (int)blockIdx.x);
        pg8::EpiResid<1> E{nullptr, F.out, XB, ss, 1.0f};
        pg8::gemm_phase<pg8::EpiResid<1>, true>(F.lds, g, S, E);
    }
    PH_END
    SEAM(6);
    PH_BEGIN(7) if (IN(7)) {
        pg8::Gemm g{XB, (const bf16_t*)(ws + WS_WGU2), T, NGU, DM, DM}; pg8::StaticOrder S; S.init(T, NGU, F.G, (int)blockIdx.x);
        pg8::EpiSwiGLU E{PC, ss};
        pg8::gemm_phase<pg8::EpiSwiGLU, true>(F.lds, g, S, E, ss);
    }
    PH_END
    SEAM(7);
    PH_BEGIN(8) if (IN(8)) {
        pg8::Gemm g{PC, (const bf16_t*)(ws + WS_WD2), T, DM, FF, FF}; pg8::StaticOrder S; S.init(T, DM, F.G, (int)blockIdx.x);
        pg8::EpiResid<2> E{nullptr, F.out, XB, ss, 0.5f};
        pg8::gemm_phase<pg8::EpiResid<2>, true>(F.lds, g, S, E);
    }
    PH_END
#undef IN
#undef SEAM
}

constexpr int N_PHASES = 9;
extern "C" void kernel_launch(void* const* d_in, const int* in_sizes, int n_in, void* d_out, int out_size, void* d_ws, size_t ws_size, hipStream_t stream) {
    static int grid = 0;
    if (grid == 0) {
        if (n_in != 23 || out_size != T * DM || ws_size < WS_END) { fprintf(stderr, "kernel_launch: unexpected shapes (n_in %d out %d ws %zu)\n", n_in, out_size, ws_size); grid = -1; return; }
        int dev = 0, cus = 0, per_cu = 0;
        (void)hipGetDevice(&dev); (void)hipDeviceGetAttribute(&cus, hipDeviceAttributeMultiprocessorCount, dev);
        (void)hipFuncSetAttribute((const void*)mk_fwd, hipFuncAttributeMaxDynamicSharedMemorySize, LDS_BYTES);
        (void)hipOccupancyMaxActiveBlocksPerMultiprocessor(&per_cu, (const void*)mk_fwd, NTHREADS, LDS_BYTES);
        (void)hipGetLastError();
        if (per_cu < 1) { fprintf(stderr, "kernel_launch: occupancy query says %d blocks/CU\n", per_cu); }
        grid = cus;
        if (grid != 256) fprintf(stderr, "kernel_launch: %d CUs (expected 256)\n", grid);
    }
    if (grid < 0) return;
    (void)hipMemsetAsync((char*)d_ws + WS_CTL, 0, 81920, stream);
    Args a{};
    for (int i = 0; i < 23; ++i) a.in[i] = (const float*)d_in[i];
    a.out = (float*)d_out; a.ws = (unsigned char*)d_ws;
    if (MK_N_LAUNCHES == 1) {
        a.ph_lo = 0; a.ph_hi = N_PHASES;
#if USE_CG_SYNC
        void* kargs[] = {&a};
        hipError_t e = hipLaunchCooperativeKernel((const void*)mk_fwd, dim3(grid), dim3(NTHREADS), kargs, LDS_BYTES, stream);
        if (e != hipSuccess) fprintf(stderr, "cooperative launch failed: %s\n", hipGetErrorString(e));
#else
        hipLaunchKernelGGL(mk_fwd, dim3(grid), dim3(NTHREADS), LDS_BYTES, stream, a);
#endif
    } else {
        for (int p = 0; p < N_PHASES; ++p) {
            a.ph_lo = p; a.ph_hi = p + 1;
            hipLaunchKernelGGL(mk_fwd, dim3(grid), dim3(NTHREADS), LDS_BYTES, stream, a);
        }
    }
}
```

```cpp
#include <hip/hip_runtime.h>
#include <hip/hip_cooperative_groups.h>
#include <cstdio>
#include <cstdint>
namespace cg = cooperative_groups;

#ifndef PROBE_DUP
#define PROBE_DUP -1
#endif
#ifndef NHELP
#define NHELP 1
#define HELP2 1
#endif
#ifndef USE_CG_SYNC
#define USE_CG_SYNC 0
#endif
#ifndef GDN_NAIVE
#define GDN_NAIVE 0
#endif
#ifndef ATTN_NAIVE
#define ATTN_NAIVE 0
#endif
#ifndef MK_N_LAUNCHES
#define MK_N_LAUNCHES 1
#endif

constexpr int BATCH = 4, SEQ = 8192, DM = 1024, T = BATCH * SEQ, FF = 2816, MEMT = 256;
constexpr int NGU = 2 * FF;
constexpr int NINR = 3072;
constexpr int NIN = 3328;
constexpr int PP = NINR;
constexpr float EPS = 1e-6f;
constexpr int C_GQ = 0, C_GK = 512, C_GV = 1024, C_GZ = 1536, C_MQ = 2048, C_MK = 2304, C_MV = 2560, C_CQ = 2816;

constexpr size_t MiB = 1u << 20;
constexpr size_t WS_CTL = 0, CTL_BYTES = 1 * MiB;
constexpr size_t WS_WGU1 = 1 * MiB, WS_WD1 = 12 * MiB, WS_WIN = 18 * MiB, WS_WOUT = 25 * MiB, WS_WGU2 = 27 * MiB, WS_WD2 = 38 * MiB, WS_WKV = 44 * MiB;
constexpr size_t WS_SS = 45 * MiB;
constexpr size_t WS_RSTDM = 47 * MiB;
constexpr size_t WS_GOUT = 47 * MiB + 65536;
constexpr size_t WS_AB = 48 * MiB;
constexpr size_t WS_KMEAN = 49 * MiB;
constexpr size_t WS_KVMEM = 50 * MiB;
constexpr size_t WS_MEMB = 52 * MiB;
constexpr size_t WS_GB = 54 * MiB;
constexpr size_t WS_GG = 54 * MiB + 512 * 1024;
constexpr size_t WS_XB = 56 * MiB;
constexpr size_t WS_KNM = 56 * MiB;
constexpr size_t WS_C = 120 * MiB;
constexpr size_t WS_G = 312 * MiB;
constexpr size_t WS_GQ = 312 * MiB, WS_GK = 344 * MiB, WS_GV = 376 * MiB;
constexpr size_t WS_END = 494 * MiB;

constexpr int NWAVES = 8, NTHREADS = 512;
constexpr int LDS_BYTES = 163840;

typedef unsigned short bf16_t;
typedef short bf16x8 __attribute__((ext_vector_type(8)));
typedef float f32x4 __attribute__((ext_vector_type(4)));
typedef float f32x2 __attribute__((ext_vector_type(2)));
typedef unsigned u32x4 __attribute__((ext_vector_type(4)));
typedef unsigned u32x2 __attribute__((ext_vector_type(2)));
#define LAS __attribute__((address_space(3)))
typedef float f32x16 __attribute__((ext_vector_type(16)));
typedef __bf16 bf16x2_t __attribute__((ext_vector_type(2)));
__device__ __forceinline__ unsigned cvtpk(float lo, float hi) { f32x2 v = {lo, hi}; bf16x2_t b = __builtin_convertvector(v, bf16x2_t); return __builtin_bit_cast(unsigned, b); }

__device__ __forceinline__ unsigned f2bf(float f) { unsigned u = __builtin_bit_cast(unsigned, f); return (u + 0x7fffu + ((u >> 16) & 1u)) >> 16; }
__device__ __forceinline__ unsigned pk2(float lo, float hi) { return f2bf(lo) | (f2bf(hi) << 16); }
__device__ __forceinline__ float bf2f(unsigned short h) { return __builtin_bit_cast(float, (unsigned)h << 16); }
__device__ __forceinline__ float bflo(unsigned w) { return __builtin_bit_cast(float, w << 16); }
__device__ __forceinline__ float bfhi(unsigned w) { return __builtin_bit_cast(float, w & 0xffff0000u); }
__device__ __forceinline__ float wave_sum(float v) {
#pragma unroll
    for (int o = 1; o < 64; o <<= 1) v += __shfl_xor(v, o);
    return v;
}
__device__ __forceinline__ float wave_max(float v) {
#pragma unroll
    for (int o = 1; o < 64; o <<= 1) v = fmaxf(v, __shfl_xor(v, o));
    return v;
}

namespace pg8 {
constexpr int BM = 256, BK = 64, HALF = 128, HTB = HALF * BK * 2, STAGE_BYTES = 8 * HTB, NXCD = 8, WGM = 4;
__host__ __device__ __forceinline__ int lds_byte(int r, int c) { const int st = (r >> 4) * 2 + (c >> 5), rr = r & 15, cc = c & 31, ob = rr * 64 + cc * 2; return st * 1024 + (ob ^ (((ob >> 9) & 1) << 5)); }
__host__ __device__ __forceinline__ void stage_rc(int b, int& R, int& C) { const int st = b / 1024, sb = b % 1024, swz = sb ^ (((sb >> 9) & 1) << 5); R = (st >> 1) * 16 + swz / 64; C = (st & 1) * 32 + (swz % 64) / 2; }
__host__ __device__ __forceinline__ int perm32(int rho) { const int n = rho >> 4, i = rho & 15; return 8 * (i >> 2) + 4 * n + (i & 3); }

struct Unit { int pm, pn; };
struct Gemm { const bf16_t* A; const bf16_t* Bt; int M, N, K, lda; };

struct StaticOrder {
    int nM, nN, nwg, G, c;
    __device__ void init(int M, int N, int G_, int c_) { nM = M / BM; nN = N / BM; nwg = nM * nN; G = G_; c = c_; }
    __device__ bool next(int i, Unit& u) const {
        const long L = (long)i * G + c; if (c < 0 || L >= nwg) return false;
        int wgid = (int)L; { const int q = nwg / NXCD, r = nwg % NXCD, xcd = wgid % NXCD, off = wgid / NXCD; wgid = (xcd < r ? xcd * (q + 1) : r * (q + 1) + (xcd - r) * q) + off; }
        const int nig = WGM * nN, gid = wgid / nig, fm = gid * WGM, gsz = (nM - fm) < WGM ? (nM - fm) : WGM;
        u.pm = fm + ((wgid % nig) % gsz); u.pn = (wgid % nig) / gsz; return true;
    }
};

__device__ __forceinline__ void rstd_table(LAS unsigned char* lds, const float* ss, const StaticOrder& S);
template <class Epi, bool ALIGN_EPI>
__device__ __forceinline__ void gemm_phase(LAS unsigned char* lds, const Gemm g, const StaticOrder& S, const Epi& E, const float* tab_ss = nullptr) {
    int tid = threadIdx.x; asm volatile("" : "+v"(tid));
    const int wid = __builtin_amdgcn_readfirstlane(tid >> 6), lane = tid & 63, wr = wid >> 2, wc = wid & 3, fr = lane & 15, fq = lane >> 4;
    const int K = g.K, nt = K / BK, lda = g.lda;
    unsigned voffA[2], voffB[2];
#pragma unroll
    for (int i = 0; i < 2; ++i) { int R, C; stage_rc(tid * 16 + i * 8192, R, C); const int Rb = (int)Epi::PERM == 2 ? (((R >> 5) << 6) + perm32(R & 31)) : (Epi::PERM ? ((R & ~31) + perm32(R & 31)) : R);
        voffA[i] = (unsigned)(R * lda + C) * 2u; voffB[i] = (unsigned)(Rb * K + C) * 2u; }
    const size_t kstep = (size_t)(BK * 2);
    const size_t hstepA = (size_t)HALF * lda * 2, hstepB = (size_t)((int)Epi::PERM == 2 ? 32 : HALF) * K * 2;
    const size_t tstepA = 2 * hstepA, tstepB = (size_t)BM * K * 2;
    const unsigned ldsw = (unsigned)wid * 1024u;
    const int aoff = lds_byte(wr * 64 + fr, fq * 8), boff = lds_byte(wc * 32 + fr, fq * 8);
#define PG8_SA(b, h) (((b) * 2 + (h)) * HTB)
#define PG8_SB(b, h) ((4 + (b) * 2 + (h)) * HTB)
#define PG8_STAGE(bufoff, gbase, voff) do { _Pragma("unroll") for (int _i = 0; _i < 2; ++_i) \
        __builtin_amdgcn_global_load_lds((const unsigned*)((const char*)(gbase) + (voff)[_i]), (LAS unsigned*)(lds + (bufoff) + ldsw + _i * 8192), 16, 0, 0); } while (0)
#define PG8_LDA(dst, b, h) do { _Pragma("unroll") for (int m = 0; m < 4; ++m) _Pragma("unroll") for (int k = 0; k < 2; ++k) dst[m][k] = *(const LAS bf16x8*)(lds + PG8_SA(b, h) + aoff + m * 2048 + k * 1024); } while (0)
#define PG8_LDB(dst, b, h) do { _Pragma("unroll") for (int n = 0; n < 2; ++n) _Pragma("unroll") for (int k = 0; k < 2; ++k) dst[n][k] = *(const LAS bf16x8*)(lds + PG8_SB(b, h) + boff + n * 2048 + k * 1024); } while (0)
#define PG8_MMA(ai, bj, At, Bt) do { __builtin_amdgcn_s_setprio(1); _Pragma("unroll") for (int m = 0; m < 4; ++m) _Pragma("unroll") for (int n = 0; n < 2; ++n) _Pragma("unroll") for (int k = 0; k < 2; ++k) \
        acc[ai][bj][m][n] = __builtin_amdgcn_mfma_f32_16x16x32_bf16(Bt[n][k], At[m][k], acc[ai][bj][m][n], 0, 0, 0); __builtin_amdgcn_s_setprio(0); } while (0)
#define PG8_WAIT_V(n) asm volatile("s_waitcnt vmcnt(" #n ")" ::: "memory")
#define PG8_WAIT_L(n) asm volatile("s_waitcnt lgkmcnt(" #n ")" ::: "memory")
#define PG8_BAR __builtin_amdgcn_s_barrier()
#define PG8_SCHED __builtin_amdgcn_sched_barrier(0)
    Unit cur, nxt; int ui = 0;
    if (!S.next(0, cur)) return;
    f32x4 acc[2][2][4][2];
#pragma unroll
    for (int a = 0; a < 2; ++a)
#pragma unroll
        for (int b = 0; b < 2; ++b)
#pragma unroll
            for (int m = 0; m < 4; ++m)
#pragma unroll
                for (int n = 0; n < 2; ++n) acc[a][b][m][n] = (f32x4){0.f, 0.f, 0.f, 0.f};
    bf16x8 At[4][2], B0[2][2], B1[2][2];
    const char* cA = (const char*)g.A + (size_t)cur.pm * tstepA; const char* cB = (const char*)g.Bt + (size_t)cur.pn * tstepB;
    PG8_STAGE(PG8_SB(0, 0), cB, voffB); PG8_STAGE(PG8_SB(0, 1), cB + hstepB, voffB); PG8_STAGE(PG8_SA(0, 0), cA, voffA); PG8_STAGE(PG8_SA(0, 1), cA + hstepA, voffA);
    if (tab_ss) rstd_table(lds, tab_ss, S);
    if (wr == 1) PG8_BAR;
    PG8_WAIT_V(2); PG8_BAR;
    PG8_STAGE(PG8_SB(1, 0), cB + kstep, voffB); PG8_STAGE(PG8_SA(1, 0), cA + kstep, voffA); PG8_STAGE(PG8_SB(1, 1), cB + hstepB + kstep, voffB);
    PG8_WAIT_V(6); PG8_BAR;
    for (;;) {
        const bool has_next = S.next(ui + 1, nxt);
        const char* nA = has_next ? (const char*)g.A + (size_t)nxt.pm * tstepA : cA; const char* nB = has_next ? (const char*)g.Bt + (size_t)nxt.pn * tstepB : cB;
        for (int t = 0; t < nt; t += 2) {
            const bool last = (t == nt - 2);
            const char* a1 = cA + (size_t)(t + 1) * kstep;
            const char* a2 = last ? nA : cA + (size_t)(t + 2) * kstep; const char* b2 = last ? nB : cB + (size_t)(t + 2) * kstep;
            const char* a3 = a2 + kstep; const char* b3 = b2 + kstep;
            PG8_LDB(B0, 0, 0); PG8_LDB(B1, 0, 1); PG8_SCHED; PG8_LDA(At, 0, 0); PG8_STAGE(PG8_SA(1, 1), a1 + hstepA, voffA);
            PG8_WAIT_V(8); PG8_WAIT_L(0); PG8_BAR; PG8_MMA(0, 0, At, B0); PG8_MMA(0, 1, At, B1); PG8_BAR; PG8_SCHED;
            PG8_LDA(At, 0, 1); PG8_STAGE(PG8_SB(0, 0), b2, voffB); PG8_STAGE(PG8_SB(0, 1), b2 + hstepB, voffB); PG8_STAGE(PG8_SA(0, 0), a2, voffA);
            PG8_WAIT_V(8); PG8_WAIT_L(0); PG8_BAR; PG8_MMA(1, 0, At, B0); PG8_MMA(1, 1, At, B1); PG8_BAR; PG8_SCHED;
            PG8_LDB(B0, 1, 0); PG8_LDB(B1, 1, 1); PG8_SCHED; PG8_LDA(At, 1, 0); PG8_STAGE(PG8_SA(0, 1), a2 + hstepA, voffA);
            PG8_WAIT_V(8); PG8_WAIT_L(0); PG8_BAR; PG8_MMA(0, 0, At, B0); PG8_MMA(0, 1, At, B1); PG8_BAR; PG8_SCHED;
            PG8_LDA(At, 1, 1); PG8_STAGE(PG8_SB(1, 0), b3, voffB); PG8_STAGE(PG8_SB(1, 1), b3 + hstepB, voffB); PG8_STAGE(PG8_SA(1, 0), a3, voffA);
            PG8_WAIT_V(8); PG8_WAIT_L(0); PG8_BAR; PG8_MMA(1, 0, At, B0); PG8_MMA(1, 1, At, B1); PG8_BAR; PG8_SCHED;
        }
        if constexpr (ALIGN_EPI) { if (wr == 0) PG8_BAR; }
        E(acc, cur, wr, wc, fr, fq, ui, lds);
        if (!has_next) break;
#pragma unroll
        for (int a = 0; a < 2; ++a)
#pragma unroll
            for (int b = 0; b < 2; ++b)
#pragma unroll
                for (int m = 0; m < 4; ++m)
#pragma unroll
                    for (int n = 0; n < 2; ++n) acc[a][b][m][n] = (f32x4){0.f, 0.f, 0.f, 0.f};
        cur = nxt; cA = nA; cB = nB; ++ui;
        if constexpr (ALIGN_EPI) { if (wr == 1) PG8_BAR; }
    }
    PG8_WAIT_V(0);
    if constexpr (!ALIGN_EPI) { if (wr == 0) PG8_BAR; }
    PG8_BAR;
#undef PG8_SA
#undef PG8_SB
#undef PG8_STAGE
#undef PG8_LDA
#undef PG8_LDB
#undef PG8_MMA
#undef PG8_WAIT_V
#undef PG8_WAIT_L
#undef PG8_BAR
#undef PG8_SCHED
}

__device__ __forceinline__ float row_rstd(const float* ss, int row) {
    const f32x4* p = (const f32x4*)(ss + (size_t)row * 16);
    const f32x4 a = p[0], b = p[1], c = p[2], d = p[3];
    const float s = ((a[0] + a[1]) + (a[2] + a[3])) + ((b[0] + b[1]) + (b[2] + b[3])) + ((c[0] + c[1]) + (c[2] + c[3])) + ((d[0] + d[1]) + (d[2] + d[3]));
    return __builtin_amdgcn_rsqf(s * (1.0f / DM) + EPS);
}
constexpr int RSTD_TAB_OFF = 131072;
__device__ __forceinline__ void rows_rstd8(LAS unsigned char* lds, int ui, int rl0  , float (&rs)[2][4]) {
    const LAS float* tab = (const LAS float*)(lds + RSTD_TAB_OFF) + ui * 256 + rl0;
#pragma unroll
    for (int ai = 0; ai < 2; ++ai)
#pragma unroll
        for (int m = 0; m < 4; ++m) rs[ai][m] = tab[ai * HALF + m * 16];
}
__device__ __forceinline__ float silu_mul(float g, float u) { return g * __builtin_amdgcn_rcpf(1.0f + __expf(-g)) * u; }

struct EpiSwiGLU {
    static constexpr bool PERM = true;
    bf16_t* H; const float* ss;
    __device__ __forceinline__ void operator()(const f32x4 (&acc)[2][2][4][2], const Unit& u, int wr, int wc, int fr, int fq, int ui, LAS unsigned char* lds) const {
        float rs8[2][4]; rows_rstd8(lds, ui, wr * 64 + fr, rs8);
#pragma unroll
        for (int ai = 0; ai < 2; ++ai)
#pragma unroll
            for (int m = 0; m < 4; ++m) {
                const int row = u.pm * BM + ai * HALF + wr * 64 + m * 16 + fr;
                const float rs = rs8[ai][m];
                u32x4 w;
                const float cneg = rs * -1.4426950408889634f, rs2 = rs * rs;
                { const f32x4 ag = acc[ai][0][m][0], au = acc[ai][1][m][0]; const f32x4 x = ag * cneg;
                  f32x4 d = (f32x4){__builtin_amdgcn_exp2f(x[0]), __builtin_amdgcn_exp2f(x[1]), __builtin_amdgcn_exp2f(x[2]), __builtin_amdgcn_exp2f(x[3])} + 1.0f;
                  const f32x4 r = (f32x4){__builtin_amdgcn_rcpf(d[0]), __builtin_amdgcn_rcpf(d[1]), __builtin_amdgcn_rcpf(d[2]), __builtin_amdgcn_rcpf(d[3])};
                  const f32x4 o = ((ag * au) * rs2) * r; w.x = cvtpk(o[0], o[1]); w.y = cvtpk(o[2], o[3]); }
                { const f32x4 ag = acc[ai][0][m][1], au = acc[ai][1][m][1]; const f32x4 x = ag * cneg;
                  f32x4 d = (f32x4){__builtin_amdgcn_exp2f(x[0]), __builtin_amdgcn_exp2f(x[1]), __builtin_amdgcn_exp2f(x[2]), __builtin_amdgcn_exp2f(x[3])} + 1.0f;
                  const f32x4 r = (f32x4){__builtin_amdgcn_rcpf(d[0]), __builtin_amdgcn_rcpf(d[1]), __builtin_amdgcn_rcpf(d[2]), __builtin_amdgcn_rcpf(d[3])};
                  const f32x4 o = ((ag * au) * rs2) * r; w.z = cvtpk(o[0], o[1]); w.w = cvtpk(o[2], o[3]); }
                *(u32x4*)(H + (size_t)row * FF + u.pn * 128 + wc * 32 + 8 * fq) = w;
            }
    }
};
template <int MODE> struct EpiResid {
    static constexpr int PERM = 2;
    const float* xin; float* out; bf16_t* xb; float* ss; float scale;
    __device__ __forceinline__ void operator()(const f32x4 (&acc)[2][2][4][2], const Unit& u, int wr, int wc, int fr, int fq, int ui, LAS unsigned char* lds) const {
        const size_t base = (size_t)(u.pm * BM + wr * 64 + fr) * DM + u.pn * BM + wc * 64 + 8 * fq;
        u32x4 rb[2][4][2];
#pragma unroll
        for (int ai = 0; ai < 2; ++ai)
#pragma unroll
            for (int m = 0; m < 4; ++m)
#pragma unroll
                for (int bj = 0; bj < 2; ++bj) rb[ai][m][bj] = *(const u32x4*)(xb + base + (size_t)(ai * HALF + m * 16) * DM + bj * 32);
#pragma unroll
        for (int ai = 0; ai < 2; ++ai)
#pragma unroll
            for (int m = 0; m < 4; ++m) {
                const size_t off = base + (size_t)(ai * HALF + m * 16) * DM;
                float s = 0.f;
#pragma unroll
                for (int bj = 0; bj < 2; ++bj) {
                    const u32x4 w = rb[ai][m][bj];
                    const f32x4 v0 = (f32x4){bflo(w.x), bfhi(w.x), bflo(w.y), bfhi(w.y)} + acc[ai][bj][m][0] * scale;
                    const f32x4 v1 = (f32x4){bflo(w.z), bfhi(w.z), bflo(w.w), bfhi(w.w)} + acc[ai][bj][m][1] * scale;
                    if (MODE == 2) { *(f32x4*)(out + off + bj * 32) = v0; *(f32x4*)(out + off + bj * 32 + 4) = v1; }
                    else { u32x4 o; o.x = cvtpk(v0[0], v0[1]); o.y = cvtpk(v0[2], v0[3]); o.z = cvtpk(v1[0], v1[1]); o.w = cvtpk(v1[2], v1[3]);
                        *(u32x4*)(xb + off + bj * 32) = o;
                        const float r0 = bflo(o.x), r1 = bfhi(o.x), r2 = bflo(o.y), r3 = bfhi(o.y), r4 = bflo(o.z), r5 = bfhi(o.z), r6 = bflo(o.w), r7 = bfhi(o.w);
                        s += ((r0 * r0 + r1 * r1) + (r2 * r2 + r3 * r3)) + ((r4 * r4 + r5 * r5) + (r6 * r6 + r7 * r7)); }
                }
                if (MODE != 2) { s += __shfl_xor(s, 16); s += __shfl_xor(s, 32); if (fq == 0) ss[(size_t)(u.pm * BM + ai * HALF + wr * 64 + m * 16 + fr) * 16 + u.pn * 4 + wc] = s; }
            }
    }
};
struct EpiWin {
    static constexpr int PERM = 2;
    bf16_t* P; float* AB; const float* ss;
    __device__ __forceinline__ void operator()(const f32x4 (&acc)[2][2][4][2], const Unit& u, int wr, int wc, int fr, int fq, int ui, LAS unsigned char* lds) const {
        float rs8[2][4]; rows_rstd8(lds, ui, wr * 64 + fr, rs8);
#pragma unroll
        for (int ai = 0; ai < 2; ++ai)
#pragma unroll
            for (int m = 0; m < 4; ++m) {
                const int row = u.pm * BM + ai * HALF + wr * 64 + m * 16 + fr;
                const float rs = rs8[ai][m];
                if (u.pn < 12) {
                    const bool gatecol = (u.pn == C_GZ / BM) || (u.pn == C_GZ / BM + 1);
#pragma unroll
                    for (int bj = 0; bj < 2; ++bj) {
                        f32x4 v0 = acc[ai][bj][m][0] * rs, v1 = acc[ai][bj][m][1] * rs;
                        if (gatecol) {
#pragma unroll
                            for (int i = 0; i < 4; ++i) { v0[i] = v0[i] * __builtin_amdgcn_rcpf(1.0f + __expf(-v0[i])); v1[i] = v1[i] * __builtin_amdgcn_rcpf(1.0f + __expf(-v1[i])); }
                        }
                        u32x4 w; w.x = cvtpk(v0[0], v0[1]); w.y = cvtpk(v0[2], v0[3]); w.z = cvtpk(v1[0], v1[1]); w.w = cvtpk(v1[2], v1[3]);
                        *(u32x4*)(P + (size_t)row * PP + u.pn * BM + wc * 64 + bj * 32 + 8 * fq) = w;
                    }
                } else if (wc == 0 && fq == 0) {
                    *(f32x4*)(AB + (size_t)row * 8) = acc[ai][0][m][0] * rs;
                    *(f32x4*)(AB + (size_t)row * 8 + 4) = acc[ai][0][m][1] * rs;
                }
            }
    }
};
struct EpiNullP { static constexpr bool PERM = true; float* sink;
    __device__ __forceinline__ void operator()(const f32x4 (&acc)[2][2][4][2], const Unit& u, int wr, int wc, int fr, int fq, int ui, LAS unsigned char* lds) const {
        float s = 0.f;
#pragma unroll
        for (int ai = 0; ai < 2; ++ai)
#pragma unroll
            for (int bj = 0; bj < 2; ++bj)
#pragma unroll
                for (int m = 0; m < 4; ++m)
#pragma unroll
                    for (int n = 0; n < 2; ++n) s += acc[ai][bj][m][n][0];
        if (s == 123456.789f) sink[0] = s;
    } };
struct EpiNullN { static constexpr bool PERM = false; float* sink;
    __device__ __forceinline__ void operator()(const f32x4 (&acc)[2][2][4][2], const Unit& u, int wr, int wc, int fr, int fq, int ui, LAS unsigned char* lds) const {
        float s = 0.f;
#pragma unroll
        for (int ai = 0; ai < 2; ++ai)
#pragma unroll
            for (int bj = 0; bj < 2; ++bj)
#pragma unroll
                for (int m = 0; m < 4; ++m)
#pragma unroll
                    for (int n = 0; n < 2; ++n) s += acc[ai][bj][m][n][0];
        if (s == 123456.789f) sink[0] = s;
    } };
struct EpiKV {
    static constexpr bool PERM = false;
    float* O; const float* rstdm;
    __device__ __forceinline__ void operator()(const f32x4 (&acc)[2][2][4][2], const Unit& u, int wr, int wc, int fr, int fq, int ui, LAS unsigned char* lds) const {
#pragma unroll
        for (int ai = 0; ai < 2; ++ai)
#pragma unroll
            for (int m = 0; m < 4; ++m) {
                const int row = u.pm * BM + ai * HALF + wr * 64 + m * 16 + fr;
                const float rs = rstdm[row];
                const size_t off = (size_t)row * 512 + u.pn * BM + wc * 32 + 4 * fq;
#pragma unroll
                for (int bj = 0; bj < 2; ++bj)
#pragma unroll
                    for (int n = 0; n < 2; ++n) *(f32x4*)(O + off + bj * HALF + n * 16) = acc[ai][bj][m][n] * rs;
            }
    }
};
__device__ __forceinline__ void rstd_table(LAS unsigned char* lds, const float* ss, const StaticOrder& S) {
    LAS float* tab = (LAS float*)(lds + RSTD_TAB_OFF);
    const int tid = threadIdx.x, half = tid >> 8, rl = tid & 255;
    for (int i = half; i < 12; i += 2) { Unit u; if (!S.next(i, u)) break; tab[i * 256 + rl] = row_rstd(ss, u.pm * BM + rl); }
    __syncthreads();
}
}


#define XB_TMO      128
#define XB_XCNT(j)  (256  + 64 * (j))
#define XB_XSUB(j)  (1280 + 64 * (j))
#define XB_XGEN(j)  (2304 + 64 * (j))
#define XB_TOP      3328
#define XB_TOPGEN   3392
#define XCD_BAR_WORDS 3456
#define XB_SPIN_CAP (1u << 18)
constexpr int CW_BAR = 1024;
constexpr int LDS_ST_OFF = 147440;
__device__ __forceinline__ unsigned xb_ld(unsigned* p)              { return __hip_atomic_load(p, __ATOMIC_RELAXED, __HIP_MEMORY_SCOPE_AGENT); }
__device__ __forceinline__ unsigned xb_add(unsigned* p, unsigned v) { return __hip_atomic_fetch_add(p, v, __ATOMIC_RELAXED, __HIP_MEMORY_SCOPE_AGENT); }
__device__ __forceinline__ unsigned xb_xcc_id() { return (unsigned)__builtin_amdgcn_s_getreg((3 << 11) | 20) & 0xFu; }
#define XB_SPIN(cond, bar) do { unsigned _sp = 0; while (cond) { __builtin_amdgcn_s_sleep(1); \
    if ((++_sp & 255u) == 0u) { if (xb_ld(&(bar)[XB_TMO])) break; if (_sp > XB_SPIN_CAP) { atomicAdd(&(bar)[XB_TMO], 1u); break; } } } } while (0)
struct XcdBarrier { unsigned* bar; unsigned x; volatile LAS unsigned* st; };
__device__ __forceinline__ XcdBarrier xcd_barrier_post(unsigned* bar, volatile LAS unsigned* st) {
    XcdBarrier b; b.bar = bar; b.x = xb_xcc_id(); b.st = st;
    if (threadIdx.x == 0) (void)xb_add(&bar[XB_XCNT(b.x)], 1u);
    return b;
}
__device__ __forceinline__ void xcd_barrier_complete(unsigned* bar, unsigned x, unsigned& nloc, unsigned& nx) {
    const unsigned G = gridDim.x * gridDim.y * gridDim.z;
    unsigned sum, cnt, mine, sp = 0u;
    for (;;) {
        sum = 0u; cnt = 0u; mine = 0u;
#pragma unroll
        for (unsigned j = 0; j < 16; ++j) { const unsigned c = xb_ld(&bar[XB_XCNT(j)]); sum += c; cnt += (c > 0u) ? 1u : 0u; mine = (j == x) ? c : mine; }
        if (sum == G) break;
        __builtin_amdgcn_s_sleep(1);
        if ((++sp & 255u) == 0u) { if (xb_ld(&bar[XB_TMO])) break; if (sp > XB_SPIN_CAP) { atomicAdd(&bar[XB_TMO], 1u); break; } }
    }
    nloc = mine > 0u ? mine : 1u; nx = cnt > 0u ? cnt : 1u;
}
__device__ __forceinline__ void xcd_barrier(const XcdBarrier& b) {
    asm volatile("s_waitcnt vmcnt(0)" ::: "memory");
    __syncthreads();
    if (threadIdx.x == 0) {
        unsigned* bar = b.bar;
        __builtin_amdgcn_s_waitcnt(0);
        unsigned nloc = b.st[0], nx = b.st[1];
        if (nloc == 0u) { xcd_barrier_complete(bar, b.x, nloc, nx); b.st[0] = nloc; b.st[1] = nx; }
        const unsigned old = xb_add(&bar[XB_XSUB(b.x)], 1u);
        const unsigned gen = old / nloc;
        if (old + 1u == (gen + 1u) * nloc) {
            __builtin_amdgcn_fence(__ATOMIC_RELEASE, "agent");
            asm volatile("s_waitcnt vmcnt(0)" ::: "memory");
            const unsigned og = xb_add(&bar[XB_TOP], 1u);
            const unsigned tg = og / nx;
            if (og + 1u == (tg + 1u) * nx) xb_add(&bar[XB_TOPGEN], 1u);
            else XB_SPIN(xb_ld(&bar[XB_TOPGEN]) == tg, bar);
            __builtin_amdgcn_fence(__ATOMIC_ACQUIRE, "agent");
            xb_add(&bar[XB_XGEN(b.x)], 1u);
            asm volatile("s_waitcnt vmcnt(0)" ::: "memory");
        } else {
            asm volatile("buffer_inv sc1" ::: "memory");
            XB_SPIN(xb_ld(&bar[XB_XGEN(b.x)]) == gen, bar);
            asm volatile("s_waitcnt vmcnt(0)" ::: "memory");
        }
    }
    __syncthreads();
}

struct Args;
struct Frame {
    LAS unsigned char* lds;
    int tid, lane, wave, vcu, G;
    float* out; unsigned char* ws;
};
struct Args { const float* in[23]; float* out; unsigned char* ws; int ph_lo, ph_hi; };

template <class SrcCol>
__device__ __forceinline__ void tr_item(const float* W, int ldw, int k0, int d0, SrcCol src, const float* gain, bf16_t* WT, int Kdim, LAS float* scr, int lane) {
    const int dl = lane & 31, sc = src(d0 + dl);
#pragma unroll 8
    for (int i = 0; i < 32; ++i) { const int kk = 2 * i + (lane >> 5);
        float v = 0.f; if (sc >= 0) { v = W[(size_t)(k0 + kk) * ldw + sc]; if (gain) v *= gain[k0 + kk]; }
        scr[kk * 33 + dl] = v; }
    asm volatile("s_waitcnt lgkmcnt(0)" ::: "memory");
    const int c = lane & 7;
#pragma unroll
    for (int j = 0; j < 4; ++j) { const int n = (lane >> 3) + 8 * j; const LAS float* s = scr + (8 * c) * 33 + n;
        u32x4 o; o.x = pk2(s[0 * 33], s[1 * 33]); o.y = pk2(s[2 * 33], s[3 * 33]); o.z = pk2(s[4 * 33], s[5 * 33]); o.w = pk2(s[6 * 33], s[7 * 33]);
        *(u32x4*)(WT + (size_t)(d0 + n) * Kdim + k0 + 8 * c) = o; }
    asm volatile("s_waitcnt lgkmcnt(0)" ::: "memory");
}
__device__ __forceinline__ void tr_item64(const float* W, int ldw, int k0, int d0, int sc0, const float* gain, bf16_t* WT, int Kdim, LAS float* scr, int lane) {
    const int n4 = (lane & 15) * 4;
#pragma unroll 8
    for (int i = 0; i < 16; ++i) { const int kk = 4 * i + (lane >> 4);
        f32x4 v = *(const f32x4*)(W + (size_t)(k0 + kk) * ldw + sc0 + n4); if (gain) v = v * gain[k0 + kk];
        scr[kk * 65 + n4] = v[0]; scr[kk * 65 + n4 + 1] = v[1]; scr[kk * 65 + n4 + 2] = v[2]; scr[kk * 65 + n4 + 3] = v[3]; }
    asm volatile("s_waitcnt lgkmcnt(0)" ::: "memory");
    const int c = lane & 7;
#pragma unroll
    for (int j = 0; j < 8; ++j) { const int n = (lane >> 3) + 8 * j; const LAS float* sp = scr + (8 * c) * 65 + n;
        u32x4 o; o.x = cvtpk(sp[0 * 65], sp[1 * 65]); o.y = cvtpk(sp[2 * 65], sp[3 * 65]); o.z = cvtpk(sp[4 * 65], sp[5 * 65]); o.w = cvtpk(sp[6 * 65], sp[7 * 65]);
        *(u32x4*)(WT + (size_t)(d0 + n) * Kdim + k0 + 8 * c) = o; }
    asm volatile("s_waitcnt lgkmcnt(0)" ::: "memory");
}
struct SrcGU { int up; __device__ int operator()(int d) const { const int pn = d >> 8, r = d & 255; return ((r >> 7) == up) ? pn * 128 + (r & 127) : -2; } };
struct SrcId { __device__ int operator()(int d) const { return d; } };
struct SrcWin { __device__ int operator()(int d) const { if (d < 2048) return d; if (d < 3072) return d + 8; if (d < 3080) return d - 3072 + 2048; return -1; } };

__device__ __forceinline__ float row_to_bf16(const float* xrow, bf16_t* orow, int lane) {
    const f32x4* xr = (const f32x4*)xrow + lane; f32x4 v[4]; float s = 0.f;
#pragma unroll
    for (int j = 0; j < 4; ++j) { v[j] = xr[64 * j]; s += (v[j][0] * v[j][0] + v[j][1] * v[j][1]) + (v[j][2] * v[j][2] + v[j][3] * v[j][3]); }
    u32x2* o8 = (u32x2*)orow + lane;
#pragma unroll
    for (int j = 0; j < 4; ++j) { u32x2 w; w.x = pk2(v[j][0], v[j][1]); w.y = pk2(v[j][2], v[j][3]); o8[64 * j] = w; }
    return wave_sum(s);
}

template <int PART>
__device__ __forceinline__ void tr_weights(Frame& F, const Args& A, int gw, int NGW) {
    LAS float* scr = (LAS float*)(F.lds + F.wave * 16640);
    const int lane = F.lane;
    unsigned char* ws = F.ws;
    constexpr int I_GU = (DM / 64) * (NGU / 64);
    constexpr int I_D = (FF / 64) * (DM / 64);
    constexpr int I_IN = (DM / 64) * (NINR / 64);
    constexpr int I_AB = (DM / 64) * 8;
    constexpr int I_O = (DM / 64) * (DM / 64);
    constexpr int I_KV = (DM / 64) * (512 / 64);
    constexpr int NITEMS = PART ? (I_GU + I_D + I_O) : (I_GU + I_D + I_IN + I_AB + I_KV);
    constexpr int l = PART;
    for (int it = gw; it < NITEMS; it += NGW) {
        int r = it;
        if (r < I_GU) { const int kb = r / (NGU / 64), db = r % (NGU / 64); const int d0 = db * 64; const int up = (d0 >> 7) & 1;
            const float* W = A.in[(l ? 20 : 3) + up]; const float* gain = A.in[l ? 19 : 2];
            tr_item64(W, FF, kb * 64, d0, (d0 >> 8) * 128 + (d0 & 127), gain, (bf16_t*)(ws + (l ? WS_WGU2 : WS_WGU1)), DM, scr, lane); continue; }
        r -= I_GU;
        if (r < I_D) { const int kb = r / (DM / 64), db = r % (DM / 64);
            tr_item64(A.in[l ? 22 : 5], DM, kb * 64, db * 64, db * 64, nullptr, (bf16_t*)(ws + (l ? WS_WD2 : WS_WD1)), FF, scr, lane); continue; }
        r -= I_D;
        if (PART) { const int kb = r / (DM / 64), db = r % (DM / 64);
            tr_item64(A.in[18], DM, kb * 64, db * 64, db * 64, (const float*)(ws + WS_GOUT), (bf16_t*)(ws + WS_WOUT), DM, scr, lane); continue; }
        if (r < I_IN) { const int kb = r / (NINR / 64), db = r % (NINR / 64); const int d0 = db * 64;
            tr_item64(A.in[7], 3080, kb * 64, d0, d0 < 2048 ? d0 : d0 + 8, A.in[6], (bf16_t*)(ws + WS_WIN), DM, scr, lane); continue; }
        r -= I_IN;
        if (r < I_AB) { const int kb = r / 8, db = r % 8;
            tr_item(A.in[7], 3080, kb * 64, NINR + db * 32, SrcWin{}, A.in[6], (bf16_t*)(ws + WS_WIN), DM, scr, lane); continue; }
        r -= I_AB;
        { const int kb = r / 8, db = r % 8;
            tr_item64(A.in[15], 512, kb * 64, db * 64, db * 64, A.in[14], (bf16_t*)(ws + WS_WKV), DM, scr, lane); }
    }
}

__device__ __forceinline__ void p0_prologue(Frame& F, const Args& A) {
    const int gw = F.vcu * NWAVES + F.wave, NGW = F.G * NWAVES, lane = F.lane;
    unsigned char* ws = F.ws;
    tr_weights<0>(F, A, gw, NGW);
    for (int i = gw * 64 + lane; i < DM; i += NGW * 64) ((float*)(ws + WS_GOUT))[i] = (i < 512) ? A.in[11][i & 127] : 1.0f;
    float* ss = (float*)(ws + WS_SS);
    for (int m = gw; m < T; m += NGW) {
        const float s = row_to_bf16(A.in[0] + (size_t)m * DM, (bf16_t*)(ws + WS_XB) + (size_t)m * DM, lane);
        if (lane < 16) ss[(size_t)m * 16 + lane] = (lane == 0) ? s : 0.f;
    }
    for (int m = gw; m < BATCH * MEMT; m += NGW) {
        const float s = row_to_bf16(A.in[1] + (size_t)m * DM, (bf16_t*)(ws + WS_MEMB) + (size_t)m * DM, lane);
        if (lane == 0) ((float*)(ws + WS_RSTDM))[m] = __builtin_amdgcn_rsqf(s * (1.0f / DM) + EPS);
    }
}

__device__ __forceinline__ void p4a_naive(Frame& F, const Args& A) {
    const int gw = F.vcu * NWAVES + F.wave, NGW = F.G * NWAVES, lane = F.lane;
    unsigned char* ws = F.ws;
    const bf16_t* P = (const bf16_t*)(ws + WS_C);
    const float* convw = A.in[8];
    const int h = lane >> 4;
#if GDN_NAIVE
    float cw[3][4][8];
#pragma unroll
    for (int s = 0; s < 3; ++s)
#pragma unroll
        for (int j = 0; j < 4; ++j)
#pragma unroll
            for (int i = 0; i < 8; ++i) cw[s][j][i] = convw[j * 1536 + s * 512 + lane * 8 + i];
    const float alog = A.in[9][h], dtb = A.in[10][h];
    const float* AB = (const float*)(ws + WS_AB);
    for (int t = gw; t < T; t += NGW) {
        const int tl = t & (SEQ - 1);
        float y[3][8];
#pragma unroll
        for (int s = 0; s < 3; ++s) {
#pragma unroll
            for (int i = 0; i < 8; ++i) y[s][i] = 0.f;
#pragma unroll
            for (int j = 0; j < 4; ++j) { const int tt = tl - 3 + j;
                if (tt >= 0) { const u32x4 w = *(const u32x4*)(P + (size_t)(t - 3 + j) * PP + s * 512 + lane * 8);
                    y[s][0] += cw[s][j][0] * bflo(w.x); y[s][1] += cw[s][j][1] * bfhi(w.x); y[s][2] += cw[s][j][2] * bflo(w.y); y[s][3] += cw[s][j][3] * bfhi(w.y);
                    y[s][4] += cw[s][j][4] * bflo(w.z); y[s][5] += cw[s][j][5] * bfhi(w.z); y[s][6] += cw[s][j][6] * bflo(w.w); y[s][7] += cw[s][j][7] * bfhi(w.w); } }
#pragma unroll
            for (int i = 0; i < 8; ++i) { const float v = y[s][i]; y[s][i] = v * __builtin_amdgcn_rcpf(1.0f + __expf(-v)); }
        }
        float sq = 0.f, sk = 0.f;
#pragma unroll
        for (int i = 0; i < 8; ++i) { sq += y[0][i] * y[0][i]; sk += y[1][i] * y[1][i]; }
#pragma unroll
        for (int o = 1; o < 16; o <<= 1) { sq += __shfl_xor(sq, o); sk += __shfl_xor(sk, o); }
        const float rq = __builtin_amdgcn_rsqf(sq + EPS) * 0.08838834764831845f, rk = __builtin_amdgcn_rsqf(sk + EPS);
        u32x4 wq, wk, wv;
        wq.x = pk2(y[0][0] * rq, y[0][1] * rq); wq.y = pk2(y[0][2] * rq, y[0][3] * rq); wq.z = pk2(y[0][4] * rq, y[0][5] * rq); wq.w = pk2(y[0][6] * rq, y[0][7] * rq);
        wk.x = pk2(y[1][0] * rk, y[1][1] * rk); wk.y = pk2(y[1][2] * rk, y[1][3] * rk); wk.z = pk2(y[1][4] * rk, y[1][5] * rk); wk.w = pk2(y[1][6] * rk, y[1][7] * rk);
        wv.x = pk2(y[2][0], y[2][1]); wv.y = pk2(y[2][2], y[2][3]); wv.z = pk2(y[2][4], y[2][5]); wv.w = pk2(y[2][6], y[2][7]);
        *(u32x4*)((bf16_t*)(ws + WS_GQ) + (size_t)t * 512 + lane * 8) = wq;
        *(u32x4*)((bf16_t*)(ws + WS_GK) + (size_t)t * 512 + lane * 8) = wk;
        *(u32x4*)((bf16_t*)(ws + WS_GV) + (size_t)t * 512 + lane * 8) = wv;
        if ((lane & 15) == 0) {
            const float a = AB[(size_t)t * 8 + h], b = AB[(size_t)t * 8 + 4 + h];
            const float xx = a + dtb; const float sp = (xx > 20.f) ? xx : log1pf(__expf(xx));
            ((float*)(ws + WS_GG))[(size_t)t * 4 + h] = -__expf(alog) * sp;
            ((float*)(ws + WS_GB))[(size_t)t * 4 + h] = 1.0f / (1.0f + __expf(-b));
        }
    }
#endif
    {
        const float* kg = A.in[13]; const int d0 = (lane & 15) * 4;
        const float g0 = kg[d0], g1 = kg[d0 + 1], g2 = kg[d0 + 2], g3 = kg[d0 + 3];
        bf16_t* KNM = (bf16_t*)(ws + WS_KNM);
        for (int t = gw; t < T; t += NGW) {
            const int b = t >> 13, tl = t & (SEQ - 1);
            const u32x2 w = *(const u32x2*)(P + (size_t)t * PP + C_MK + lane * 4);
            float v0 = bflo(w.x), v1 = bfhi(w.x), v2 = bflo(w.y), v3 = bfhi(w.y);
            float s = v0 * v0 + v1 * v1 + v2 * v2 + v3 * v3;
#pragma unroll
            for (int o = 1; o < 16; o <<= 1) s += __shfl_xor(s, o);
            const float r = __builtin_amdgcn_rsqf(s * (1.0f / 64) + EPS);
            u32x2 o; o.x = pk2(v0 * r * g0, v1 * r * g1); o.y = pk2(v2 * r * g2, v3 * r * g3);
            *(u32x2*)(KNM + ((size_t)(b * 4 + h) * SEQ + tl) * 64 + d0) = o;
        }
        float* KM = (float*)(ws + WS_KMEAN);
        for (int it = gw; it < BATCH * 32; it += NGW) {
            const int b = it >> 5, j = it & 31;
            float a0 = 0.f, a1 = 0.f, a2 = 0.f, a3 = 0.f;
            for (int k = 0; k < 256; ++k) {
                const int t = b * SEQ + j * 256 + k;
                const u32x2 w = *(const u32x2*)(P + (size_t)t * PP + C_MK + lane * 4);
                float v0 = bflo(w.x), v1 = bfhi(w.x), v2 = bflo(w.y), v3 = bfhi(w.y);
                float s = v0 * v0 + v1 * v1 + v2 * v2 + v3 * v3;
#pragma unroll
                for (int o = 1; o < 16; o <<= 1) s += __shfl_xor(s, o);
                const float r = __builtin_amdgcn_rsqf(s * (1.0f / 64) + EPS);
                a0 += bf2f((unsigned short)f2bf(v0 * r * g0)); a1 += bf2f((unsigned short)f2bf(v1 * r * g1)); a2 += bf2f((unsigned short)f2bf(v2 * r * g2)); a3 += bf2f((unsigned short)f2bf(v3 * r * g3));
            }
            f32x4 o = {a0 * (1.0f / 256), a1 * (1.0f / 256), a2 * (1.0f / 256), a3 * (1.0f / 256)};
            *(f32x4*)(KM + ((size_t)(b * 4 + h) * 32 + j) * 64 + d0) = o;
        }
    }
}


constexpr int GREC = 73728;
constexpr int CW_PROG = 12288;
constexpr int CW_PQ = 14336;
constexpr int CW_FLG = 16384;
constexpr int CW_MDONE = 19072;
constexpr int N_PREP = T / 64 * 4;
constexpr int R_W = 0, R_QG = 16384, R_KD = 32768, R_QK = 49152, R_U = 55296, R_GL = 71680;
constexpr int R_OPS = 55296;
constexpr int L_QN = 0, L_KN = 17408, L_KNT = 34816, L_VT = 53248, L_AT = 71680, L_TP = 89088, L_KGT = 98304, L_SC = 116736, L_AB = 117760, L_TT = 126976, L_CW = 147456;
constexpr int PQ = 272, PT = 144;
__device__ __forceinline__ u32x4 pack8(const float (&v)[8]) { u32x4 w; w.x = cvtpk(v[0], v[1]); w.y = cvtpk(v[2], v[3]); w.z = cvtpk(v[4], v[5]); w.w = cvtpk(v[6], v[7]); return w; }

__device__ __forceinline__ bf16x8 cvt8(const f32x16& x, int s) {
    u32x4 w;
    if (s == 0) { w.x = cvtpk(x[0], x[1]); w.y = cvtpk(x[2], x[3]); w.z = cvtpk(x[4], x[5]); w.w = cvtpk(x[6], x[7]); }
    else { w.x = cvtpk(x[8], x[9]); w.y = cvtpk(x[10], x[11]); w.z = cvtpk(x[12], x[13]); w.w = cvtpk(x[14], x[15]); }
    return __builtin_bit_cast(bf16x8, w);
}

__device__ __forceinline__ void gdn_prep_fetch(Frame& F, int item, u32x4 (&praw)[11], float& pa, float& pb) {
    const int cidx = item >> 2, h = item & 3; const int t0 = cidx * 64, tl0 = t0 & (SEQ - 1);
    const bf16_t* P = (const bf16_t*)(F.ws + WS_C); const int tid2 = F.tid & 127, cg = tid2 & 15, c0 = (tid2 >> 4) * 8; const int s = F.wave >> 1;
    if (F.wave < 6) {
#pragma unroll
        for (int k = 0; k < 11; ++k)
            praw[k] = (tl0 + c0 - 3 + k >= 0) ? *(const u32x4*)(P + (size_t)(t0 + c0 - 3 + k) * PP + s * 512 + h * 128 + cg * 8) : (u32x4){0u, 0u, 0u, 0u};
    }
    if (F.wave == 0) { const float* AB = (const float*)(F.ws + WS_AB); pa = AB[(size_t)(t0 + F.lane) * 8 + h]; pb = AB[(size_t)(t0 + F.lane) * 8 + 4 + h]; }
}
typedef int i32x4 __attribute__((ext_vector_type(4)));
__device__ __forceinline__ void st16_wt(__amdgpu_buffer_rsrc_t rsrc, int off, u32x4 v) { __builtin_amdgcn_raw_buffer_store_b128(__builtin_bit_cast(i32x4, v), rsrc, off, 0, 16); }
__device__ __forceinline__ void gdn_prep_item(Frame& F, const Args& A, int item, unsigned* qhead, LAS unsigned* qw, int& next_q, u32x4 (&praw)[11], float& pa, float& pb, int& cw_head, int& pend) {
    const int cidx = item >> 2, h = item & 3;
    const int t0 = cidx * 64, tl0 = t0 & (SEQ - 1);
    LAS unsigned char* L = F.lds;
    int tid = F.tid; asm volatile("" : "+v"(tid));
    const int lane = tid & 63, wave = F.wave;
    unsigned nx_raw = 0u; if (tid == 0) nx_raw = atomicAdd(qhead, 1u);
    unsigned char* rec = F.ws + WS_G + (size_t)item * GREC;
    const __amdgpu_buffer_rsrc_t rsrc = __builtin_amdgcn_make_buffer_rsrc(rec, 0, GREC, 0x00020000);
    const bf16_t* P = (const bf16_t*)(F.ws + WS_C);
    LAS float* sc_beta = (LAS float*)(L + L_SC); LAS float* sc_gc = sc_beta + 64; LAS float* sc_eg = sc_beta + 128; LAS float* sc_ekd = sc_beta + 192;
    if (wave == 0) {
        const float a = pa, bb = pb;
        const float xx = a + A.in[10][h]; const float sp = (xx > 20.f) ? xx : log1pf(__expf(xx));
        float g = -__expf(A.in[9][h]) * sp;
        const float beta = 1.0f / (1.0f + __expf(-bb));
#pragma unroll
        for (int o = 1; o < 64; o <<= 1) { const float u = __shfl_up(g, o); if (lane >= o) g += u; }
        const float gl = __shfl(g, 63);
        sc_beta[lane] = beta; sc_gc[lane] = g; sc_eg[lane] = __expf(g); sc_ekd[lane] = __expf(gl - g);
        if (lane == 0) __hip_atomic_store((float*)(rec + R_GL), __expf(gl), __ATOMIC_RELAXED, __HIP_MEMORY_SCOPE_AGENT);
    }
    for (int i = tid; i < 576; i += NTHREADS) { *(LAS u32x4*)(L + L_TP + i * 16) = (u32x4){0u, 0u, 0u, 0u}; *(LAS u32x4*)(L + L_TT + i * 16) = (u32x4){0u, 0u, 0u, 0u}; }
    if (h != cw_head) {
        LAS float* cwl = (LAS float*)(L + L_CW);
        for (int i = tid; i < 1536; i += NTHREADS) { const int e = i & 7, j = (i >> 3) & 3, s3 = (i >> 5) % 3, cg2 = i / 96;
            cwl[i] = A.in[8][j * 1536 + s3 * 512 + h * 128 + cg2 * 8 + e]; }
        cw_head = h;
    }
    __syncthreads();
    if (wave < 6) {
        const int s = wave >> 1, tid2 = tid & 127, cg = tid2 & 15, c0 = (tid2 >> 4) * 8;
        const LAS float* cwl = (const LAS float*)(L + L_CW) + cg * 96 + s * 32;
        f32x4 cw0[4], cw1[4];
#pragma unroll
        for (int j = 0; j < 4; ++j) { cw0[j] = *(const LAS f32x4*)(cwl + j * 8); cw1[j] = *(const LAS f32x4*)(cwl + j * 8 + 4); }
        const int cst = ((c0 + 8 * (cg & 7)) & 63) * 2;
#pragma unroll
        for (int g4 = 0; g4 < 2; ++g4) {
            float y[4][8];
#pragma unroll
            for (int k = 0; k < 4; ++k)
#pragma unroll
                for (int i = 0; i < 8; ++i) y[k][i] = 0.f;
#pragma unroll
            for (int r7 = 0; r7 < 7; ++r7) {
                const u32x4 w = praw[4 * g4 + r7];
                const float x0 = bflo(w.x), x1 = bfhi(w.x), x2 = bflo(w.y), x3 = bfhi(w.y), x4 = bflo(w.z), x5 = bfhi(w.z), x6 = bflo(w.w), x7 = bfhi(w.w);
#pragma unroll
                for (int j = 0; j < 4; ++j) { const int k = r7 - j;
                    if (k >= 0 && k < 4) {
                        y[k][0] += cw0[j][0] * x0; y[k][1] += cw0[j][1] * x1; y[k][2] += cw0[j][2] * x2; y[k][3] += cw0[j][3] * x3;
                        y[k][4] += cw1[j][0] * x4; y[k][5] += cw1[j][1] * x5; y[k][6] += cw1[j][2] * x6; y[k][7] += cw1[j][3] * x7; } }
            }
#pragma unroll
            for (int k = 0; k < 4; ++k)
#pragma unroll
                for (int i = 0; i < 8; ++i) { const float v = y[k][i]; y[k][i] = v * __builtin_amdgcn_rcpf(1.0f + __expf(-v)); }
            if (s < 2) {
#pragma unroll
                for (int k = 0; k < 4; ++k) {
                    float sq = 0.f;
#pragma unroll
                    for (int i = 0; i < 8; ++i) sq += y[k][i] * y[k][i];
#pragma unroll
                    for (int o = 1; o < 16; o <<= 1) sq += __shfl_xor(sq, o);
                    const float rn = __builtin_amdgcn_rsqf(sq + EPS) * (s == 0 ? 0.08838834764831845f : 1.0f);
#pragma unroll
                    for (int i = 0; i < 8; ++i) y[k][i] *= rn;
                }
            }
            const int cb = c0 + 4 * g4;
            if (s == 0) {
#pragma unroll
                for (int k = 0; k < 4; ++k) *(LAS u32x4*)(L + L_QN + (cb + k) * PQ + cg * 16) = pack8(y[k]);
            } else if (s == 1) {
#pragma unroll
                for (int k = 0; k < 4; ++k) *(LAS u32x4*)(L + L_KN + (cb + k) * PQ + cg * 16) = pack8(y[k]);
                float be[4];
#pragma unroll
                for (int k = 0; k < 4; ++k) be[k] = sc_beta[cb + k] * sc_eg[cb + k];
#pragma unroll
                for (int i = 0; i < 8; ++i) {
                    u32x2 kw, gw;
                    kw.x = cvtpk(y[0][i], y[1][i]); kw.y = cvtpk(y[2][i], y[3][i]);
                    gw.x = cvtpk(y[0][i] * be[0], y[1][i] * be[1]); gw.y = cvtpk(y[2][i] * be[2], y[3][i] * be[3]);
                    *(LAS u32x2*)(L + L_KNT + (cg * 8 + i) * PT + cst + 8 * g4) = kw;
                    *(LAS u32x2*)(L + L_KGT + (cg * 8 + i) * PT + cst + 8 * g4) = gw;
                }
            } else {
                float bt[4];
#pragma unroll
                for (int k = 0; k < 4; ++k) bt[k] = sc_beta[cb + k];
#pragma unroll
                for (int i = 0; i < 8; ++i) {
                    u32x2 vw; vw.x = cvtpk(y[0][i] * bt[0], y[1][i] * bt[1]); vw.y = cvtpk(y[2][i] * bt[2], y[3][i] * bt[3]);
                    *(LAS u32x2*)(L + L_VT + (cg * 8 + i) * PT + cst + 8 * g4) = vw;
                }
            }
        }
    }
    if (pend >= 0) asm volatile("s_waitcnt vmcnt(0)" ::: "memory");
    if (tid == 0) *qw = nx_raw;
    __syncthreads();
    if (pend >= 0 && tid == 0) __hip_atomic_store((unsigned*)(F.ws + WS_CTL) + CW_FLG + pend, 1u, __ATOMIC_RELAXED, __HIP_MEMORY_SCOPE_AGENT);
    next_q = __builtin_amdgcn_readfirstlane((int)*qw);
    const int next_item = (next_q < N_PREP) ? ((((next_q & 15) >> 2) * 128 + (next_q >> 4)) * 4 + (next_q & 3)) : (1 << 30);
    if (next_item < T / 64 * 4) gdn_prep_fetch(F, next_item, praw, pa, pb);
    const int r = lane & 31, hh = lane >> 5;
    if (wave < 6) {
        int tm, tn; const LAS unsigned char* Ab; const LAS unsigned char* Bb;
        if (wave < 3) { tm = (wave >= 1); tn = (wave == 2); Ab = L + L_KN + (32 * tm + r) * PQ; Bb = L + L_KN + (32 * tn + r) * PQ; }
        else { tm = (wave == 5); tn = (wave >= 4); Ab = L + L_KN + (32 * tm + r) * PQ; Bb = L + L_QN + (32 * tn + r) * PQ; }
        f32x16 acc;
#pragma unroll
        for (int i = 0; i < 16; ++i) acc[i] = 0.f;
#pragma unroll
        for (int s = 0; s < 8; ++s) { const bf16x8 a = *(const LAS bf16x8*)(Ab + s * 32 + hh * 16), b = *(const LAS bf16x8*)(Bb + s * 32 + hh * 16);
            acc = __builtin_amdgcn_mfma_f32_32x32x16_bf16(a, b, acc, 0, 0, 0); }
        const int col = tn * 32 + r; const float gcc = sc_gc[col];
        if (wave < 3) {
#pragma unroll
            for (int i = 0; i < 16; ++i) { const int row = tm * 32 + (i & 3) + 8 * (i >> 2) + 4 * hh;
                const float v = (row > col) ? acc[i] * sc_beta[row] * __expf(sc_gc[row] - gcc) : 0.f;
                *(LAS float*)(L + L_AT + col * PQ + row * 4) = v;
                *(LAS unsigned short*)(L + L_AB + row * PT + col * 2) = (unsigned short)(cvtpk(v, 0.f) & 0xffffu); }
        } else {
            float v[16];
#pragma unroll
            for (int i = 0; i < 16; ++i) { const int row = tm * 32 + (i & 3) + 8 * (i >> 2) + 4 * hh;
                v[i] = (row <= col) ? acc[i] * __expf(gcc - sc_gc[row]) : 0.f; }
            const int f0 = (tn == 0) ? 0 : 2 + 2 * tm;
            u32x4 w0, w1; w0.x = cvtpk(v[0], v[1]); w0.y = cvtpk(v[2], v[3]); w0.z = cvtpk(v[4], v[5]); w0.w = cvtpk(v[6], v[7]);
            w1.x = cvtpk(v[8], v[9]); w1.y = cvtpk(v[10], v[11]); w1.z = cvtpk(v[12], v[13]); w1.w = cvtpk(v[14], v[15]);
            st16_wt(rsrc, R_QK + f0 * 1024 + lane * 16, w0);
            st16_wt(rsrc, R_QK + (f0 + 1) * 1024 + lane * 16, w1);
        }
    }
    __syncthreads();
    if (wave == 0) {
        {
            const int g = lane >> 4, rr = lane & 15;
            const LAS unsigned char* ab = L + L_AT + (16 * g) * PQ + (16 * g) * 4;
            float Dr[16];
#pragma unroll
            for (int i = 0; i < 16; ++i) Dr[i] = 0.f;
            Dr[15] = (rr == 15) ? 1.0f : 0.f;
#define GDN_L0_BATCH(JHI, JLO) { asm volatile("" : "+v"(ab)); f32x4 av[(JHI) - (JLO) + 1][4]; \
            _Pragma("unroll") for (int jj = (JHI); jj >= (JLO); --jj) _Pragma("unroll") for (int k = 0; k < 4; ++k) if (k >= ((jj + 1) >> 2)) av[jj - (JLO)][k] = *(const LAS f32x4*)(ab + jj * PQ + k * 16); \
            _Pragma("unroll") for (int jj = (JHI); jj >= (JLO); --jj) { f32x2 a0 = {0.f, 0.f}, a1 = {0.f, 0.f}; \
                _Pragma("unroll") for (int k = 0; k < 4; ++k) if (k >= ((jj + 1) >> 2)) { \
                    a0 += (f32x2){Dr[4 * k], Dr[4 * k + 1]} * (f32x2){av[jj - (JLO)][k][0], av[jj - (JLO)][k][1]}; \
                    a1 += (f32x2){Dr[4 * k + 2], Dr[4 * k + 3]} * (f32x2){av[jj - (JLO)][k][2], av[jj - (JLO)][k][3]}; } \
                Dr[jj] = (rr == jj) ? 1.0f : -((a0[0] + a0[1]) + (a1[0] + a1[1])); } }
            GDN_L0_BATCH(14, 7)
            GDN_L0_BATCH(6, 3)
            GDN_L0_BATCH(2, 0)
#undef GDN_L0_BATCH
            u32x4 w0, w1; w0.x = cvtpk(Dr[0], Dr[1]); w0.y = cvtpk(Dr[2], Dr[3]); w0.z = cvtpk(Dr[4], Dr[5]); w0.w = cvtpk(Dr[6], Dr[7]);
            w1.x = cvtpk(Dr[8], Dr[9]); w1.y = cvtpk(Dr[10], Dr[11]); w1.z = cvtpk(Dr[12], Dr[13]); w1.w = cvtpk(Dr[14], Dr[15]);
            *(LAS u32x4*)(L + L_TP + (16 * g + rr) * PT + 32 * g) = w0; *(LAS u32x4*)(L + L_TP + (16 * g + rr) * PT + 32 * g + 16) = w1;
            const unsigned dw[8] = {w0.x, w0.y, w0.z, w0.w, w1.x, w1.y, w1.z, w1.w};
#pragma unroll
            for (int c = 0; c < 16; ++c) *(LAS unsigned short*)(L + L_TT + (16 * g + c) * PT + (16 * g + rr) * 2) = (unsigned short)((c & 1) ? (dw[c >> 1] >> 16) : (dw[c >> 1] & 0xffffu));
        }
        asm volatile("s_waitcnt lgkmcnt(0)" ::: "memory");
#pragma unroll
        for (int q = 0; q < 2; ++q) {
            f32x16 G, M;
#pragma unroll
            for (int i = 0; i < 16; ++i) { G[i] = 0.f; M[i] = 0.f; }
            G = __builtin_amdgcn_mfma_f32_32x32x16_bf16(*(const LAS bf16x8*)(L + L_AB + (32 * q + r) * PT + (32 * q + 8 * hh) * 2),
                                                         *(const LAS bf16x8*)(L + L_TT + (32 * q + r) * PT + (32 * q + 8 * hh) * 2), G, 0, 0, 0);
            const bf16x8 gb = cvt8(G, 1);
            const u32x2 d0 = *(const LAS u32x2*)(L + L_TP + (32 * q + r) * PT + (32 * q + 16 + 4 * hh) * 2), d1 = *(const LAS u32x2*)(L + L_TP + (32 * q + r) * PT + (32 * q + 16 + 8 + 4 * hh) * 2);
            u32x4 da; da.x = d0.x; da.y = d0.y; da.z = d1.x; da.w = d1.y;
            M = __builtin_amdgcn_mfma_f32_32x32x16_bf16(__builtin_bit_cast(bf16x8, da), gb, M, 0, 0, 0);
            if (r < 16) {
#pragma unroll
                for (int i = 8; i < 16; ++i) { const int m = (i & 3) + 8 * (i >> 2) + 4 * hh;
                    *(LAS unsigned short*)(L + L_TP + (32 * q + m) * PT + (32 * q + r) * 2) = (unsigned short)(cvtpk(-M[i], 0.f) & 0xffffu); }
                u32x2 t0, t1; t0.x = cvtpk(-M[8], -M[9]); t0.y = cvtpk(-M[10], -M[11]); t1.x = cvtpk(-M[12], -M[13]); t1.y = cvtpk(-M[14], -M[15]);
                *(LAS u32x2*)(L + L_TT + (32 * q + r) * PT + (32 * q + 16 + 4 * hh) * 2) = t0;
                *(LAS u32x2*)(L + L_TT + (32 * q + r) * PT + (32 * q + 24 + 4 * hh) * 2) = t1;
            }
        }
        asm volatile("s_waitcnt lgkmcnt(0)" ::: "memory");
        {
            f32x16 G, M;
#pragma unroll
            for (int i = 0; i < 16; ++i) { G[i] = 0.f; M[i] = 0.f; }
#pragma unroll
            for (int sx = 0; sx < 2; ++sx)
                G = __builtin_amdgcn_mfma_f32_32x32x16_bf16(*(const LAS bf16x8*)(L + L_AB + (32 + r) * PT + (16 * sx + 8 * hh) * 2),
                                                             *(const LAS bf16x8*)(L + L_TT + r * PT + (16 * sx + 8 * hh) * 2), G, 0, 0, 0);
#pragma unroll
            for (int sx = 0; sx < 2; ++sx) {
                const bf16x8 gb = cvt8(G, sx);
                const u32x2 d0 = *(const LAS u32x2*)(L + L_TP + (32 + r) * PT + (32 + 16 * sx + 4 * hh) * 2), d1 = *(const LAS u32x2*)(L + L_TP + (32 + r) * PT + (32 + 16 * sx + 8 + 4 * hh) * 2);
                u32x4 da; da.x = d0.x; da.y = d0.y; da.z = d1.x; da.w = d1.y;
                M = __builtin_amdgcn_mfma_f32_32x32x16_bf16(__builtin_bit_cast(bf16x8, da), gb, M, 0, 0, 0);
            }
#pragma unroll
            for (int i = 0; i < 16; ++i) { const int m = (i & 3) + 8 * (i >> 2) + 4 * hh;
                *(LAS unsigned short*)(L + L_TP + (32 + m) * PT + r * 2) = (unsigned short)(cvtpk(-M[i], 0.f) & 0xffffu); }
        }
    } else {
        for (int f = wave - 1; f < 32; f += 7) {
            if (f < 16) {
                const int mt = f >> 3, dblk = (f >> 1) & 3, s = f & 1; const int c = 32 * mt + r, d0 = 32 * dblk + 16 * s + 4 * hh;
                const u32x2 lo = *(const LAS u32x2*)(L + L_QN + c * PQ + d0 * 2), hi = *(const LAS u32x2*)(L + L_QN + c * PQ + (d0 + 8) * 2);
                const float e = sc_eg[c];
                float v[8] = {bflo(lo.x) * e, bfhi(lo.x) * e, bflo(lo.y) * e, bfhi(lo.y) * e, bflo(hi.x) * e, bfhi(hi.x) * e, bflo(hi.y) * e, bfhi(hi.y) * e};
                st16_wt(rsrc, R_QG + f * 1024 + lane * 16, pack8(v));
            } else {
                const int g = f - 16; const int dblk = g >> 2, blk = (g >> 1) & 1, s = g & 1; const int d = 32 * dblk + r, c0 = 32 * blk + 16 * s + 4 * hh;
                const int rot = 8 * ((d >> 3) & 7);
                const u32x2 lo = *(const LAS u32x2*)(L + L_KNT + d * PT + ((c0 + rot) & 63) * 2), hi = *(const LAS u32x2*)(L + L_KNT + d * PT + ((c0 + 8 + rot) & 63) * 2);
                const f32x4 e0 = *(const LAS f32x4*)(sc_ekd + c0), e1 = *(const LAS f32x4*)(sc_ekd + c0 + 8);
                float v[8] = {bflo(lo.x) * e0[0], bfhi(lo.x) * e0[1], bflo(lo.y) * e0[2], bfhi(lo.y) * e0[3], bflo(hi.x) * e1[0], bfhi(hi.x) * e1[1], bflo(hi.y) * e1[2], bfhi(hi.y) * e1[3]};
                st16_wt(rsrc, R_KD + g * 1024 + lane * 16, pack8(v));
            }
        }
    }
    __syncthreads();
    {
        const int ct = wave >> 2, et = wave & 3, dt = wave & 3;
        f32x16 acc;
#pragma unroll
        for (int i = 0; i < 16; ++i) acc[i] = 0.f;
        const LAS unsigned char* Ab = L + L_TP + (32 * ct + r) * PT + hh * 16; const LAS unsigned char* Bb = L + L_VT + (32 * et + r) * PT; const int rotv = (4 * et + (r >> 3)) & 7;
#define ROTC(s_, hh_, rot_) ((((2 * (s_) + (hh_)) + (rot_)) & 7) * 16)
#pragma unroll
        for (int s = 0; s < 2; ++s) acc = __builtin_amdgcn_mfma_f32_32x32x16_bf16(*(const LAS bf16x8*)(Ab + s * 32), *(const LAS bf16x8*)(Bb + ROTC(s, hh, rotv)), acc, 0, 0, 0);
        if (ct) {
#pragma unroll
            for (int s = 2; s < 4; ++s) acc = __builtin_amdgcn_mfma_f32_32x32x16_bf16(*(const LAS bf16x8*)(Ab + s * 32), *(const LAS bf16x8*)(Bb + ROTC(s, hh, rotv)), acc, 0, 0, 0);
        }
        { u32x4 w0, w1; w0.x = cvtpk(acc[0], acc[1]); w0.y = cvtpk(acc[2], acc[3]); w0.z = cvtpk(acc[4], acc[5]); w0.w = cvtpk(acc[6], acc[7]);
          w1.x = cvtpk(acc[8], acc[9]); w1.y = cvtpk(acc[10], acc[11]); w1.z = cvtpk(acc[12], acc[13]); w1.w = cvtpk(acc[14], acc[15]);
          st16_wt(rsrc, R_U + (et * 2 + ct) * 2048 + lane * 32, w0); st16_wt(rsrc, R_U + (et * 2 + ct) * 2048 + lane * 32 + 16, w1); }
#pragma unroll
        for (int i = 0; i < 16; ++i) acc[i] = 0.f;
        Ab = L + L_KGT + (32 * dt + r) * PT; Bb = L + L_TP + (32 * ct + r) * PT + hh * 16;
#pragma unroll
        for (int s = 0; s < 2; ++s) acc = __builtin_amdgcn_mfma_f32_32x32x16_bf16(*(const LAS bf16x8*)(Ab + ROTC(s, hh, rotv)), *(const LAS bf16x8*)(Bb + s * 32), acc, 0, 0, 0);
        if (ct) {
#pragma unroll
            for (int s = 2; s < 4; ++s) acc = __builtin_amdgcn_mfma_f32_32x32x16_bf16(*(const LAS bf16x8*)(Ab + ROTC(s, hh, rotv)), *(const LAS bf16x8*)(Bb + s * 32), acc, 0, 0, 0);
        }
#undef ROTC
        { u32x4 w0, w1; w0.x = cvtpk(acc[0], acc[1]); w0.y = cvtpk(acc[2], acc[3]); w0.z = cvtpk(acc[4], acc[5]); w0.w = cvtpk(acc[6], acc[7]);
          w1.x = cvtpk(acc[8], acc[9]); w1.y = cvtpk(acc[10], acc[11]); w1.z = cvtpk(acc[12], acc[13]); w1.w = cvtpk(acc[14], acc[15]);
          const int f0 = (ct * 4 + dt) * 2;
          st16_wt(rsrc, R_W + f0 * 1024 + lane * 16, w0); st16_wt(rsrc, R_W + (f0 + 1) * 1024 + lane * 16, w1); }
    }
    pend = item;
}

constexpr int S_OP0 = 0, S_OP1 = 55296, S_OB0 = 110592, S_OB1 = 128000;
__device__ __forceinline__ float quad_xor1(float x) { return __builtin_bit_cast(float, __builtin_amdgcn_update_dpp(0, __builtin_bit_cast(int, x), 0xB1, 0xf, 0xf, false)); }
__device__ __forceinline__ float quad_xor2(float x) { return __builtin_bit_cast(float, __builtin_amdgcn_update_dpp(0, __builtin_bit_cast(int, x), 0x4E, 0xf, 0xf, false)); }
__device__ __forceinline__ void gdn_scan(Frame& F, const Args& A, int b, int h) {
    LAS unsigned char* L = F.lds;
    int tid = F.tid; asm volatile("" : "+v"(tid));
    const int lane = tid & 63, wave = F.wave;
    const unsigned char* rec0 = F.ws + WS_G + ((size_t)(b * 128) * 4 + h) * GREC;
    const size_t rstep = (size_t)4 * GREC;
    bf16_t* P = (bf16_t*)(F.ws + WS_C);
    const int r = lane & 31, hh = lane >> 5;
    auto stage = [&](int n) {
        const unsigned char* src = rec0 + (size_t)n * rstep; const int lw = wave - 4; const int ob = (n & 1) ? S_OP1 : S_OP0;
        for (int k = lw; k < 54; k += 4)
            __builtin_amdgcn_global_load_lds((const unsigned*)(src + k * 1024 + lane * 16), (LAS unsigned*)(L + ob + k * 1024), 16, 0, 0);
    };
    auto warm = [&](int n) {
        const unsigned char* src = rec0 + (size_t)(n < 127 ? n : 127) * rstep; const int lw = wave - 4;
#pragma unroll
        for (int k = 0; k < 3; ++k) { const int p = lw + 4 * k; const int off = (p < 9 ? p : p - 3) * 8192;
            __builtin_amdgcn_global_load_lds((const unsigned*)(src + off + lane * 128), (LAS unsigned*)(L + 145920 + lw * 256), 4, 0, 0); }
    };
    auto zstage = [&](int m) {
        const int lw = wave - 4;
#pragma unroll
        for (int k = 0; k < 4; ++k) { const int p = lw * 4 + k;
            const bf16_t* zp = P + ((size_t)b * SEQ + m * 64 + 4 * p + (lane >> 4)) * PP + C_GZ + h * 128 + (lane & 15) * 8;
            __builtin_amdgcn_global_load_lds((const unsigned*)zp, (LAS unsigned*)(L + 147456 + p * 1024), 16, 0, 0); }
    };
    unsigned* flags = (unsigned*)(F.ws + WS_CTL) + CW_FLG + (size_t)(b * 128) * 4 + h;
    auto ensure = [&](int first, int count) {
        unsigned spins = 0;
        for (;;) {
            const unsigned v = (lane < count) ? __hip_atomic_load(flags + 4 * (first + lane), __ATOMIC_RELAXED, __HIP_MEMORY_SCOPE_AGENT) : 1u;
            if (__ballot(v == 0u) == 0ull) break;
            __builtin_amdgcn_s_sleep(4);
            if (++spins > (1u << 20)) break;
        }
        __builtin_amdgcn_fence(__ATOMIC_ACQUIRE, "agent");
        asm volatile("s_waitcnt vmcnt(0)" ::: "memory");
    };
    if (wave == 4) ensure(0, 8);
    __syncthreads();
    if (wave >= 4) { stage(0);
        const unsigned char* src1 = rec0 + rstep; const int lw = wave - 4;
#pragma unroll
        for (int j = 0; j < 8; ++j) { const int k = lw + 4 * j; __builtin_amdgcn_global_load_lds((const unsigned*)(src1 + k * 1024 + lane * 16), (LAS unsigned*)(L + S_OP1 + k * 1024), 16, 0, 0); } }
    f32x16 S[4];
#pragma unroll
    for (int d = 0; d < 4; ++d)
#pragma unroll
        for (int i = 0; i < 16; ++i) S[d][i] = 0.f;
    u32x4 Uc[4]; float glc = 0.f;
    if (wave < 4) {
        const unsigned char* up = rec0 + R_U + wave * 4096 + lane * 32;
        Uc[0] = *(const u32x4*)(up); Uc[1] = *(const u32x4*)(up + 16); Uc[2] = *(const u32x4*)(up + 2048); Uc[3] = *(const u32x4*)(up + 2048 + 16);
        glc = *(const float*)(rec0 + R_GL);
    }
    LAS float* ogl = (LAS float*)(L + 145408);
    if (tid < 128) ogl[tid] = A.in[11][tid];
    asm volatile("s_waitcnt vmcnt(0)" ::: "memory");
    __syncthreads();
    unsigned* prog = (unsigned*)(F.ws + WS_CTL) + CW_PROG + 64 * (b * 4 + h);
    if (wave < 4) __builtin_amdgcn_s_setprio(3);
    for (int n = 0; n < 128; ++n) {
        if (tid == 0) __hip_atomic_store(prog, (unsigned)(n + 1), __ATOMIC_RELAXED, __HIP_MEMORY_SCOPE_AGENT);
        if (wave < 4) {
            const LAS unsigned char* ob = L + ((n & 1) ? S_OP1 : S_OP0) + lane * 16;
            f32x16 w0, w1, o0, o1;
#pragma unroll
            for (int i = 0; i < 16; ++i) { w0[i] = 0.f; w1[i] = 0.f; o0[i] = 0.f; o1[i] = 0.f; }
            bf16x8 sb[4][2];
#pragma unroll
            for (int d = 0; d < 4; ++d)
#pragma unroll
                for (int s = 0; s < 2; ++s) sb[d][s] = cvt8(S[d], s);
#pragma unroll
            for (int d = 0; d < 4; ++d)
#pragma unroll
                for (int s = 0; s < 2; ++s) {
                    w0 = __builtin_amdgcn_mfma_f32_32x32x16_bf16(*(const LAS bf16x8*)(ob + R_W + ((0 * 4 + d) * 2 + s) * 1024), sb[d][s], w0, 0, 0, 0);
                    w1 = __builtin_amdgcn_mfma_f32_32x32x16_bf16(*(const LAS bf16x8*)(ob + R_W + ((1 * 4 + d) * 2 + s) * 1024), sb[d][s], w1, 0, 0, 0);
                }
#define QGF(a_, d_, s_) (*(const LAS bf16x8*)(ob + R_QG + (((a_) * 4 + (d_)) * 2 + (s_)) * 1024))
            bf16x8 qa[4], qb[4];
            qa[0] = QGF(0, 0, 0); qa[1] = QGF(0, 0, 1); qa[2] = QGF(1, 0, 0); qa[3] = QGF(1, 0, 1);
            __builtin_amdgcn_sched_group_barrier(0x2, 32, 0);
            __builtin_amdgcn_sched_group_barrier(0x100, 8, 0);
#pragma unroll
            for (int g = 0; g < 12; ++g) { __builtin_amdgcn_sched_group_barrier(0x8, 1, 0); __builtin_amdgcn_sched_group_barrier(0x100, 1, 0); }
            __builtin_amdgcn_sched_group_barrier(0x8, 4, 0);
            __builtin_amdgcn_sched_barrier(0);
            const unsigned u0[8] = {Uc[0].x, Uc[0].y, Uc[0].z, Uc[0].w, Uc[1].x, Uc[1].y, Uc[1].z, Uc[1].w};
            const unsigned u1[8] = {Uc[2].x, Uc[2].y, Uc[2].z, Uc[2].w, Uc[3].x, Uc[3].y, Uc[3].z, Uc[3].w};
            bf16x8 vb[2][2];
            const float gl = glc;
#define QG_RUN(d_, qc_) do { o0 = __builtin_amdgcn_mfma_f32_32x32x16_bf16(qc_[0], sb[d_][0], o0, 0, 0, 0); o1 = __builtin_amdgcn_mfma_f32_32x32x16_bf16(qc_[2], sb[d_][0], o1, 0, 0, 0); \
                             o0 = __builtin_amdgcn_mfma_f32_32x32x16_bf16(qc_[1], sb[d_][1], o0, 0, 0, 0); o1 = __builtin_amdgcn_mfma_f32_32x32x16_bf16(qc_[3], sb[d_][1], o1, 0, 0, 0); } while (0)
#define QG_SGB(nds_) do { _Pragma("unroll") for (int g_ = 0; g_ < 4; ++g_) { __builtin_amdgcn_sched_group_barrier(0x8, 1, 0); if (nds_) __builtin_amdgcn_sched_group_barrier(0x100, 1, 0); __builtin_amdgcn_sched_group_barrier(0x2, 6, 0); } } while (0)
            qb[0] = QGF(0, 1, 0); qb[1] = QGF(0, 1, 1); qb[2] = QGF(1, 1, 0); qb[3] = QGF(1, 1, 1);
            QG_RUN(0, qa);
#pragma unroll
            for (int i = 0; i < 8; ++i) { w0[2 * i] = bflo(u0[i]) - w0[2 * i]; w0[2 * i + 1] = bfhi(u0[i]) - w0[2 * i + 1]; }
            QG_SGB(1); __builtin_amdgcn_sched_barrier(0);
            qa[0] = QGF(0, 2, 0); qa[1] = QGF(0, 2, 1); qa[2] = QGF(1, 2, 0); qa[3] = QGF(1, 2, 1);
            QG_RUN(1, qb);
            vb[0][0] = cvt8(w0, 0); vb[0][1] = cvt8(w0, 1);
#pragma unroll
            for (int i = 0; i < 4; ++i) { w1[2 * i] = bflo(u1[i]) - w1[2 * i]; w1[2 * i + 1] = bfhi(u1[i]) - w1[2 * i + 1]; }
            QG_SGB(1); __builtin_amdgcn_sched_barrier(0);
            qb[0] = QGF(0, 3, 0); qb[1] = QGF(0, 3, 1); qb[2] = QGF(1, 3, 0); qb[3] = QGF(1, 3, 1);
            QG_RUN(2, qa);
#pragma unroll
            for (int i = 4; i < 8; ++i) { w1[2 * i] = bflo(u1[i]) - w1[2 * i]; w1[2 * i + 1] = bfhi(u1[i]) - w1[2 * i + 1]; }
            vb[1][0] = cvt8(w1, 0); vb[1][1] = cvt8(w1, 1);
            QG_SGB(1); __builtin_amdgcn_sched_barrier(0);
            QG_RUN(3, qb);
#pragma unroll
            for (int d = 0; d < 2; ++d)
#pragma unroll
                for (int i = 0; i < 16; ++i) S[d][i] *= gl;
            QG_SGB(0);
#undef QGF
#undef QG_RUN
#undef QG_SGB
            __builtin_amdgcn_sched_barrier(0); asm volatile("" ::: "memory"); __builtin_amdgcn_s_barrier(); asm volatile("" ::: "memory"); __builtin_amdgcn_sched_barrier(0);
            bf16x8 qkf[6], kdA[8];
#pragma unroll
            for (int f = 0; f < 6; ++f) qkf[f] = *(const LAS bf16x8*)(ob + R_QK + f * 1024);
#pragma unroll
            for (int f = 0; f < 8; ++f) kdA[f] = *(const LAS bf16x8*)(ob + R_KD + f * 1024);
#pragma unroll
            for (int d = 2; d < 4; ++d)
#pragma unroll
                for (int i = 0; i < 16; ++i) S[d][i] *= gl;
            __builtin_amdgcn_sched_barrier(0);
            bf16x8 kdB[8];
#pragma unroll
            for (int f = 0; f < 8; ++f) kdB[f] = *(const LAS bf16x8*)(ob + R_KD + (8 + f) * 1024);
#pragma unroll
            for (int s = 0; s < 2; ++s) {
                o0 = __builtin_amdgcn_mfma_f32_32x32x16_bf16(qkf[0 + s], vb[0][s], o0, 0, 0, 0);
                o1 = __builtin_amdgcn_mfma_f32_32x32x16_bf16(qkf[2 + s], vb[0][s], o1, 0, 0, 0);
                o1 = __builtin_amdgcn_mfma_f32_32x32x16_bf16(qkf[4 + s], vb[1][s], o1, 0, 0, 0);
            }
            __builtin_amdgcn_sched_group_barrier(0x8, 2, 1);
            __builtin_amdgcn_sched_group_barrier(0x100, 8, 1);
            __builtin_amdgcn_sched_group_barrier(0x8, 4, 1);
            __builtin_amdgcn_sched_barrier(0);
            LAS unsigned char* obuf = L + ((n & 1) ? S_OB1 : S_OB0) + (wave * 32 + r) * 2;
#define OW2(ov_, base_, i_) do { const int r0_ = ((i_) & 3) + 8 * ((i_) >> 2) + 4 * hh, r1_ = (((i_) + 1) & 3) + 8 * (((i_) + 1) >> 2) + 4 * hh; \
                *(LAS unsigned short*)(obuf + ((base_) + r0_) * PQ) = (unsigned short)(cvtpk(ov_[(i_)], 0.f) & 0xffffu); \
                *(LAS unsigned short*)(obuf + ((base_) + r1_) * PQ) = (unsigned short)(cvtpk(ov_[(i_) + 1], 0.f) & 0xffffu); } while (0)
#pragma unroll
            for (int d = 0; d < 2; ++d)
#pragma unroll
                for (int bk = 0; bk < 2; ++bk)
#pragma unroll
                    for (int s = 0; s < 2; ++s) { const int g = (d * 2 + bk) * 2 + s;
                        S[d] = __builtin_amdgcn_mfma_f32_32x32x16_bf16(kdA[g], vb[bk][s], S[d], 0, 0, 0);
                        OW2(o0, 0, 2 * g);
                        __builtin_amdgcn_sched_barrier(0); }
            {   const int nn = (n + 1 < 128) ? n + 1 : 127;
                const unsigned char* up = rec0 + (size_t)nn * rstep + R_U + wave * 4096 + lane * 32;
                Uc[0] = *(const u32x4*)(up); Uc[1] = *(const u32x4*)(up + 16); Uc[2] = *(const u32x4*)(up + 2048); Uc[3] = *(const u32x4*)(up + 2048 + 16);
                glc = *(const float*)(rec0 + (size_t)nn * rstep + R_GL); }
            __builtin_amdgcn_sched_barrier(0);
#pragma unroll
            for (int d = 2; d < 4; ++d)
#pragma unroll
                for (int bk = 0; bk < 2; ++bk)
#pragma unroll
                    for (int s = 0; s < 2; ++s) { const int g = ((d - 2) * 2 + bk) * 2 + s;
                        S[d] = __builtin_amdgcn_mfma_f32_32x32x16_bf16(kdB[g], vb[bk][s], S[d], 0, 0, 0);
                        OW2(o1, 32, 2 * g);
                        __builtin_amdgcn_sched_barrier(0); }
#undef OW2
        } else {
            const int m = n - 1; const int tt = tid - 256, row = tt >> 2, qd = tt & 3;
            const size_t t = (size_t)b * SEQ + (m < 0 ? 0 : m) * 64 + row;
            u32x4 zv0, zv1, zv2, zv3;
            { const bf16_t* zp = P + t * PP + C_GZ + h * 128 + qd * 32;
              asm volatile("global_load_dwordx4 %0, %4, off\n\tglobal_load_dwordx4 %1, %4, off offset:16\n\tglobal_load_dwordx4 %2, %4, off offset:32\n\tglobal_load_dwordx4 %3, %4, off offset:48"
                           : "=&v"(zv0), "=&v"(zv1), "=&v"(zv2), "=&v"(zv3) : "v"(zp) : "memory"); }
            { const int nn = (n + 1 < 128) ? n + 1 : 127; const unsigned char* src = rec0 + (size_t)nn * rstep; const int lw = wave - 4; const int obn = (nn & 1) ? S_OP1 : S_OP0;
#pragma unroll
              for (int j = 8; j < 14; ++j) { const int k = lw + 4 * j;
                  if (k < 54) __builtin_amdgcn_global_load_lds((const unsigned*)(src + k * 1024 + lane * 16), (LAS unsigned*)(L + obn + k * 1024), 16, 0, 0);
                  else __builtin_amdgcn_global_load_lds((const unsigned*)(src + lane * 16), (LAS unsigned*)(L + 147456 + (lw & 1) * 1024), 16, 0, 0); } }
            float v[32]; float ssq = 0.f;
            if (n >= 1) {
                const LAS unsigned char* ob = L + ((m & 1) ? S_OB1 : S_OB0) + row * PQ + qd * 64;
#pragma unroll
                for (int k = 0; k < 4; ++k) {
                    const u32x4 o4 = *(const LAS u32x4*)(ob + k * 16);
                    const unsigned ow[4] = {o4.x, o4.y, o4.z, o4.w};
#pragma unroll
                    for (int i = 0; i < 4; ++i) { v[k * 8 + 2 * i] = bflo(ow[i]); v[k * 8 + 2 * i + 1] = bfhi(ow[i]); }
                }
#pragma unroll
                for (int i = 0; i < 32; ++i) ssq += v[i] * v[i];
            } else {
#pragma unroll
                for (int i = 0; i < 32; ++i) v[i] = 0.f;
            }
            if (n >= 2) asm volatile("s_waitcnt vmcnt(22)" ::: "memory"); else asm volatile("s_waitcnt vmcnt(18)" ::: "memory");
            __builtin_amdgcn_s_barrier();
            { const int nn = (n + 2 < 128) ? n + 2 : 127; const unsigned char* src = rec0 + (size_t)nn * rstep; const int lw = wave - 4; const int obn = (n & 1) ? S_OP1 : S_OP0;
#pragma unroll
              for (int j = 0; j < 8; ++j) { const int k = lw + 4 * j;
                  __builtin_amdgcn_global_load_lds((const unsigned*)(src + k * 1024 + lane * 16), (LAS unsigned*)(L + obn + k * 1024), 16, 0, 0); } }
            asm volatile("s_waitcnt vmcnt(14)" : "+v"(zv0), "+v"(zv1), "+v"(zv2), "+v"(zv3) :: "memory");
            const u32x4 zv[4] = {zv0, zv1, zv2, zv3};
            if (n >= 1) {
                float z[32];
#pragma unroll
                for (int k = 0; k < 4; ++k) {
                    const unsigned zw[4] = {zv[k].x, zv[k].y, zv[k].z, zv[k].w};
#pragma unroll
                    for (int i = 0; i < 4; ++i) { z[k * 8 + 2 * i] = bflo(zw[i]); z[k * 8 + 2 * i + 1] = bfhi(zw[i]); }
                }
                ssq += quad_xor1(ssq); ssq += quad_xor2(ssq);
                const float rs = __builtin_amdgcn_rsqf(ssq * (1.0f / 128) + EPS);
#pragma unroll
                for (int k = 0; k < 4; ++k) {
                    float o[8];
#pragma unroll
                    for (int i = 0; i < 8; ++i) o[i] = v[k * 8 + i] * rs * z[k * 8 + i];
                    *(u32x4*)(P + t * PP + h * 128 + qd * 32 + k * 8) = pack8(o);
                }
            }
            if (n >= 2) asm volatile("s_waitcnt vmcnt(26)" ::: "memory"); else asm volatile("s_waitcnt vmcnt(22)" ::: "memory");
            if (wave == 4 && n + 3 < 128 && ((n + 3) & 31) == 8) ensure(n + 3, (n + 3 + 32 <= 128) ? 32 : 128 - (n + 3));
        }
        asm volatile("s_waitcnt lgkmcnt(0)" ::: "memory"); __builtin_amdgcn_s_barrier(); asm volatile("" ::: "memory");
    }
    __builtin_amdgcn_s_setprio(0);
    asm volatile("s_waitcnt vmcnt(0)" ::: "memory");
    if (tid == 0) __hip_atomic_store(prog, 1000u, __ATOMIC_RELAXED, __HIP_MEMORY_SCOPE_AGENT);
    if (wave >= 4) {
        const int m = 127; const int tt = tid - 256, row = tt >> 2, qd = tt & 3;
        const LAS unsigned char* ob = L + ((m & 1) ? S_OB1 : S_OB0) + row * PQ + qd * 64;
        const size_t t = (size_t)b * SEQ + m * 64 + row;
        float ssq = 0.f; float v[32], z[32];
#pragma unroll
        for (int k = 0; k < 4; ++k) {
            const u32x4 o4 = *(const LAS u32x4*)(ob + k * 16), z4 = *(const u32x4*)(P + t * PP + C_GZ + h * 128 + qd * 32 + k * 8);
            const unsigned ow[4] = {o4.x, o4.y, o4.z, o4.w}, zw[4] = {z4.x, z4.y, z4.z, z4.w};
#pragma unroll
            for (int i = 0; i < 4; ++i) { v[k * 8 + 2 * i] = bflo(ow[i]); v[k * 8 + 2 * i + 1] = bfhi(ow[i]); z[k * 8 + 2 * i] = bflo(zw[i]); z[k * 8 + 2 * i + 1] = bfhi(zw[i]); }
        }
#pragma unroll
        for (int i = 0; i < 32; ++i) ssq += v[i] * v[i];
        ssq += quad_xor1(ssq); ssq += quad_xor2(ssq);
        const float rs = __builtin_amdgcn_rsqf(ssq * (1.0f / 128) + EPS);
#pragma unroll
        for (int k = 0; k < 4; ++k) {
            float o[8];
#pragma unroll
            for (int i = 0; i < 8; ++i) o[i] = v[k * 8 + i] * rs * z[k * 8 + i];
            *(u32x4*)(P + t * PP + h * 128 + qd * 32 + k * 8) = pack8(o);
        }
    }
}


__device__ __forceinline__ void scan_helper(Frame& F, int i, int part) {
    LAS unsigned char* L = F.lds; const int lane = F.lane, wave = F.wave;
#if HELP2
    const int tid = F.tid & 255; constexpr int HSTRIDE = 256; i += 8 * (wave >> 2);
#else
    const int tid = F.tid; constexpr int HSTRIDE = NTHREADS;
#endif
    const int b = i >> 2, h = i & 3;
    const unsigned char* rec0 = F.ws + WS_G + ((size_t)(b * 128) * 4 + h) * GREC; const size_t rstep = (size_t)4 * GREC;
    const bf16_t* P = (const bf16_t*)(F.ws + WS_C);
    unsigned* prog = (unsigned*)(F.ws + WS_CTL) + CW_PROG + 64 * i;
    constexpr int LA = 8;
    for (int n = 1; n < 128; ++n) {
        unsigned spins = 0;
        for (;;) {
            const unsigned p = __builtin_amdgcn_readfirstlane(__hip_atomic_load(prog, __ATOMIC_RELAXED, __HIP_MEMORY_SCOPE_AGENT));
            const unsigned f = __builtin_amdgcn_readfirstlane(__hip_atomic_load((unsigned*)(F.ws + WS_CTL) + CW_FLG + ((size_t)(b * 128 + n) * 4 + h), __ATOMIC_RELAXED, __HIP_MEMORY_SCOPE_AGENT));
            if ((int)p + LA >= n && f != 0u) break;
            __builtin_amdgcn_s_sleep(8);
            if (++spins > 20000u) break;
        }
        constexpr int NL = 576 / NHELP;
        for (int line = tid; line < NL + (part == 0 ? 128 : 0); line += HSTRIDE) {
        if (line < NL) __builtin_amdgcn_global_load_lds((const unsigned*)(rec0 + (size_t)n * rstep + part * (NL * 128) + line * 128), (LAS unsigned*)(L + wave * 256), 4, 0, 0);
        else { const int zl = line - NL; const int row = zl >> 1, hf = zl & 1;
            __builtin_amdgcn_global_load_lds((const unsigned*)(P + ((size_t)b * SEQ + n * 64 + row) * PP + C_GZ + h * 128 + hf * 64), (LAS unsigned*)(L + wave * 256), 4, 0, 0); }
        }
        asm volatile("s_waitcnt vmcnt(4)" ::: "memory");
    }
    asm volatile("s_waitcnt vmcnt(0)" ::: "memory");
}

constexpr size_t WS_IMG = 460 * MiB;
constexpr size_t WS_IMGM = 492 * MiB;
constexpr int CW_QUEUE = 8192;
constexpr float LOG2E = 1.4426950408889634f;

__device__ __forceinline__ void img_item(Frame& F, const Args& A, int item) {
    LAS unsigned char* L = F.lds; int tid = F.tid; asm volatile("" : "+v"(tid));
    const bool mem = item >= 512; const int bh = mem ? item - 512 : item >> 5, j = item & 31, b = bh >> 2, h = bh & 3;
    unsigned char* img = F.ws + (mem ? WS_IMGM + (size_t)bh * 65536 : WS_IMG + ((size_t)bh * 32 + j) * 65536);
    const __amdgpu_buffer_rsrc_t irs = __builtin_amdgcn_make_buffer_rsrc(img, 0, 65536, 0x00020000);
    const int key = tid >> 1, half = tid & 1;
    LAS unsigned* TK = (LAS unsigned*)L;
    LAS unsigned* TV = TK + 256 * 33;
    LAS float* part = (LAS float*)(TV + 256 * 33);
    float kv[32], vv[32];
    if (!mem) {
        const bf16_t* P = (const bf16_t*)(F.ws + WS_C); const size_t t = (size_t)b * SEQ + j * 256 + key;
#pragma unroll
        for (int c4 = 0; c4 < 4; ++c4) {
            const u32x4 kw = *(const u32x4*)(P + t * PP + C_MK + h * 64 + half * 32 + c4 * 8), vw = *(const u32x4*)(P + t * PP + C_MV + h * 64 + half * 32 + c4 * 8);
            const unsigned ka[4] = {kw.x, kw.y, kw.z, kw.w}, va[4] = {vw.x, vw.y, vw.z, vw.w};
#pragma unroll
            for (int i = 0; i < 4; ++i) { kv[c4 * 8 + 2 * i] = bflo(ka[i]); kv[c4 * 8 + 2 * i + 1] = bfhi(ka[i]); vv[c4 * 8 + 2 * i] = bflo(va[i]); vv[c4 * 8 + 2 * i + 1] = bfhi(va[i]); }
        }
    } else {
        const float* KV = (const float*)(F.ws + WS_KVMEM) + ((size_t)b * MEMT + key) * 512 + h * 64 + half * 32;
#pragma unroll
        for (int c4 = 0; c4 < 8; ++c4) { const f32x4 kw = *(const f32x4*)(KV + c4 * 4), vw = *(const f32x4*)(KV + 256 + c4 * 4);
#pragma unroll
            for (int i = 0; i < 4; ++i) { kv[c4 * 4 + i] = kw[i]; vv[c4 * 4 + i] = vw[i]; } }
    }
    float ss = 0.f;
#pragma unroll
    for (int i = 0; i < 32; ++i) ss += kv[i] * kv[i];
    ss += __shfl_xor(ss, 1);
    const float rs = __builtin_amdgcn_rsqf(ss * (1.0f / 64) + EPS);
    const float* kg = (mem ? A.in[17] : A.in[13]) + half * 32;
    unsigned kp[16], vp[16];
#pragma unroll
    for (int i = 0; i < 16; ++i) { kp[i] = cvtpk(kv[2 * i] * rs * kg[2 * i], kv[2 * i + 1] * rs * kg[2 * i + 1]); vp[i] = cvtpk(vv[2 * i], vv[2 * i + 1]); }
#pragma unroll
    for (int i = 0; i < 16; ++i) { TK[key * 33 + half * 16 + i] = kp[i]; TV[key * 33 + half * 16 + i] = vp[i]; }
#pragma unroll
    for (int cc = 0; cc < 4; ++cc) { const int ch = half * 4 + cc; u32x4 w; w.x = kp[cc * 4]; w.y = kp[cc * 4 + 1]; w.z = kp[cc * 4 + 2]; w.w = kp[cc * 4 + 3];
        if (mem) st16_wt(irs, key * 128 + ((ch ^ ((key >> 1) & 7)) * 16), w); else *(u32x4*)(img + key * 128 + ((ch ^ ((key >> 1) & 7)) * 16)) = w; }
    __syncthreads();
    const LAS unsigned short* TKh = (const LAS unsigned short*)TK; const LAS unsigned short* TVh = (const LAS unsigned short*)TV;
    if (!mem) { const int d = tid & 63, kq = tid >> 6; float a = 0.f;
#pragma unroll 8
        for (int k = 0; k < 32; ++k) a += bf2f(TKh[(kq * 32 + k) * 66 + d]);
        part[kq * 64 + d] = a; }
    {
        const int d = tid >> 3, pt = tid & 7;
#pragma unroll
        for (int cc = 0; cc < 4; ++cc) { const int ch = pt * 4 + cc; unsigned short e[8];
#pragma unroll
            for (int x = 0; x < 8; ++x) { const int pos = ch * 8 + x, kt = pos >> 5, p5 = pos & 31; const int kap = (p5 & 16) | ((p5 & 4) << 1) | ((p5 & 8) >> 1) | (p5 & 3);
                e[x] = TVh[(kt * 32 + kap) * 66 + d]; }
            u32x4 w; w.x = e[0] | ((unsigned)e[1] << 16); w.y = e[2] | ((unsigned)e[3] << 16); w.z = e[4] | ((unsigned)e[5] << 16); w.w = e[6] | ((unsigned)e[7] << 16);
            if (mem) st16_wt(irs, 32768 + d * 512 + ((ch ^ (d & 15)) * 16), w); else *(u32x4*)(img + 32768 + d * 512 + ((ch ^ (d & 15)) * 16)) = w; }
    }
    __syncthreads();
    if (!mem && tid < 64) { float a = 0.f;
#pragma unroll
        for (int k = 0; k < 8; ++k) a += part[k * 64 + tid];
        ((float*)(F.ws + WS_KMEAN))[((size_t)bh * 32 + j) * 64 + tid] = a * (1.0f / 256); }
    if (mem) {
        asm volatile("s_waitcnt vmcnt(0)" ::: "memory");
        __syncthreads();
        if (tid == 0) __hip_atomic_fetch_add((unsigned*)(F.ws + WS_CTL) + CW_MDONE, 1u, __ATOMIC_RELAXED, __HIP_MEMORY_SCOPE_AGENT);
    }
    __syncthreads();
}

__device__ __forceinline__ void attn_item(Frame& F, const Args& A, const int kind, const int bh, const int c) {
    LAS unsigned char* L = F.lds; int tid = F.tid; asm volatile("" : "+v"(tid)); const int lane = tid & 63, wave = F.wave;
    const int b = bh >> 2, h = bh & 3, r = lane & 31, hh = lane >> 5;
    bf16_t* P = (bf16_t*)(F.ws + WS_C);
    const unsigned char* img0 = F.ws + (kind ? WS_IMGM + (size_t)bh * 65536 : WS_IMG + (size_t)bh * 32 * 65536);
    const int nb = kind ? 1 : c + 1, nst = 2 * nb;
    auto stage = [&](int st) {
        const unsigned char* src = img0 + (size_t)(st >> 1) * 65536; const int hf = st & 1; LAS unsigned char* dst = L + (st & 3) * 32768;
#pragma unroll
        for (int k = 0; k < 4; ++k) { const int p = wave * 4 + k;
            if (p < 16) __builtin_amdgcn_global_load_lds((const unsigned*)(src + hf * 16384 + p * 1024 + lane * 16), (LAS unsigned*)(dst + p * 1024), 16, 0, 0);
            else { const int pp = p - 16;
                __builtin_amdgcn_global_load_lds((const unsigned*)(src + 32768 + (4 * pp + (lane >> 4)) * 512 + hf * 256 + (lane & 15) * 16), (LAS unsigned*)(dst + 16384 + pp * 1024), 16, 0, 0); } }
    };
    LAS float* KM = (LAS float*)(L + 131072);
    if (!kind) { const float* kmg = (const float*)(F.ws + WS_KMEAN) + (size_t)bh * 32 * 64; for (int i = tid; i < c * 64; i += NTHREADS) KM[i] = kmg[i]; }
    const int qloc = 32 * wave + r, qpos = c * 256 + qloc; const size_t t = (size_t)b * SEQ + qpos;
    const bf16_t* qp = P + t * PP + (kind ? C_CQ : C_MQ) + h * 64;
    const float* qgain = kind ? A.in[16] : A.in[12]; const float* kgain = kind ? A.in[17] : A.in[13];
    const float mq = wave_max(fabsf(qgain[lane])), mk = wave_max(fabsf(kgain[lane]));
    const float M2 = (8.0f * mq * mk * 1.02f + 0.05f) * LOG2E;
    const float slope2 = kind ? 0.f : exp2f(-2.0f * (float)(h + 1)) * LOG2E;
    float qg[32];
    {
#pragma unroll
        for (int c4 = 0; c4 < 4; ++c4) { const u32x4 w = *(const u32x4*)(qp + hh * 32 + c4 * 8); const unsigned wa[4] = {w.x, w.y, w.z, w.w};
#pragma unroll
            for (int i = 0; i < 4; ++i) { qg[c4 * 8 + 2 * i] = bflo(wa[i]); qg[c4 * 8 + 2 * i + 1] = bfhi(wa[i]); } }
    }
    float ss = 0.f;
#pragma unroll
    for (int i = 0; i < 32; ++i) ss += qg[i] * qg[i];
    ss += __shfl_xor(ss, 32);
    const float rs = __builtin_amdgcn_rsqf(ss * (1.0f / 64) + EPS);
    bf16x8 Qf[4];
#pragma unroll
    for (int s = 0; s < 4; ++s) { const int d0 = 16 * s + 8 * hh; const u32x4 w = *(const u32x4*)(qp + d0); const unsigned wa[4] = {w.x, w.y, w.z, w.w}; const float sc = rs * (0.125f * LOG2E);
        float v[8];
#pragma unroll
        for (int i = 0; i < 4; ++i) { v[2 * i] = bflo(wa[i]) * sc * qgain[d0 + 2 * i]; v[2 * i + 1] = bfhi(wa[i]) * sc * qgain[d0 + 2 * i + 1]; }
        Qf[s] = __builtin_bit_cast(bf16x8, pack8(v)); }
    unsigned selmask = 0u;
    if (!kind) {
#pragma unroll
        for (int i = 0; i < 32; ++i) qg[i] *= rs * qgain[hh * 32 + i];
    }
    asm volatile("s_waitcnt vmcnt(0)" : "+v"(qg[0]), "+v"(qg[31]) :: "memory");
    __syncthreads();
    stage(0); stage(1); if (nst > 2) stage(2);
    if (!kind && c > 0) {
        float v0 = -INFINITY, v1 = -INFINITY, v2 = -INFINITY; int i0 = -1, i1 = -1, i2 = -1;
        for (int j = 0; j < c; ++j) {
            const LAS f32x4* km = (const LAS f32x4*)(KM + j * 64 + hh * 32);
            float g = 0.f;
#pragma unroll
            for (int k = 0; k < 8; ++k) { const f32x4 m4 = km[k]; g += qg[4 * k] * m4[0] + qg[4 * k + 1] * m4[1] + qg[4 * k + 2] * m4[2] + qg[4 * k + 3] * m4[3]; }
            g += __shfl_xor(g, 32);
            if (g > v0) { v2 = v1; i2 = i1; v1 = v0; i1 = i0; v0 = g; i0 = j; }
            else if (g > v1) { v2 = v1; i2 = i1; v1 = g; i1 = j; }
            else if (g > v2) { v2 = g; i2 = j; }
        }
        if (i0 >= 0) selmask |= 1u << i0; if (i1 >= 0) selmask |= 1u << i1; if (i2 >= 0) selmask |= 1u << i2;
    }
    unsigned chs[4];
#pragma unroll
    for (int s = 0; s < 4; ++s) chs[s] = (unsigned)(r * 128 + (((2 * s + hh) ^ ((r >> 1) & 7)) * 16));
    const float lo4 = slope2 * (float)(4 * hh);
    f32x16 O0, O1;
#pragma unroll
    for (int i = 0; i < 16; ++i) { O0[i] = 0.f; O1[i] = 0.f; }
    float lsum = 0.f;
    for (int st = 0; st < nst; ++st) {
        const int younger = (nst - 1 - st) < 2 ? (nst - 1 - st) : 2;
        if (younger == 2) asm volatile("s_waitcnt vmcnt(8)" ::: "memory"); else if (younger == 1) asm volatile("s_waitcnt vmcnt(4)" ::: "memory"); else asm volatile("s_waitcnt vmcnt(0)" ::: "memory");
        asm volatile("s_waitcnt lgkmcnt(0)" ::: "memory"); __builtin_amdgcn_s_barrier(); asm volatile("" ::: "memory");
        if (st + 3 < nst) stage(st + 3);
        const int i = st >> 1, hf = st & 1;
        const bool own = (!kind) && (i == c);
        bool sel = true; if (!kind && !own) sel = (selmask >> i) & 1u;
        if (__ballot(sel) == 0ull) continue;
        const float laneoff = sel ? (slope2 * (float)(256 * i - qpos) - M2) : -INFINITY;
        const int ktmax = own ? wave : 7;
        const LAS unsigned char* kb = L + (st & 3) * 32768; const LAS unsigned char* vb = kb + 16384 + r * 256;
        const int nkt = (ktmax - 4 * hf + 1) < 4 ? (ktmax - 4 * hf + 1) : 4;
        if (nkt <= 0) continue;
        bf16x8 kf[4];
#pragma unroll
        for (int s = 0; s < 4; ++s) kf[s] = *(const LAS bf16x8*)(kb + chs[s]);
#pragma unroll 1
        for (int ktl = 0; ktl < nkt; ++ktl) {
            const int kt = 4 * hf + ktl;
            f32x16 C; const float lo = laneoff + slope2 * (float)(32 * kt) + lo4;
#pragma unroll
            for (int x = 0; x < 16; ++x) C[x] = slope2 * (float)((x & 3) + 8 * (x >> 2)) + lo;
#pragma unroll
            for (int s = 0; s < 4; ++s) C = __builtin_amdgcn_mfma_f32_32x32x16_bf16(kf[s], Qf[s], C, 0, 0, 0);
            const unsigned c0 = (unsigned)(((4 * ktl + hh) ^ (r & 15)) * 16), c1 = (unsigned)(((4 * ktl + 2 + hh) ^ (r & 15)) * 16);
            const bf16x8 vf0 = *(const LAS bf16x8*)(vb + c0), vf1 = *(const LAS bf16x8*)(vb + 32 * 256 + c0);
            const bf16x8 vf2 = *(const LAS bf16x8*)(vb + c1), vf3 = *(const LAS bf16x8*)(vb + 32 * 256 + c1);
            const int kn = (ktl + 1 < nkt) ? ktl + 1 : ktl;
#pragma unroll
            for (int s = 0; s < 4; ++s) kf[s] = *(const LAS bf16x8*)(kb + kn * 4096 + chs[s]);
            __builtin_amdgcn_sched_barrier(0);
            if (own && kt == wave) {
#pragma unroll
                for (int x = 0; x < 16; ++x) if ((x & 3) + 8 * (x >> 2) + 4 * hh > r) C[x] = -INFINITY;
            }
#pragma unroll
            for (int x = 0; x < 16; ++x) C[x] = __builtin_amdgcn_exp2f(C[x]);
            const float ps = (((C[0] + C[1]) + (C[2] + C[3])) + ((C[4] + C[5]) + (C[6] + C[7]))) + (((C[8] + C[9]) + (C[10] + C[11])) + ((C[12] + C[13]) + (C[14] + C[15])));
            lsum += ps;
            const bf16x8 p0 = cvt8(C, 0), p1 = cvt8(C, 1);
            O0 = __builtin_amdgcn_mfma_f32_32x32x16_bf16(vf0, p0, O0, 0, 0, 0);
            O1 = __builtin_amdgcn_mfma_f32_32x32x16_bf16(vf1, p0, O1, 0, 0, 0);
            O0 = __builtin_amdgcn_mfma_f32_32x32x16_bf16(vf2, p1, O0, 0, 0, 0);
            O1 = __builtin_amdgcn_mfma_f32_32x32x16_bf16(vf3, p1, O1, 0, 0, 0);
        }
    }
    lsum += __shfl_xor(lsum, 32);
    const float inv = 1.0f / lsum;
    bf16_t* yp = P + t * PP + (kind ? 768 : 512) + h * 64 + 4 * hh;
#pragma unroll
    for (int g = 0; g < 4; ++g) {
        u32x2 w0, w1; w0.x = cvtpk(O0[4 * g] * inv, O0[4 * g + 1] * inv); w0.y = cvtpk(O0[4 * g + 2] * inv, O0[4 * g + 3] * inv);
        w1.x = cvtpk(O1[4 * g] * inv, O1[4 * g + 1] * inv); w1.y = cvtpk(O1[4 * g + 2] * inv, O1[4 * g + 3] * inv);
        *(u32x2*)(yp + 8 * g) = w0; *(u32x2*)(yp + 32 + 8 * g) = w1;
    }
}

__device__ __forceinline__ void p4b_attn(Frame& F, const Args& A, int pass) {
    LAS unsigned* qw = (LAS unsigned*)(F.lds + 140000);
    unsigned* heads = (unsigned*)(F.ws + WS_CTL) + CW_QUEUE + 1024 * pass;
    const int myq = (int)(xb_xcc_id() & 7u);
    bool mem_ready = false;
    unsigned live = 0xffu;
    for (int qi = 0; qi < 8; ++qi) {
        const int q = (myq + qi) & 7;
        if (qi == 1) {
            __syncthreads();
            if (F.tid < 8) { const unsigned hv = __hip_atomic_load(heads + 64 * F.tid, __ATOMIC_RELAXED, __HIP_MEMORY_SCOPE_AGENT); const unsigned long long bm = __ballot(hv < 128u); if (F.tid == 0) *qw = (unsigned)bm; }
            __syncthreads();
            live = *qw & 0xffu;
        }
        if (!((live >> q) & 1u)) continue;
        for (;;) {
            __syncthreads();
            if (F.tid == 0) *qw = atomicAdd(heads + 64 * q, 1u);
            __syncthreads();
            const int idx = (int)*qw;
            if (idx >= 128) break;
            const int bh = 2 * q + (idx & 1);
            if (idx < 64) attn_item(F, A, 0, bh, 31 - (idx >> 1));
            else {
                if (!mem_ready) {
                    if (F.wave == 0) { unsigned spins = 0;
                        while (__hip_atomic_load((unsigned*)(F.ws + WS_CTL) + CW_MDONE, __ATOMIC_RELAXED, __HIP_MEMORY_SCOPE_AGENT) < 16u) { __builtin_amdgcn_s_sleep(4); if (++spins > (1u << 20)) break; }
                        __builtin_amdgcn_fence(__ATOMIC_ACQUIRE, "agent"); asm volatile("s_waitcnt vmcnt(0)" ::: "memory"); }
                    __syncthreads(); mem_ready = true;
                }
                attn_item(F, A, 1, bh, (idx - 64) >> 1);
            }
        }
    }
}

__device__ __forceinline__ void naive_gdn(Frame& F, const Args& A, int b, int h) {
    unsigned char* ws = F.ws;
    LAS float* vec = (LAS float*)F.lds;
    LAS float* ba = vec + 32 * 384;
    LAS float* part = ba + 64;
    LAS float* part2 = part + 512;
    LAS float* obuf = part2 + 512;
    const int tid = F.tid, e = tid & 127, dq = tid >> 7;
    const bf16_t* GQ = (const bf16_t*)(ws + WS_GQ); const bf16_t* GK = (const bf16_t*)(ws + WS_GK); const bf16_t* GV = (const bf16_t*)(ws + WS_GV);
    const float* GB = (const float*)(ws + WS_GB); const float* GG = (const float*)(ws + WS_GG);
    bf16_t* P = (bf16_t*)(ws + WS_C);
    const float* og = A.in[11];
    float S[32];
#pragma unroll
    for (int i = 0; i < 32; ++i) S[i] = 0.f;
    for (int c0 = 0; c0 < SEQ; c0 += 32) {
        __syncthreads();
        for (int i = tid; i < 32 * 384; i += NTHREADS) { const int tk = i / 384, r = i % 384; const size_t t = (size_t)b * SEQ + c0 + tk;
            const bf16_t* src = (r < 128) ? GQ : (r < 256) ? GK : GV;
            vec[i] = bf2f(src[t * 512 + h * 128 + (r & 127)]); }
        if (tid < 32) { const size_t t = (size_t)b * SEQ + c0 + tid; ba[tid * 2] = GB[t * 4 + h]; ba[tid * 2 + 1] = __expf(GG[t * 4 + h]); }
        __syncthreads();
        for (int tk = 0; tk < 32; ++tk) {
            const LAS float* qq = vec + tk * 384 + 32 * dq; const LAS float* kk = qq + 128; const float vv = vec[tk * 384 + 256 + e];
            const float beta = ba[tk * 2], alpha = ba[tk * 2 + 1];
            float p = 0.f;
#pragma unroll
            for (int i = 0; i < 32; ++i) p += S[i] * kk[i];
            part[dq * 128 + e] = p;
            __syncthreads();
            const float Sk = (part[e] + part[128 + e]) + (part[256 + e] + part[384 + e]);
            const float vn = beta * (vv - alpha * Sk);
            float po = 0.f;
#pragma unroll
            for (int i = 0; i < 32; ++i) { S[i] = alpha * S[i] + kk[i] * vn; po += S[i] * qq[i]; }
            part2[dq * 128 + e] = po;
            __syncthreads();
            if (dq == 0) obuf[tk * 128 + e] = (part2[e] + part2[128 + e]) + (part2[256 + e] + part2[384 + e]);
        }
        __syncthreads();
        { const int r = tid >> 4, cb = (tid & 15) * 8; const size_t t = (size_t)b * SEQ + c0 + r;
            float v[8]; float s = 0.f;
#pragma unroll
            for (int i = 0; i < 8; ++i) { v[i] = obuf[r * 128 + cb + i]; s += v[i] * v[i]; }
#pragma unroll
            for (int o = 1; o < 16; o <<= 1) s += __shfl_xor(s, o);
            const float rs = __builtin_amdgcn_rsqf(s * (1.0f / 128) + EPS);
            const u32x4 zw = *(const u32x4*)(P + t * PP + C_GZ + h * 128 + cb);
            float z[8] = {bflo(zw.x), bfhi(zw.x), bflo(zw.y), bfhi(zw.y), bflo(zw.z), bfhi(zw.z), bflo(zw.w), bfhi(zw.w)};
            float o[8];
#pragma unroll
            for (int i = 0; i < 8; ++i) o[i] = v[i] * rs * og[cb + i] * z[i];
            u32x4 w; w.x = pk2(o[0], o[1]); w.y = pk2(o[2], o[3]); w.z = pk2(o[4], o[5]); w.w = pk2(o[6], o[7]);
            *(u32x4*)(P + t * PP + h * 128 + cb) = w; }
    }
}

__device__ __forceinline__ void naive_moba_query(Frame& F, const Args& A, int t, int h, LAS float* sc, LAS float* qs) {
    unsigned char* ws = F.ws; const int lane = F.lane;
    bf16_t* P = (bf16_t*)(ws + WS_C);
    const bf16_t* KNM = (const bf16_t*)(ws + WS_KNM); const float* KM = (const float*)(ws + WS_KMEAN);
    const int b = t >> 13, tl = t & (SEQ - 1), own = tl >> 8, bh = b * 4 + h;
    const float qraw = bf2f(P[(size_t)t * PP + C_MQ + h * 64 + lane]);
    const float qh = qraw * __builtin_amdgcn_rsqf(wave_sum(qraw * qraw) * (1.0f / 64) + EPS) * A.in[12][lane];
    qs[lane] = qh;
    float mygate = -INFINITY;
    for (int j = 0; j < own; ++j) { const float g = wave_sum(qh * KM[((size_t)bh * 32 + j) * 64 + lane]); if (lane == j) mygate = g; }
    const int nsel = own < 3 ? own : 3;
    int sel0 = 0, sel1 = 0, sel2 = 0;
#pragma unroll
    for (int r = 0; r < 3; ++r) {
        if (r < nsel) {
            const float mx = wave_max(mygate);
            const unsigned long long bal = __ballot(mygate == mx);
            const int idx = __builtin_ctzll(bal);
            if (r == 0) sel0 = idx; else if (r == 1) sel1 = idx; else sel2 = idx;
            if (lane == idx) mygate = -INFINITY;
        }
    }
#define SELBLK(bi) (((bi) >= nsel) ? own : ((bi) == 0 ? sel0 : ((bi) == 1 ? sel1 : sel2)))
    const float slope = exp2f(-2.0f * (float)(h + 1));
    asm volatile("s_waitcnt lgkmcnt(0)" ::: "memory");
    float m = -INFINITY;
    const int nblk = nsel + 1;
    for (int bi = 0; bi < nblk; ++bi) {
        const int blk = SELBLK(bi);
        for (int kc = 0; kc < 4; ++kc) {
            const int key = blk * 256 + kc * 64 + lane;
            const u32x4* kp = (const u32x4*)(KNM + ((size_t)bh * SEQ + key) * 64);
            float dot = 0.f;
#pragma unroll
            for (int c = 0; c < 8; ++c) { const u32x4 w = kp[c];
                dot += qs[c * 8 + 0] * bflo(w.x) + qs[c * 8 + 1] * bfhi(w.x) + qs[c * 8 + 2] * bflo(w.y) + qs[c * 8 + 3] * bfhi(w.y)
                     + qs[c * 8 + 4] * bflo(w.z) + qs[c * 8 + 5] * bfhi(w.z) + qs[c * 8 + 6] * bflo(w.w) + qs[c * 8 + 7] * bfhi(w.w); }
            float s = dot * 0.125f - slope * (float)(tl - key);
            if (key > tl) s = -INFINITY;
            sc[bi * 256 + kc * 64 + lane] = s; m = fmaxf(m, s);
        }
    }
    m = wave_max(m);
    float l = 0.f;
    for (int i = lane; i < nblk * 256; i += 64) { const float p = __expf(sc[i] - m); sc[i] = p; l += p; }
    l = wave_sum(l);
    asm volatile("s_waitcnt lgkmcnt(0)" ::: "memory");
    float o = 0.f;
    for (int bi = 0; bi < nblk; ++bi) {
        const int blk = SELBLK(bi);
        const bf16_t* vp = P + ((size_t)b * SEQ + blk * 256) * PP + C_MV + h * 64 + lane;
#pragma unroll 8
        for (int k = 0; k < 256; ++k) o += sc[bi * 256 + k] * bf2f(vp[(size_t)k * PP]);
    }
    P[(size_t)t * PP + 512 + h * 64 + lane] = (bf16_t)f2bf(o / l);
}
__device__ __forceinline__ void naive_mem_query(Frame& F, const Args& A, int t, int h, LAS float* sc, LAS float* qs) {
    unsigned char* ws = F.ws; const int lane = F.lane;
    bf16_t* P = (bf16_t*)(ws + WS_C);
    const float* KV = (const float*)(ws + WS_KVMEM);
    const int b = t >> 13;
    const float qraw = bf2f(P[(size_t)t * PP + C_CQ + h * 64 + lane]);
    const float qh = qraw * __builtin_amdgcn_rsqf(wave_sum(qraw * qraw) * (1.0f / 64) + EPS) * A.in[16][lane];
    qs[lane] = qh;
    const float* kg = A.in[17];
    asm volatile("s_waitcnt lgkmcnt(0)" ::: "memory");
    float m = -INFINITY;
    for (int kc = 0; kc < 4; ++kc) {
        const int key = kc * 64 + lane;
        const f32x4* kp = (const f32x4*)(KV + ((size_t)b * MEMT + key) * 512 + h * 64);
        float dot = 0.f, s2 = 0.f;
#pragma unroll
        for (int c = 0; c < 16; ++c) { const f32x4 w = kp[c];
            dot += qs[c * 4 + 0] * w[0] * kg[c * 4 + 0] + qs[c * 4 + 1] * w[1] * kg[c * 4 + 1] + qs[c * 4 + 2] * w[2] * kg[c * 4 + 2] + qs[c * 4 + 3] * w[3] * kg[c * 4 + 3];
            s2 += (w[0] * w[0] + w[1] * w[1]) + (w[2] * w[2] + w[3] * w[3]); }
        const float s = dot * __builtin_amdgcn_rsqf(s2 * (1.0f / 64) + EPS) * 0.125f;
        sc[key] = s; m = fmaxf(m, s);
    }
    m = wave_max(m);
    float l = 0.f;
    for (int i = lane; i < 256; i += 64) { const float p = __expf(sc[i] - m); sc[i] = p; l += p; }
    l = wave_sum(l);
    asm volatile("s_waitcnt lgkmcnt(0)" ::: "memory");
    float o = 0.f;
    const float* vp = KV + (size_t)b * MEMT * 512 + 256 + h * 64 + lane;
#pragma unroll 8
    for (int k = 0; k < 256; ++k) o += sc[k] * vp[(size_t)k * 512];
    P[(size_t)t * PP + 768 + h * 64 + lane] = (bf16_t)f2bf(o / l);
}

__device__ __forceinline__ void p4b_naive(Frame& F, const Args& A, int pass) {
    const int bx = blockIdx.x;
#if GDN_NAIVE
    if (bx < 16) { naive_gdn(F, A, bx >> 2, bx & 3); return; }
#else
    if (bx < 16 && !(PROBE_DUP == 51 && pass == 1)) { gdn_scan(F, A, bx >> 2, bx & 3); }
#if HELP2
    else if (bx < 24 && !(PROBE_DUP == 51 && pass == 1)) { scan_helper(F, bx - 16, 0); }
#else
    else if (bx < 16 + 16 * NHELP && !(PROBE_DUP == 51 && pass == 1)) { scan_helper(F, (bx - 16) & 15, (bx - 16) >> 4); }
#endif
#endif
#if !ATTN_NAIVE
    if (!(PROBE_DUP == 51 && pass == 1) && bx >= 32)
        for (int it = bx - 32; it < 16; it += (int)gridDim.x - 32) img_item(F, A, 512 + it);
#endif
#if !GDN_NAIVE
    if (!(PROBE_DUP == 51 && pass == 1)) {
        LAS unsigned* qw = (LAS unsigned*)(F.lds + 140000);
        unsigned* head = (unsigned*)(F.ws + WS_CTL) + CW_PQ;
        u32x4 praw[11]; float pa = 0.f, pb = 0.f; int cw_head = -1, pend = -1;
#define PREP_ITEM(q_) ((((q_) & 15) >> 2) * 128 + ((q_) >> 4)) * 4 + ((q_) & 3)
        __syncthreads(); if (F.tid == 0) *qw = atomicAdd(head, 1u); __syncthreads();
        int cur = __builtin_amdgcn_readfirstlane((int)*qw);
        if (cur < N_PREP) gdn_prep_fetch(F, PREP_ITEM(cur), praw, pa, pb);
        while (cur < N_PREP) {
            int nxt = N_PREP;
            __syncthreads();
            gdn_prep_item(F, A, PREP_ITEM(cur), head, qw, nxt, praw, pa, pb, cw_head, pend);
            cur = nxt;
        }
        if (pend >= 0) {
            asm volatile("s_waitcnt vmcnt(0)" ::: "memory");
            __syncthreads();
            if (F.tid == 0) __hip_atomic_store((unsigned*)(F.ws + WS_CTL) + CW_FLG + pend, 1u, __ATOMIC_RELAXED, __HIP_MEMORY_SCOPE_AGENT);
        }
#undef PREP_ITEM
    }
#endif
#if !ATTN_NAIVE
    p4b_attn(F, A, (PROBE_DUP == 51) ? pass : 0); return;
#endif
    LAS float* sc = (LAS float*)F.lds + F.wave * 1152;
    LAS float* qs = sc + 1024;
    const int w = bx - 16, NW = F.G - 16;
    const int NQ = T * 4 / 8;
    for (int it = w; it < 2 * NQ; it += NW) {
        const int kind = it >= NQ; const int q = (kind ? it - NQ : it) * 8 + F.wave;
        if (kind) naive_mem_query(F, A, q >> 2, q & 3, sc, qs); else naive_moba_query(F, A, q >> 2, q & 3, sc, qs);
    }
}

__global__ void __launch_bounds__(NTHREADS, 2) mk_fwd(Args args) {
    extern __shared__ __attribute__((aligned(16))) unsigned char lds_raw[];
    Frame F;
    F.lds = (LAS unsigned char*)lds_raw;
    F.tid = threadIdx.x; F.lane = F.tid & 63; F.wave = __builtin_amdgcn_readfirstlane(F.tid >> 6);
    F.G = gridDim.x; { const int bx = blockIdx.x; F.vcu = (F.G % 8 == 0) ? (bx % 8) * (F.G / 8) + bx / 8 : bx; }
    F.out = args.out; F.ws = args.ws;
    unsigned char* ws = args.ws;
    const int lo = args.ph_lo, hi = args.ph_hi;
#define IN(k) (lo <= (k) && (k) < hi)
#if USE_CG_SYNC
#define SEAM(k) do { if (IN(k) && IN((k) + 1)) { cg::this_grid().sync(); } } while (0)
#else
    { volatile LAS unsigned* st = (volatile LAS unsigned*)(F.lds + LDS_ST_OFF); if (F.tid < 4) st[F.tid] = 0u; }
    __syncthreads();
    XcdBarrier bar = xcd_barrier_post((unsigned*)(ws + WS_CTL) + CW_BAR, (volatile LAS unsigned*)(F.lds + LDS_ST_OFF));
#define SEAM(k) do { if (IN(k) && IN((k) + 1)) { xcd_barrier(bar); } } while (0)
#endif
#define PH_BEGIN(k) for (int _r = 0; _r < ((PROBE_DUP == (k) || (PROBE_DUP == 51 && (k) == 5)) ? 2 : 1); ++_r) { if (_r) xcd_barrier(bar);
#define PH_END }
    float* ss = (float*)(ws + WS_SS);
    bf16_t* XB = (bf16_t*)(ws + WS_XB);
    bf16_t* PC = (bf16_t*)(ws + WS_C);

    PH_BEGIN(0) if (IN(0)) { p0_prologue(F, args); }
    PH_END
    SEAM(0);
#if PROBE_DUP == 61
    { pg8::Gemm g{XB, (const bf16_t*)(ws + WS_WGU1), T, NGU, DM, DM}; pg8::StaticOrder S; S.init(T, NGU, F.G, (int)blockIdx.x);
      pg8::EpiNullP E{(float*)(ws + WS_CTL) + 60000}; pg8::gemm_phase<pg8::EpiNullP, true>(F.lds, g, S, E); xcd_barrier(bar); }
#endif
    PH_BEGIN(1) if (IN(1)) {
        pg8::Gemm g{XB, (const bf16_t*)(ws + WS_WGU1), T, NGU, DM, DM}; pg8::StaticOrder S; S.init(T, NGU, F.G, (int)blockIdx.x);
        pg8::EpiSwiGLU E{PC, ss};
        pg8::gemm_phase<pg8::EpiSwiGLU, true>(F.lds, g, S, E, ss);
    }
    PH_END
    SEAM(1);
#if PROBE_DUP == 62
    { pg8::Gemm g{PC, (const bf16_t*)(ws + WS_WD1), T, DM, FF, FF}; pg8::StaticOrder S; S.init(T, DM, F.G, (int)blockIdx.x);
      pg8::EpiNullN E{(float*)(ws + WS_CTL) + 60000}; pg8::gemm_phase<pg8::EpiNullN, true>(F.lds, g, S, E); xcd_barrier(bar); }
#endif
    PH_BEGIN(2) if (IN(2)) {
        pg8::Gemm g{PC, (const bf16_t*)(ws + WS_WD1), T, DM, FF, FF}; pg8::StaticOrder S; S.init(T, DM, F.G, (int)blockIdx.x);
        pg8::EpiResid<1> E{nullptr, F.out, XB, ss, 0.5f};
        pg8::gemm_phase<pg8::EpiResid<1>, true>(F.lds, g, S, E);
    }
    PH_END
    SEAM(2);
    PH_BEGIN(3) if (IN(3)) {
        pg8::Gemm g{XB, (const bf16_t*)(ws + WS_WIN), T, NIN, DM, DM}; pg8::StaticOrder S; S.init(T, NIN, F.G, (int)blockIdx.x);
        pg8::EpiWin E{PC, (float*)(ws + WS_AB), ss};
        pg8::gemm_phase<pg8::EpiWin, true>(F.lds, g, S, E, ss);
        {
            pg8::Gemm g2{(const bf16_t*)(ws + WS_MEMB), (const bf16_t*)(ws + WS_WKV), BATCH * MEMT, 512, DM, DM}; pg8::StaticOrder S2; S2.init(BATCH * MEMT, 512, 8, (int)blockIdx.x - (F.G - 8));
            pg8::EpiKV E2{(float*)(ws + WS_KVMEM), (const float*)(ws + WS_RSTDM)};
            pg8::gemm_phase<pg8::EpiKV, false>(F.lds, g2, S2, E2);
        }
        {
            const int rem = ((T / 256) * (NIN / 256)) % F.G; int lo = rem, hi = F.G - 8; if (hi - lo < 32) { lo = 0; hi = F.G; }
            const int c = (int)blockIdx.x;
            if (c >= lo && c < hi) tr_weights<1>(F, args, (c - lo) * NWAVES + F.wave, (hi - lo) * NWAVES);
        }
    }
    PH_END
    SEAM(3);
    PH_BEGIN(4) if (IN(4)) {
#if ATTN_NAIVE
        p4a_naive(F, args);
#else
        for (int it = F.vcu; it < 512; it += F.G) img_item(F, args, it);
#endif
    }
    PH_END
    SEAM(4);
    PH_BEGIN(5) if (IN(5)) { p4b_naive(F, args, _r); }
    PH_END
    SEAM(5);
    PH_BEGIN(6) if (IN(6)) {
        pg8::Gemm g{PC, (const bf16_t*)(ws + WS_WOUT), T, DM, DM, PP}; pg8::StaticOrder S; S.init(T, DM, F.G, (int)blockIdx.x);
        pg8::EpiResid<1> E{nullptr, F.out, XB, ss, 1.0f};
        pg8::gemm_phase<pg8::EpiResid<1>, true>(F.lds, g, S, E);
    }
    PH_END
    SEAM(6);
    PH_BEGIN(7) if (IN(7)) {
        pg8::Gemm g{XB, (const bf16_t*)(ws + WS_WGU2), T, NGU, DM, DM}; pg8::StaticOrder S; S.init(T, NGU, F.G, (int)blockIdx.x);
        pg8::EpiSwiGLU E{PC, ss};
        pg8::gemm_phase<pg8::EpiSwiGLU, true>(F.lds, g, S, E, ss);
    }
    PH_END
    SEAM(7);
    PH_BEGIN(8) if (IN(8)) {
        pg8::Gemm g{PC, (const bf16_t*)(ws + WS_WD2), T, DM, FF, FF}; pg8::StaticOrder S; S.init(T, DM, F.G, (int)blockIdx.x);
        pg8::EpiResid<2> E{nullptr, F.out, XB, ss, 0.5f};
        pg8::gemm_phase<pg8::EpiResid<2>, true>(F.lds, g, S, E);
    }
    PH_END
#undef IN
#undef SEAM
}

constexpr int N_PHASES = 9;
extern "C" void kernel_launch(void* const* d_in, const int* in_sizes, int n_in, void* d_out, int out_size, void* d_ws, size_t ws_size, hipStream_t stream) {
    static int grid = 0;
    if (grid == 0) {
        if (n_in != 23 || out_size != T * DM || ws_size < WS_END) { fprintf(stderr, "kernel_launch: unexpected shapes (n_in %d out %d ws %zu)\n", n_in, out_size, ws_size); grid = -1; return; }
        int dev = 0, cus = 0, per_cu = 0;
        (void)hipGetDevice(&dev); (void)hipDeviceGetAttribute(&cus, hipDeviceAttributeMultiprocessorCount, dev);
        (void)hipFuncSetAttribute((const void*)mk_fwd, hipFuncAttributeMaxDynamicSharedMemorySize, LDS_BYTES);
        (void)hipOccupancyMaxActiveBlocksPerMultiprocessor(&per_cu, (const void*)mk_fwd, NTHREADS, LDS_BYTES);
        (void)hipGetLastError();
        if (per_cu < 1) { fprintf(stderr, "kernel_launch: occupancy query says %d blocks/CU\n", per_cu); }
        grid = cus;
        if (grid != 256) fprintf(stderr, "kernel_launch: %d CUs (expected 256)\n", grid);
    }
    if (grid < 0) return;
    (void)hipMemsetAsync((char*)d_ws + WS_CTL, 0, 81920, stream);
    Args a{};
    for (int i = 0; i < 23; ++i) a.in[i] = (const float*)d_in[i];
    a.out = (float*)d_out; a.ws = (unsigned char*)d_ws;
    if (MK_N_LAUNCHES == 1) {
        a.ph_lo = 0; a.ph_hi = N_PHASES;
#if USE_CG_SYNC
        void* kargs[] = {&a};
        hipError_t e = hipLaunchCooperativeKernel((const void*)mk_fwd, dim3(grid), dim3(NTHREADS), kargs, LDS_BYTES, stream);
        if (e != hipSuccess) fprintf(stderr, "cooperative launch failed: %s\n", hipGetErrorString(e));
#else
        hipLaunchKernelGGL(mk_fwd, dim3(grid), dim3(NTHREADS), LDS_BYTES, stream, a);
#endif
    } else {
        for (int p = 0; p < N_PHASES; ++p) {
            a.ph_lo = p; a.ph_hi = p + 1;
            hipLaunchKernelGGL(mk_fwd, dim3(grid), dim3(NTHREADS), LDS_BYTES, stream, a);
        }
    }
}
```
